# Optimizing an MI355X kernel written in HIP

```python
import jax
import jax.numpy as jnp
from jax import lax
import numpy as np

D_MODEL = 1024
BATCH = 8
SEQ = 8192
DEPTH = 2

RW_HEADS = 8
RW_HEAD = 64
RW = RW_HEADS * RW_HEAD
RW_LORA_W = 64
RW_LORA_A = 64
RW_LORA_G = 128
RW_LORA_V = 32
RW_GN_EPS = 64e-5
CV = 512
CONV_WIDTH = 31
POOL_WINDOWS = (2, 4, 8, 16)
N_POOL = len(POOL_WINDOWS)
PW = 512
PG = PW // N_POOL
N_BRANCH = 3
D_FF = 4 * D_MODEL
N_ADA = 6
LN_EPS = 1e-5
ALPHA = (2 * DEPTH) ** 0.25
BETA = (8 * DEPTH) ** -0.25

RW_SHIFT = 3 * RW + RW_LORA_W + RW_LORA_A + RW_LORA_G
CV_OFF = RW_SHIFT
PL_OFF = CV_OFF + 2 * CV
GT_OFF = PL_OFF + PW
C_MAIN = GT_OFF + N_BRANCH * D_MODEL

kernel_name = "hybrid_rwkv7_conformer_pool_deepnorm_block"


def _layernorm(x, g, b, eps=LN_EPS):
    xf = x.astype(jnp.float32)
    mu = xf.mean(-1, keepdims=True)
    var = jnp.square(xf - mu).mean(-1, keepdims=True)
    y = (xf - mu) * lax.rsqrt(var + eps)
    return (y * g.astype(jnp.float32) + b.astype(jnp.float32)).astype(x.dtype)


def _token_shift(z, mu):
    prev = jnp.pad(z[:, :-1], ((0, 0), (1, 0), (0, 0)))
    return z + (prev - z) * mu


def _rwkv7_recurrence(r, w, k, v, a, b):
    Bn, S, H, N = r.shape

    def step(state, inp):
        r_t, w_t, k_t, v_t, a_t, b_t = inp
        sa = jnp.einsum('bhvk,bhk->bhv', state, a_t)
        state = (state * w_t[:, :, None, :] + sa[..., None] * b_t[:, :, None, :]
                 + v_t[..., None] * k_t[:, :, None, :])
        y_t = jnp.einsum('bhvk,bhk->bhv', state, r_t)
        return state, y_t

    s0 = jnp.zeros((Bn, H, N, N), jnp.float32)
    xs = tuple(jnp.moveaxis(t, 1, 0) for t in (r, w, k, v, a, b))
    _, y = lax.scan(step, s0, xs)
    return jnp.moveaxis(y, 0, 1)


def _rwkv7_branch(z, lv, v_first, w0, w2, a0, a2, g2, v0, v2, k_k, k_a, r_k, gn_g, gn_b, w_o):
    Bn, S, _ = z.shape
    f32 = jnp.float32
    r, k, v, lw, la, lg = jnp.split(
        z, [RW, 2 * RW, 3 * RW, 3 * RW + RW_LORA_W, 3 * RW + RW_LORA_W + RW_LORA_A], axis=-1)
    w_log = -jax.nn.softplus(-(w0 + jnp.tanh(lw) @ w2).astype(f32)) - 0.5
    decay = jnp.exp(-jnp.exp(w_log))
    a = jax.nn.sigmoid(a0 + la @ a2)
    g = jax.nn.sigmoid(lg) @ g2
    if v_first is None:
        v_first = v
    else:
        v = v + (v_first - v) * jax.nn.sigmoid(v0 + lv @ v2)

    def heads(t):
        return t.astype(f32).reshape(Bn, S, RW_HEADS, RW_HEAD)

    kk = heads(k * k_k)
    kk = kk / jnp.maximum(jnp.sqrt(jnp.sum(kk * kk, -1, keepdims=True)), 1e-12)
    a_h = heads(a)
    k_h = heads(k * (1 + (a - 1) * k_a))
    r_h = heads(r)
    v_h = heads(v)
    y = _rwkv7_recurrence(r_h, decay.reshape(Bn, S, RW_HEADS, RW_HEAD), k_h, v_h, -kk, kk * a_h)
    mu = y.mean(-1, keepdims=True)
    var = jnp.square(y - mu).mean(-1, keepdims=True)
    y = (y - mu) * lax.rsqrt(var + RW_GN_EPS)
    y = y.reshape(Bn, S, RW) * gn_g.astype(f32) + gn_b.astype(f32)
    bonus = jnp.sum(r_h * k_h * r_k.astype(f32), -1, keepdims=True) * v_h
    y = (y + bonus.reshape(Bn, S, RW)).astype(z.dtype) * g
    return y @ w_o, v_first


def _conv_branch(u, conv_w, conv_b, ln_g, ln_b, w_o):
    val, gate = jnp.split(u, 2, axis=-1)
    h = val * jax.nn.sigmoid(gate)
    h = lax.conv_general_dilated(
        h, conv_w[:, None, :], window_strides=(1,),
        padding=((CONV_WIDTH - 1, 0),),
        dimension_numbers=('NWC', 'WIO', 'NWC'),
        feature_group_count=CV) + conv_b
    h = jax.nn.silu(_layernorm(h, ln_g, ln_b))
    return h @ w_o


def _pool_branch(p, lin_w, scale, w_o):
    Bn, S, _ = p.shape
    pf = p.astype(jnp.float32)
    cs = jnp.cumsum(pf, axis=1)
    t1 = jnp.arange(1, S + 1, dtype=jnp.float32)[None, :, None]
    outs = []
    for gi, win in enumerate(POOL_WINDOWS):
        sl = slice(gi * PG, (gi + 1) * PG)
        csg = cs[..., sl]
        lower = jnp.pad(csg[:, :S - win], ((0, 0), (win, 0), (0, 0)))
        mean = (csg - lower) / jnp.minimum(t1, float(win))
        outs.append(mean - pf[..., sl])
    pooled = jnp.stack(outs, axis=2).astype(p.dtype)
    mixed = jnp.einsum('bsgc,gcd->bsgd', pooled, lin_w).reshape(Bn, S, PW)
    return (mixed * scale) @ w_o


def setup_inputs(seed: int = 0) -> dict:
    key = jax.random.key(seed)
    ks = iter(jax.random.split(key, 40))
    f32 = jnp.float32

    def nrm(shape, s):
        return jax.random.normal(next(ks), shape, f32) * s

    def unif(shape, lo, hi):
        return jax.random.uniform(next(ks), shape, f32, lo, hi)

    L, D, Lv = DEPTH, D_MODEL, DEPTH - 1
    return {
        "x": nrm((BATCH, SEQ, D), 1.0),
        "c": nrm((BATCH, D), 1.0),
        "ada_w": nrm((L, D, N_ADA * D), 0.5 * D ** -0.5),
        "ada_b": nrm((L, N_ADA * D), 0.02),
        "w_in": nrm((L, D, C_MAIN), D ** -0.5),
        "w_in_vres": nrm((Lv, D, RW_LORA_V), D ** -0.5),
        "shift_mu": unif((L, RW_SHIFT), 0.0, 1.0),
        "shift_mu_vres": unif((Lv, RW_LORA_V), 0.0, 1.0),
        "rw_w0": unif((L, RW), -5.0, -1.0),
        "rw_w2": nrm((L, RW_LORA_W, RW), 0.5 * RW_LORA_W ** -0.5),
        "rw_a0": nrm((L, RW), 0.1),
        "rw_a2": nrm((L, RW_LORA_A, RW), 0.5 * RW_LORA_A ** -0.5),
        "rw_g2": nrm((L, RW_LORA_G, RW), RW_LORA_G ** -0.5),
        "rw_v0": 1.0 + nrm((Lv, RW), 0.1),
        "rw_v2": nrm((Lv, RW_LORA_V, RW), 0.5 * RW_LORA_V ** -0.5),
        "rw_kk": 0.85 + nrm((L, RW), 0.05),
        "rw_ka": 1.0 + nrm((L, RW), 0.05),
        "rw_rk": nrm((L, RW_HEADS, RW_HEAD), 0.1),
        "rw_gn_g": 1.0 + nrm((L, RW), 0.05),
        "rw_gn_b": nrm((L, RW), 0.02),
        "rw_wo": nrm((L, RW, D), BETA * RW ** -0.5),
        "cv_w": nrm((L, CONV_WIDTH, CV), CONV_WIDTH ** -0.5),
        "cv_b": nrm((L, CV), 0.02),
        "cv_ln_g": 1.0 + nrm((L, CV), 0.05),
        "cv_ln_b": nrm((L, CV), 0.02),
        "cv_wo": nrm((L, CV, D), BETA * CV ** -0.5),
        "pl_w": nrm((L, N_POOL, PG, PG), PG ** -0.5),
        "pl_scale": 1.0 + nrm((L, PW), 0.1),
        "pl_wo": nrm((L, PW, D), BETA * PW ** -0.5),
        "w_out": nrm((L, D, D), BETA * D ** -0.5),
        "ln_m_g": 1.0 + nrm((L, D), 0.05),
        "ln_m_b": nrm((L, D), 0.02),
        "mlp_w1": nrm((L, D, D_FF), BETA * D ** -0.5),
        "mlp_w2": nrm((L, D_FF, D), BETA * D_FF ** -0.5),
        "ln_f_g": 1.0 + nrm((L, D), 0.05),
        "ln_f_b": nrm((L, D), 0.02),
    }


def reference(x, c, ada_w, ada_b, w_in, w_in_vres, shift_mu, shift_mu_vres,
              rw_w0, rw_w2, rw_a0, rw_a2, rw_g2, rw_v0, rw_v2, rw_kk, rw_ka, rw_rk,
              rw_gn_g, rw_gn_b, rw_wo, cv_w, cv_b, cv_ln_g, cv_ln_b, cv_wo,
              pl_w, pl_scale, pl_wo, w_out, ln_m_g, ln_m_b, mlp_w1, mlp_w2,
              ln_f_g, ln_f_b):
    Bn, S, D = x.shape
    cond = jax.nn.silu(c)
    v_first = None
    for l in range(DEPTH):
        ada = (cond @ ada_w[l] + ada_b[l])[:, None, :]
        sh_m, sc_m, gt_m, sh_f, sc_f, gt_f = jnp.split(ada, N_ADA, axis=-1)

        h = x * (1 + sc_m) + sh_m
        if l == 0:
            proj = h @ w_in[l]
            lv = None
        else:
            proj = h @ jnp.concatenate([w_in[l], w_in_vres[l - 1]], axis=1)
            lv = _token_shift(proj[..., C_MAIN:], shift_mu_vres[l - 1])
        z = _token_shift(proj[..., :RW_SHIFT], shift_mu[l])
        u = proj[..., CV_OFF:PL_OFF]
        p = proj[..., PL_OFF:GT_OFF]
        gates = jax.nn.sigmoid(proj[..., GT_OFF:C_MAIN]).reshape(Bn, S, N_BRANCH, D)

        y_rw, v_first = _rwkv7_branch(
            z, lv, v_first, rw_w0[l], rw_w2[l], rw_a0[l], rw_a2[l], rw_g2[l],
            rw_v0[l - 1] if l > 0 else None, rw_v2[l - 1] if l > 0 else None,
            rw_kk[l], rw_ka[l], rw_rk[l], rw_gn_g[l], rw_gn_b[l], rw_wo[l])
        y_cv = _conv_branch(u, cv_w[l], cv_b[l], cv_ln_g[l], cv_ln_b[l], cv_wo[l])
        y_pl = _pool_branch(p, pl_w[l], pl_scale[l], pl_wo[l])
        merged = gates[:, :, 0] * y_rw + gates[:, :, 1] * y_cv + gates[:, :, 2] * y_pl
        x = _layernorm(ALPHA * x + gt_m * (merged @ w_out[l]), ln_m_g[l], ln_m_b[l])

        h = x * (1 + sc_f) + sh_f
        y_ff = jnp.square(jax.nn.relu(h @ mlp_w1[l])) @ mlp_w2[l]
        x = _layernorm(ALPHA * x + gt_f * y_ff, ln_f_g[l], ln_f_b[l])
    return x
```

```cpp
#include <hip/hip_runtime.h>
#include <hip/hip_cooperative_groups.h>
#include <cstdio>
#include <cstdint>
namespace cg = cooperative_groups;
__device__ __forceinline__ int opq_tid() { int t = threadIdx.x; asm volatile("" : "+v"(t)); return t; }
__device__ __forceinline__ int opq_bid() { int t = blockIdx.x; asm volatile("" : "+s"(t)); return t; }
__device__ __forceinline__ int opq_gdim() { int t = gridDim.x; asm volatile("" : "+s"(t)); return t; }
namespace pg8 {
#define PG8_LAS __attribute__((address_space(3)))
typedef unsigned short bf16_t;
typedef short bf16x8 __attribute__((ext_vector_type(8)));
typedef float f32x4 __attribute__((ext_vector_type(4)));
typedef unsigned u32x4 __attribute__((ext_vector_type(4)));
constexpr int BM = 256, BK = 64, HALF = 128, HTB = HALF * BK * 2  , STAGE_BYTES = 8 * HTB, NXCD = 8, WGM = 8;

__host__ __device__ __forceinline__ int lds_byte(int r, int c) { const int st = (r >> 4) * 2 + (c >> 5), rr = r & 15, cc = c & 31, ob = rr * 64 + cc * 2; return st * 1024 + (ob ^ (((ob >> 9) & 1) << 5)); }
__host__ __device__ __forceinline__ void stage_rc(int b, int& R, int& C) { const int st = b / 1024, sb = b % 1024, swz = sb ^ (((sb >> 9) & 1) << 5); R = (st >> 1) * 16 + swz / 64; C = (st & 1) * 32 + (swz % 64) / 2; }
__host__ __device__ __forceinline__ int perm32(int rho) { const int n = rho >> 4, i = rho & 15; return 8 * (i >> 2) + 4 * n + (i & 3); }

struct Unit { int pm, pn; };
struct Gemm { const bf16_t* A; const bf16_t* A1; const bf16_t* A2; int segt; const bf16_t* Bt; int M, N, K;
    __device__ __forceinline__ const bf16_t* a_of(int pn) const { return segt == 0 ? A : (pn < segt ? A : (pn < 2 * segt ? A1 : A2)); } };

struct StaticOrder {
    int nM, nN, nwg, G, c;
    __host__ __device__ void init(int M, int N, int G_, int c_) { nM = M / BM; nN = N / BM; nwg = nM * nN; G = G_; c = c_; }
    __host__ __device__ bool next(int i, Unit& u) const {
        const long L = (long)i * G + c; if (L >= nwg) return false;
        int wgid = (int)L; { const int q = nwg / NXCD, r = nwg % NXCD, xcd = wgid % NXCD, off = wgid / NXCD; wgid = (xcd < r ? xcd * (q + 1) : r * (q + 1) + (xcd - r) * q) + off; }
        const int nig = WGM * nN, gid = wgid / nig, fm = gid * WGM, gsz = (nM - fm) < WGM ? (nM - fm) : WGM;
        u.pm = fm + ((wgid % nig) % gsz); u.pn = (wgid % nig) / gsz; return true;
    }
    __device__ __forceinline__ void a_ready(const Unit&) const {}
    __device__ __forceinline__ void done(const Unit&) const {}
};
__device__ __forceinline__ unsigned cvt_pk_bf16(float lo, float hi) { unsigned r; asm volatile("v_cvt_pk_bf16_f32 %0, %1, %2" : "=v"(r) : "v"(lo), "v"(hi)); return r; }
template <class Epi, class Sched, bool ALIGN_EPI = false, bool SP2 = false>
__device__ __forceinline__ void gemm_phase(PG8_LAS unsigned char* lds, const Gemm g, const Sched& S, const Epi& E) {
    const int tid = opq_tid(), wid = __builtin_amdgcn_readfirstlane(tid >> 6), lane = tid & 63, wr = wid >> 2, wc = wid & 3, fr = lane & 15, fq = lane >> 4;
    const int K = g.K, nt = K / BK;
    unsigned voffA[2], voffB[2];
#pragma unroll
    for (int i = 0; i < 2; ++i) { int R, C; stage_rc(tid * 16 + i * 8192, R, C); const int Rb = Epi::PERM ? ((R & ~31) + perm32(R & 31)) : R;
        voffA[i] = (unsigned)(R * K + C) * 2u; voffB[i] = (unsigned)(Rb * K + C) * 2u; }
    const size_t kstep = (size_t)(BK * 2);
    const size_t hstep = (size_t)HALF * K * 2;
    const size_t tstep = 2 * hstep;
    const unsigned ldsw = (unsigned)wid * 1024u;
    const int aoff = lds_byte(wr * 64 + fr, fq * 8), boff = lds_byte(wc * 32 + fr, fq * 8);
#define PG8_SA(b, h) (((b) * 2 + (h)) * HTB)
#define PG8_SB(b, h) ((4 + (b) * 2 + (h)) * HTB)
#define PG8_STAGE(bufoff, gbase, voff) do { _Pragma("unroll") for (int _i = 0; _i < 2; ++_i) \
        __builtin_amdgcn_global_load_lds((const unsigned*)((const char*)(gbase) + (voff)[_i]), (PG8_LAS unsigned*)(lds + (bufoff) + ldsw + _i * 8192), 16, 0, 0); } while (0)
#define PG8_LDA(dst, b, h) do { _Pragma("unroll") for (int m = 0; m < 4; ++m) _Pragma("unroll") for (int k = 0; k < 2; ++k) dst[m][k] = *(const PG8_LAS bf16x8*)(lds + PG8_SA(b, h) + aoff + m * 2048 + k * 1024); } while (0)
#define PG8_LDB(dst, b, h) do { _Pragma("unroll") for (int n = 0; n < 2; ++n) _Pragma("unroll") for (int k = 0; k < 2; ++k) dst[n][k] = *(const PG8_LAS bf16x8*)(lds + PG8_SB(b, h) + boff + n * 2048 + k * 1024); } while (0)
#define PG8_MMA(ai, bj, At, Bt) do { __builtin_amdgcn_s_setprio(1); _Pragma("unroll") for (int m = 0; m < 4; ++m) _Pragma("unroll") for (int n = 0; n < 2; ++n) _Pragma("unroll") for (int k = 0; k < 2; ++k) \
        acc[ai][bj][m][n] = __builtin_amdgcn_mfma_f32_16x16x32_bf16(Bt[n][k], At[m][k], acc[ai][bj][m][n], 0, 0, 0); __builtin_amdgcn_s_setprio(0); } while (0)
#define PG8_WAIT_V(n) asm volatile("s_waitcnt vmcnt(" #n ")" ::: "memory")
#define PG8_WAIT_L(n) asm volatile("s_waitcnt lgkmcnt(" #n ")" ::: "memory")
#define PG8_BAR __builtin_amdgcn_s_barrier()
#define PG8_SCHED __builtin_amdgcn_sched_barrier(0)
    Unit cur, nxt; int ui = 0;
    if (!S.next(0, cur)) return;
    f32x4 acc[2][2][4][2];
#pragma unroll
    for (int a = 0; a < 2; ++a)
#pragma unroll
        for (int b = 0; b < 2; ++b)
#pragma unroll
            for (int m = 0; m < 4; ++m)
#pragma unroll
                for (int n = 0; n < 2; ++n) acc[a][b][m][n] = (f32x4){0.f, 0.f, 0.f, 0.f};
    bf16x8 At[4][2], B0[2][2], B1[2][2];
    const char* cA = (const char*)g.a_of(cur.pn) + (size_t)cur.pm * tstep; const char* cB = (const char*)g.Bt + (size_t)cur.pn * tstep;
    S.a_ready(cur);
    if constexpr (SP2) {
        PG8_STAGE(PG8_SB(0, 0), cB, voffB); PG8_STAGE(PG8_SB(0, 1), cB + hstep, voffB); PG8_STAGE(PG8_SA(0, 0), cA, voffA); PG8_STAGE(PG8_SA(0, 1), cA + hstep, voffA);
        if (wr == 1) PG8_BAR;
        PG8_WAIT_V(2); PG8_BAR;
        PG8_STAGE(PG8_SB(1, 0), cB + kstep, voffB); PG8_STAGE(PG8_SA(1, 0), cA + kstep, voffA); PG8_STAGE(PG8_SB(1, 1), cB + hstep + kstep, voffB);
        PG8_WAIT_V(6); PG8_BAR;
    } else {
        PG8_STAGE(PG8_SB(0, 0), cB, voffB); PG8_STAGE(PG8_SA(0, 0), cA, voffA); PG8_STAGE(PG8_SB(0, 1), cB + hstep, voffB); PG8_STAGE(PG8_SA(0, 1), cA + hstep, voffA);
        if (wr == 1) PG8_BAR;
        PG8_WAIT_V(4); PG8_BAR;
        PG8_STAGE(PG8_SB(1, 0), cB + kstep, voffB); PG8_STAGE(PG8_SA(1, 0), cA + kstep, voffA); PG8_STAGE(PG8_SB(1, 1), cB + hstep + kstep, voffB);
        PG8_WAIT_V(6); PG8_BAR;
    }
    for (;;) {
        const bool has_next = S.next(ui + 1, nxt);
        const char* nA = has_next ? (const char*)g.a_of(nxt.pn) + (size_t)nxt.pm * tstep : cA; const char* nB = has_next ? (const char*)g.Bt + (size_t)nxt.pn * tstep : cB;
        for (int t = 0; t < nt; t += 2) {
            const bool last = (t == nt - 2);
            const char* a1 = cA + (size_t)(t + 1) * kstep;
            const char* a2 = last ? nA : cA + (size_t)(t + 2) * kstep; const char* b2 = last ? nB : cB + (size_t)(t + 2) * kstep;
            const char* a3 = a2 + kstep; const char* b3 = b2 + kstep;
            if (last && has_next) S.a_ready(nxt);
            if constexpr (SP2) {
            PG8_LDB(B0, 0, 0); PG8_LDB(B1, 0, 1); PG8_SCHED; PG8_LDA(At, 0, 0); PG8_STAGE(PG8_SA(1, 1), a1 + hstep, voffA);
            PG8_WAIT_V(8); PG8_WAIT_L(0); PG8_BAR; PG8_MMA(0, 0, At, B0); PG8_MMA(0, 1, At, B1); PG8_BAR; PG8_SCHED;
            PG8_LDA(At, 0, 1); PG8_STAGE(PG8_SB(0, 0), b2, voffB); PG8_STAGE(PG8_SB(0, 1), b2 + hstep, voffB); PG8_STAGE(PG8_SA(0, 0), a2, voffA);
            PG8_WAIT_V(8); PG8_WAIT_L(0); PG8_BAR; PG8_MMA(1, 0, At, B0); PG8_MMA(1, 1, At, B1); PG8_BAR; PG8_SCHED;
            PG8_LDB(B0, 1, 0); PG8_LDB(B1, 1, 1); PG8_SCHED; PG8_LDA(At, 1, 0); PG8_STAGE(PG8_SA(0, 1), a2 + hstep, voffA);
            PG8_WAIT_V(8); PG8_WAIT_L(0); PG8_BAR; PG8_MMA(0, 0, At, B0); PG8_MMA(0, 1, At, B1); PG8_BAR; PG8_SCHED;
            PG8_LDA(At, 1, 1); PG8_STAGE(PG8_SB(1, 0), b3, voffB); PG8_STAGE(PG8_SB(1, 1), b3 + hstep, voffB); PG8_STAGE(PG8_SA(1, 0), a3, voffA);
            PG8_WAIT_V(8); PG8_WAIT_L(0); PG8_BAR; PG8_MMA(1, 0, At, B0); PG8_MMA(1, 1, At, B1); PG8_BAR; PG8_SCHED;
            } else {
            PG8_LDB(B0, 0, 0); PG8_SCHED; PG8_LDA(At, 0, 0); PG8_STAGE(PG8_SA(1, 1), a1 + hstep, voffA);
            PG8_WAIT_L(8); PG8_BAR; PG8_WAIT_L(0); PG8_MMA(0, 0, At, B0); PG8_BAR; PG8_SCHED;
            PG8_LDB(B1, 0, 1); PG8_STAGE(PG8_SB(0, 0), b2, voffB);
            PG8_BAR; PG8_WAIT_L(0); PG8_MMA(0, 1, At, B1); PG8_BAR;
            PG8_LDA(At, 0, 1); PG8_STAGE(PG8_SA(0, 0), a2, voffA);
            PG8_BAR; PG8_WAIT_L(0); PG8_MMA(1, 0, At, B0); PG8_BAR; PG8_SCHED;
            PG8_STAGE(PG8_SB(0, 1), b2 + hstep, voffB);
            PG8_WAIT_V(6); PG8_BAR; PG8_MMA(1, 1, At, B1); PG8_BAR;
            PG8_LDB(B0, 1, 0); PG8_SCHED; PG8_LDA(At, 1, 0); PG8_STAGE(PG8_SA(0, 1), a2 + hstep, voffA);
            PG8_WAIT_L(8); PG8_BAR; PG8_WAIT_L(0); PG8_MMA(0, 0, At, B0); PG8_BAR; PG8_SCHED;
            PG8_LDB(B1, 1, 1); PG8_STAGE(PG8_SB(1, 0), b3, voffB);
            PG8_BAR; PG8_WAIT_L(0); PG8_MMA(0, 1, At, B1); PG8_BAR;
            PG8_LDA(At, 1, 1); PG8_STAGE(PG8_SA(1, 0), a3, voffA);
            PG8_BAR; PG8_WAIT_L(0); PG8_MMA(1, 0, At, B0); PG8_BAR; PG8_SCHED;
            PG8_STAGE(PG8_SB(1, 1), b3 + hstep, voffB);
            PG8_WAIT_V(6); PG8_BAR; PG8_MMA(1, 1, At, B1); PG8_BAR;
            }
        }
        if constexpr (ALIGN_EPI) { if (wr == 0) PG8_BAR; }
        if constexpr (!Epi::AFTER_DRAIN) { E(acc, cur, wr, wc, fr, fq); S.done(cur); }
        if (!has_next) break;
#pragma unroll
        for (int a = 0; a < 2; ++a)
#pragma unroll
            for (int b = 0; b < 2; ++b)
#pragma unroll
                for (int m = 0; m < 4; ++m)
#pragma unroll
                    for (int n = 0; n < 2; ++n) acc[a][b][m][n] = (f32x4){0.f, 0.f, 0.f, 0.f};
        cur = nxt; cA = nA; cB = nB; ++ui;
        if constexpr (ALIGN_EPI) { if (wr == 1) PG8_BAR; }
    }
    PG8_WAIT_V(0);
    if constexpr (!ALIGN_EPI) { if (wr == 0) PG8_BAR; }
    PG8_BAR;
    if constexpr (Epi::AFTER_DRAIN) { E.fused(acc, cur, wr, wc, fr, fq, lds, wid, lane); S.done(cur); }
#undef PG8_SA
#undef PG8_SB
#undef PG8_STAGE
#undef PG8_LDA
#undef PG8_LDB
#undef PG8_MMA
#undef PG8_WAIT_V
#undef PG8_WAIT_L
#undef PG8_BAR
#undef PG8_SCHED
}
}

#define LAS __attribute__((address_space(3)))
typedef unsigned short bf16;
typedef pg8::f32x4 f32x4;
typedef pg8::u32x4 u32x4;
typedef unsigned u32x2 __attribute__((ext_vector_type(2)));
using pg8::Unit;

constexpr int M = 65536, D = 1024, SEQ = 8192;
constexpr float ALPHA = 1.4142135623730951f;
constexpr float LN_EPS = 1e-5f, GN_EPS = 64e-5f;
constexpr int LDS_BYTES = 147456;

constexpr size_t MiB = (size_t)1 << 20;
constexpr size_t WS_ADAP = 1 * MiB, WS_ADA = 4 * MiB, WS_WLORA0 = 5 * MiB, WS_WLORA1 = 6 * MiB, WS_WINA0 = 8 * MiB, WS_WINA1 = 15 * MiB,
    WS_WG0 = 22 * MiB, WS_WG1 = 28 * MiB, WS_WBR0 = 34 * MiB, WS_WBR1 = 37 * MiB, WS_WOUT0 = 40 * MiB, WS_WOUT1 = 42 * MiB,
    WS_W1_0 = 44 * MiB, WS_W1_1 = 52 * MiB, WS_W2_0 = 60 * MiB, WS_W2_1 = 68 * MiB, WS_VFIRST = 76 * MiB, WS_H = 140 * MiB, WS_AR = 268 * MiB;
constexpr size_t AR_ZR = 0, AR_CG = 224 * MiB, AR_PL = 288 * MiB, AR_LV = 352 * MiB, AR_LO = 224 * MiB, AR_YCV = 480 * MiB, AR_POOL = 544 * MiB,
    AR_YRW = 608 * MiB, AR_LA = 672 * MiB, AR_P = 0, AR_HID = 0;
constexpr size_t WS_END = WS_AR + 720 * MiB;

struct Args { const float* in[36]; float* out; unsigned char* ws; };
typedef const Args __attribute__((address_space(4)))* ArgsP;
__device__ __forceinline__ ArgsP launder(ArgsP p) { asm volatile("" : "+s"(p)); return p; }

#define LDS_WAIT() asm volatile("s_waitcnt lgkmcnt(0)" ::: "memory")
__device__ __forceinline__ unsigned f2bf(float f) { unsigned u = __builtin_bit_cast(unsigned, f); return (u + 0x7fffu + ((u >> 16) & 1u)) >> 16; }
__device__ __forceinline__ unsigned pk2(float lo, float hi) { return pg8::cvt_pk_bf16(lo, hi); }
__device__ __forceinline__ float bflo(unsigned u) { return __uint_as_float(u << 16); }
__device__ __forceinline__ float bfhi(unsigned u) { return __uint_as_float(u & 0xffff0000u); }
__device__ __forceinline__ float bf1(unsigned short u) { return __uint_as_float(((unsigned)u) << 16); }
__device__ __forceinline__ float sigm(float x) { return 1.f / (1.f + __expf(-x)); }
__device__ __forceinline__ void unpack8(const u32x4 v, float (&o)[8]) { o[0] = bflo(v.x); o[1] = bfhi(v.x); o[2] = bflo(v.y); o[3] = bfhi(v.y); o[4] = bflo(v.z); o[5] = bfhi(v.z); o[6] = bflo(v.w); o[7] = bfhi(v.w); }
__device__ __forceinline__ u32x4 pack8(const float (&o)[8]) { u32x4 r; r.x = pk2(o[0], o[1]); r.y = pk2(o[2], o[3]); r.z = pk2(o[4], o[5]); r.w = pk2(o[6], o[7]); return r; }
__device__ __forceinline__ void load8f(const float* p, float (&o)[8]) { const f32x4 a = *(const f32x4*)p, b = *(const f32x4*)(p + 4); o[0] = a.x; o[1] = a.y; o[2] = a.z; o[3] = a.w; o[4] = b.x; o[5] = b.y; o[6] = b.z; o[7] = b.w; }
__device__ __forceinline__ float wave_sum(float v) {
#pragma unroll
    for (int o = 1; o < 64; o <<= 1) v += __shfl_xor(v, o);
    return v;
}
template <int CTRL> __device__ __forceinline__ float dppf(float x) { return __builtin_bit_cast(float, __builtin_amdgcn_update_dpp(0, __builtin_bit_cast(int, x), CTRL, 0xF, 0xF, true)); }
__device__ __forceinline__ float red4(float x) { x += dppf<0xB1>(x); x += dppf<0x4E>(x); return x; }
__device__ __forceinline__ float red8(float x) { x = red4(x); x += dppf<0x141>(x); return x; }
__device__ __forceinline__ float red16(float x) { x = red8(x); x += dppf<0x140>(x); return x; }

__device__ __forceinline__ void store8(bf16* p, const f32x4 v0, const f32x4 v1) {
    u32x4 w; w.x = pk2(v0[0], v0[1]); w.y = pk2(v0[2], v0[3]); w.z = pk2(v1[0], v1[1]); w.w = pk2(v1[2], v1[3]); *(u32x4*)p = w;
}
struct EpiG1 {
    static constexpr bool PERM = true, AFTER_DRAIN = false;
    bf16 *ZR, *CG, *PL, *LV;
    __device__ __forceinline__ void operator()(const f32x4 (&acc)[2][2][4][2], const Unit& u, int wr, int wc, int fr, int fq) const {
        const int row0 = u.pm * 256 + wr * 64 + fr, pn = u.pn, cin = wc * 32 + 8 * fq;
        if (pn < 7 || (pn >= 11 && pn < 13)) {
            bf16* base = pn < 7 ? ZR : PL; const int ldc = pn < 7 ? 1792 : 512, col0 = (pn < 7 ? pn : pn - 11) * 256 + cin;
#pragma unroll
            for (int ai = 0; ai < 2; ++ai)
#pragma unroll
                for (int m = 0; m < 4; ++m) { bf16* rp = base + (size_t)(row0 + ai * 128 + m * 16) * ldc + col0;
#pragma unroll
                    for (int bj = 0; bj < 2; ++bj) store8(rp + bj * 128, acc[ai][bj][m][0], acc[ai][bj][m][1]); }
        } else if (pn < 11) {
            const int col0 = (pn - 7) * 128 + cin;
#pragma unroll
            for (int ai = 0; ai < 2; ++ai)
#pragma unroll
                for (int m = 0; m < 4; ++m) { f32x4 h0, h1;
#pragma unroll
                    for (int i = 0; i < 4; ++i) { h0[i] = acc[ai][0][m][0][i] * sigm(acc[ai][1][m][0][i]); h1[i] = acc[ai][0][m][1][i] * sigm(acc[ai][1][m][1][i]); }
                    store8(CG + (size_t)(row0 + ai * 128 + m * 16) * 512 + col0, h0, h1); }
        } else {
            if (wc == 0) {
#pragma unroll
                for (int ai = 0; ai < 2; ++ai)
#pragma unroll
                    for (int m = 0; m < 4; ++m) store8(LV + (size_t)(row0 + ai * 128 + m * 16) * 32 + 8 * fq, acc[ai][0][m][0], acc[ai][0][m][1]);
            }
        }
    }
};
struct EpiLora {
    static constexpr bool PERM = true, AFTER_DRAIN = false;
    bf16* O; int ldc; const float *w0, *a0, *v0;
    __device__ __forceinline__ void operator()(const f32x4 (&acc)[2][2][4][2], const Unit& u, int wr, int wc, int fr, int fq) const {
        const int row0 = u.pm * 256 + wr * 64 + fr, type = u.pn >> 1, cin = wc * 32 + 8 * fq;
#pragma unroll
        for (int bj = 0; bj < 2; ++bj) {
            const int cb = u.pn * 256 + bj * 128 + cin, pc = cb & 511;
            f32x4 p0 = (f32x4){0.f, 0.f, 0.f, 0.f}, p1 = p0;
            if (type == 0) { p0 = *(const f32x4*)(w0 + pc); p1 = *(const f32x4*)(w0 + pc + 4); }
            else if (type == 1) { p0 = *(const f32x4*)(a0 + pc); p1 = *(const f32x4*)(a0 + pc + 4); }
            else if (type == 3) { p0 = *(const f32x4*)(v0 + pc); p1 = *(const f32x4*)(v0 + pc + 4); }
#pragma unroll
            for (int ai = 0; ai < 2; ++ai)
#pragma unroll
                for (int m = 0; m < 4; ++m) { f32x4 v0_ = acc[ai][bj][m][0] + p0, v1_ = acc[ai][bj][m][1] + p1;
                    if (type != 2) {
                        const float sc = type == 0 ? 0.60653065971f : 1.f;
#pragma unroll
                        for (int i = 0; i < 4; ++i) { v0_[i] = sc * sigm(v0_[i]); v1_[i] = sc * sigm(v1_[i]); } }
                    store8(O + (size_t)(row0 + ai * 128 + m * 16) * ldc + cb, v0_, v1_); }
        }
    }
};
template <int MODE  > struct EpiBf {
    static constexpr bool PERM = true, AFTER_DRAIN = false;
    bf16* O; int ldc;
    __device__ __forceinline__ void operator()(const f32x4 (&acc)[2][2][4][2], const Unit& u, int wr, int wc, int fr, int fq) const {
        const int row0 = u.pm * 256 + wr * 64 + fr, col0 = u.pn * 256 + wc * 32 + 8 * fq;
#pragma unroll
        for (int ai = 0; ai < 2; ++ai)
#pragma unroll
            for (int m = 0; m < 4; ++m) { bf16* rp = O + (size_t)(row0 + ai * 128 + m * 16) * ldc + col0;
#pragma unroll
                for (int bj = 0; bj < 2; ++bj) { f32x4 v0 = acc[ai][bj][m][0], v1 = acc[ai][bj][m][1];
                    if (MODE == 1) {
#pragma unroll
                        for (int i = 0; i < 4; ++i) { const float a = fmaxf(v0[i], 0.f), b = fmaxf(v1[i], 0.f); v0[i] = a * a; v1[i] = b * b; } }
                    if (MODE == 2) { float p[8]; unpack8(*(const u32x4*)(rp + bj * 128), p);
#pragma unroll
                        for (int i = 0; i < 4; ++i) { v0[i] = sigm(v0[i]) * p[i]; v1[i] = sigm(v1[i]) * p[4 + i]; } }
                    store8(rp + bj * 128, v0, v1); } }
    }
};
struct EpiRes {
    static constexpr bool PERM = false, AFTER_DRAIN = false;
    const float* xin; float* out; const float* gt;
    __device__ __forceinline__ void operator()(const f32x4 (&acc)[2][2][4][2], const Unit& u, int wr, int wc, int fr, int fq) const {
        const float* gtb = gt + (size_t)(u.pm >> 5) * 6144; const int col0 = u.pn * 256 + wc * 32 + 4 * fq;
        f32x4 g4[2][2];
#pragma unroll
        for (int bj = 0; bj < 2; ++bj)
#pragma unroll
            for (int n = 0; n < 2; ++n) g4[bj][n] = *(const f32x4*)(gtb + col0 + bj * 128 + n * 16);
#pragma unroll
        for (int ai = 0; ai < 2; ++ai)
#pragma unroll
            for (int m = 0; m < 4; ++m) { const size_t off = (size_t)(u.pm * 256 + ai * 128 + wr * 64 + m * 16 + fr) * 1024 + col0;
#pragma unroll
                for (int bj = 0; bj < 2; ++bj)
#pragma unroll
                    for (int n = 0; n < 2; ++n) { const f32x4 x4 = *(const f32x4*)(xin + off + bj * 128 + n * 16);
                        *(f32x4*)(out + off + bj * 128 + n * 16) = x4 * ALPHA + g4[bj][n] * acc[ai][bj][m][n]; } }
    }
};

__device__ __forceinline__ void tr_item(const float* W, int N, int k0, int n0, bf16* dst, int K, LAS float* scr, int lane) {
#pragma unroll 8
    for (int i = 0; i < 32; ++i) { const int kk = 2 * i + (lane >> 5); scr[kk * 33 + (lane & 31)] = W[(size_t)(k0 + kk) * N + n0 + (lane & 31)]; }
    LDS_WAIT(); asm volatile("" ::: "memory");
    const int c = lane & 7;
#pragma unroll
    for (int j = 0; j < 4; ++j) { const int n = (lane >> 3) + 8 * j; const LAS float* s = scr + (8 * c) * 33 + n;
        u32x4 o; o.x = pk2(s[0 * 33], s[1 * 33]); o.y = pk2(s[2 * 33], s[3 * 33]); o.z = pk2(s[4 * 33], s[5 * 33]); o.w = pk2(s[6 * 33], s[7 * 33]);
        *(u32x4*)(dst + (size_t)n * K + 8 * c) = o; }
    LDS_WAIT(); asm volatile("" ::: "memory");
}
__device__ __forceinline__ bf16* win_dst(unsigned char* ws, int l, int n0) {
    bf16* wina = (bf16*)(ws + (l ? WS_WINA1 : WS_WINA0)); bf16* wg = (bf16*)(ws + (l ? WS_WG1 : WS_WG0));
    if (n0 < 1792) return wina + (size_t)n0 * 1024;
    if (n0 < 2816) { const int c = n0 - 1792, half = c >> 9, cc = c & 511, j = cc >> 7, i = cc & 127; return wina + (size_t)(1792 + j * 256 + half * 128 + i) * 1024; }
    if (n0 < 3328) return wina + (size_t)n0 * 1024;
    return wg + (size_t)(n0 - 3328) * 1024;
}
__device__ __forceinline__ void p0_phase(ArgsP a_, LAS unsigned char* lds) {
    const ArgsP a = launder(a_);
    const int tid = opq_tid(), lane = tid & 63, wave = tid >> 6, G = opq_gdim();
    const int gw = opq_bid() * 8 + wave, NGW = G * 8, gt = opq_bid() * 512 + tid, NT = G * 512;
    unsigned char* ws = a->ws;
    LAS float* scr = (LAS float*)(lds + wave * 8448);
    for (int it = gw; it < 16656; it += NGW) {
        int r = it;
        if (r >= 16640) { const int kb = r - 16640; tr_item(a->in[5], 32, 64 * kb, 0, (bf16*)(ws + WS_WINA1) + (size_t)3328 * 1024 + 64 * kb, 1024, scr, lane); continue; }
        const int l = r >= 8320 ? 1 : 0; r -= l * 8320;
        if (r < 3200) { const int kb = r / 200, nb = r % 200; tr_item(a->in[4] + (size_t)l * 1024 * 6400, 6400, 64 * kb, 32 * nb, win_dst(ws, l, 32 * nb) + 64 * kb, 1024, scr, lane); continue; } r -= 3200;
        bf16* wbr = (bf16*)(ws + (l ? WS_WBR1 : WS_WBR0));
        if (r < 256) { const int kb = r >> 5, nb = r & 31; tr_item(a->in[20] + (size_t)l * 512 * 1024, 1024, 64 * kb, 32 * nb, wbr + (size_t)(32 * nb) * 512 + 64 * kb, 512, scr, lane); continue; } r -= 256;
        if (r < 256) { const int kb = r >> 5, nb = r & 31; tr_item(a->in[25] + (size_t)l * 512 * 1024, 1024, 64 * kb, 32 * nb, wbr + (size_t)(1024 + 32 * nb) * 512 + 64 * kb, 512, scr, lane); continue; } r -= 256;
        if (r < 512) { const int kb = r >> 5, nb = r & 31; tr_item(a->in[29] + (size_t)l * 1024 * 1024, 1024, 64 * kb, 32 * nb, (bf16*)(ws + (l ? WS_WOUT1 : WS_WOUT0)) + (size_t)(32 * nb) * 1024 + 64 * kb, 1024, scr, lane); continue; } r -= 512;
        if (r < 2048) { const int kb = r >> 7, nb = r & 127; tr_item(a->in[32] + (size_t)l * 1024 * 4096, 4096, 64 * kb, 32 * nb, (bf16*)(ws + (l ? WS_W1_1 : WS_W1_0)) + (size_t)(32 * nb) * 1024 + 64 * kb, 1024, scr, lane); continue; } r -= 2048;
        { const int kb = r >> 5, nb = r & 31; tr_item(a->in[33] + (size_t)l * 4096 * 1024, 1024, 64 * kb, 32 * nb, (bf16*)(ws + (l ? WS_W2_1 : WS_W2_0)) + (size_t)(32 * nb) * 4096 + 64 * kb, 4096, scr, lane); }
    }
    { u32x4* z = (u32x4*)((bf16*)(ws + WS_WINA1) + (size_t)3360 * 1024); for (int i = gt; i < 28672; i += NT) z[i] = (u32x4){0u, 0u, 0u, 0u}; }
    { bf16* w = (bf16*)(ws + WS_WLORA0);
      for (int i = gt; i < 1536 * 256; i += NT) { const int n = i >> 8, k = i & 255; float v = 0.f;
          if (n < 512) { if (k < 64) v = a->in[9][k * 512 + n]; }
          else if (n < 1024) { if (k >= 64 && k < 128) v = a->in[11][(k - 64) * 512 + n - 512]; }
          else { if (k >= 128) v = a->in[12][(k - 128) * 512 + n - 1024]; }
          w[i] = (bf16)f2bf(v); } }
    { bf16* w = (bf16*)(ws + WS_WLORA1);
      for (int i = gt; i < 2048 * 384; i += NT) { const int n = i / 384, k = i % 384; float v = 0.f;
          if (n < 512) { if (k < 64) v = a->in[9][64 * 512 + k * 512 + n]; }
          else if (n < 1024) { if (k >= 64 && k < 128) v = a->in[11][64 * 512 + (k - 64) * 512 + n - 512]; }
          else if (n < 1536) { if (k >= 128 && k < 256) v = a->in[12][128 * 512 + (k - 128) * 512 + n - 1024]; }
          else { if (k >= 256 && k < 288) v = a->in[14][(k - 256) * 512 + n - 1536]; }
          w[i] = (bf16)f2bf(v); } }
    for (int idx = gt; idx < 131072; idx += NT) {
        const int n = idx & 1023, cg8 = (idx >> 10) & 63, l = idx >> 16, g = cg8 >> 4, c0 = (cg8 & 15) * 8;
        const float* plw = a->in[26] + ((size_t)(l * 4 + g) * 128 + c0) * 128; const float* pls = a->in[27] + l * 512 + g * 128; const float* plo = a->in[28] + ((size_t)l * 512 + g * 128) * 1024 + n;
        float acc[8];
#pragma unroll
        for (int i = 0; i < 8; ++i) acc[i] = 0.f;
        for (int d = 0; d < 128; ++d) { const float bw = plo[(size_t)d * 1024] * pls[d];
#pragma unroll
            for (int i = 0; i < 8; ++i) acc[i] += plw[i * 128 + d] * bw; }
        bf16* wbr = (bf16*)(ws + (l ? WS_WBR1 : WS_WBR0));
        *(u32x4*)(wbr + (size_t)(2048 + n) * 512 + g * 128 + c0) = pack8(acc);
    }
    float* adap = (float*)(ws + WS_ADAP);
    for (int wt = gw; wt < 1536; wt += NGW) {
        const int l = wt / 768, r = wt % 768, cb = r >> 3, kc = r & 7, col = cb * 64 + lane;
#pragma unroll
        for (int i = 0; i < 16; ++i) { const int idx = lane + 64 * i, b = idx >> 7, kk = idx & 127; const float x = a->in[1][b * 1024 + kc * 128 + kk]; scr[idx] = x * sigm(x); }
        LDS_WAIT(); asm volatile("" ::: "memory");
        float acc[8];
#pragma unroll
        for (int b = 0; b < 8; ++b) acc[b] = 0.f;
        const float* wp = a->in[2] + ((size_t)l * 1024 + kc * 128) * 6144 + col;
#pragma unroll 4
        for (int kk = 0; kk < 128; ++kk) { const float w = wp[(size_t)kk * 6144];
#pragma unroll
            for (int b = 0; b < 8; ++b) acc[b] += scr[b * 128 + kk] * w; }
#pragma unroll
        for (int b = 0; b < 8; ++b) adap[((size_t)(l * 8 + kc) * 8 + b) * 6144 + col] = acc[b];
        LDS_WAIT(); asm volatile("" ::: "memory");
    }
}
__device__ __forceinline__ void p0b_phase(ArgsP a_) {
    const ArgsP a = launder(a_);
    const int tid = opq_tid(), lane = tid & 63, wave = tid >> 6, G = opq_gdim();
    const int gw = opq_bid() * 8 + wave, NGW = G * 8, gt = opq_bid() * 512 + tid, NT = G * 512;
    const float* adap = (const float*)(a->ws + WS_ADAP); float* ada = (float*)(a->ws + WS_ADA);
    for (int i = gt; i < 2 * 49152; i += NT) { const int l = i / 49152, r = i % 49152, col = r % 6144; float s = a->in[3][l * 6144 + col];
#pragma unroll
        for (int kc = 0; kc < 8; ++kc) s += adap[(size_t)(l * 8 + kc) * 49152 + r];
        ada[i] = s; }
    bf16* H = (bf16*)(a->ws + WS_H);
    for (int rb = gw; rb < 2048; rb += NGW) {
        const int b = rb >> 8; f32x4 sh[4], sc[4];
#pragma unroll
        for (int j = 0; j < 4; ++j) { const int col = 4 * lane + 256 * j; f32x4 s0 = *(const f32x4*)(a->in[3] + col), s1 = *(const f32x4*)(a->in[3] + 1024 + col);
#pragma unroll
            for (int kc = 0; kc < 8; ++kc) { s0 += *(const f32x4*)(adap + (size_t)kc * 49152 + b * 6144 + col); s1 += *(const f32x4*)(adap + (size_t)kc * 49152 + b * 6144 + 1024 + col); }
            sh[j] = s0; sc[j] = s1 + 1.f; }
        for (int rr = 0; rr < 32; ++rr) { const size_t m = (size_t)rb * 32 + rr;
#pragma unroll
            for (int j = 0; j < 4; ++j) { const int col = 4 * lane + 256 * j; const f32x4 x = *(const f32x4*)(a->in[0] + m * 1024 + col); const f32x4 h = x * sc[j] + sh[j];
                u32x2 w; w.x = pk2(h[0], h[1]); w.y = pk2(h[2], h[3]); *(u32x2*)(H + m * 1024 + col) = w; } }
    }
}
__device__ __forceinline__ void ln_phase(float* X, bf16* H, const float* gam, const float* bet, const float* adash  , const float* adasc, bool writeH) {
    const int tid = opq_tid(), lane = tid & 63, wave = tid >> 6, gw = opq_bid() * 8 + wave, NGW = opq_gdim() * 8;
    for (int rb = gw; rb < 2048; rb += NGW) {
        const int b = rb >> 8; f32x4 g4[4], b4[4], sh[4], sc[4];
#pragma unroll
        for (int j = 0; j < 4; ++j) { const int col = 4 * lane + 256 * j; g4[j] = *(const f32x4*)(gam + col); b4[j] = *(const f32x4*)(bet + col);
            if (writeH) { sh[j] = *(const f32x4*)(adash + b * 6144 + col); sc[j] = *(const f32x4*)(adasc + b * 6144 + col) + 1.f; } else { sh[j] = g4[j]; sc[j] = g4[j]; } }
        for (int rr = 0; rr < 32; ++rr) { const size_t m = (size_t)rb * 32 + rr; f32x4 v[4]; float s = 0.f;
#pragma unroll
            for (int j = 0; j < 4; ++j) { v[j] = *(const f32x4*)(X + m * 1024 + 4 * lane + 256 * j); s += (v[j][0] + v[j][1]) + (v[j][2] + v[j][3]); }
            const float mean = wave_sum(s) * (1.f / 1024.f); float q = 0.f;
#pragma unroll
            for (int j = 0; j < 4; ++j) { v[j] = v[j] - mean; q += (v[j][0] * v[j][0] + v[j][1] * v[j][1]) + (v[j][2] * v[j][2] + v[j][3] * v[j][3]); }
            const float rstd = 1.0f / sqrtf(wave_sum(q) * (1.f / 1024.f) + LN_EPS);
#pragma unroll
            for (int j = 0; j < 4; ++j) { const int col = 4 * lane + 256 * j; const f32x4 y = v[j] * rstd * g4[j] + b4[j]; *(f32x4*)(X + m * 1024 + col) = y;
                if (writeH) { const f32x4 h = y * sc[j] + sh[j]; u32x2 w; w.x = pk2(h[0], h[1]); w.y = pk2(h[2], h[3]); *(u32x2*)(H + m * 1024 + col) = w; } } }
    }
}
__device__ __forceinline__ void prep_phase(ArgsP a_, int l, LAS unsigned char* lds) {
    const ArgsP a = launder(a_);
    const int tid = opq_tid(), lane = tid & 63, wave = tid >> 6, gw = opq_bid() * 8 + wave, NGW = opq_gdim() * 8;
    unsigned char* ar = a->ws + WS_AR;
    const bf16* ZR = (const bf16*)(ar + AR_ZR); const bf16* CG = (const bf16*)(ar + AR_CG); const bf16* PL = (const bf16*)(ar + AR_PL); const bf16* LV = (const bf16*)(ar + AR_LV);
    bf16* LA = (bf16*)(ar + AR_LA); bf16* YCV = (bf16*)(ar + AR_YCV); bf16* POOL = (bf16*)(ar + AR_POOL);
    LAS float* cw = (LAS float*)lds;
    for (int i = tid; i < 31 * 512; i += 512) cw[i] = a->in[21][l * 31 * 512 + i];
    __syncthreads();
    const int c8 = 8 * lane, ldA = l ? 384 : 256;
    float cvb[8], lng[8], lnb[8], mu[8];
    load8f(a->in[22] + l * 512 + c8, cvb); load8f(a->in[23] + l * 512 + c8, lng); load8f(a->in[24] + l * 512 + c8, lnb);
    if (lane < 32) load8f(a->in[6] + l * 1792 + 1536 + c8, mu);
    else if (l && lane < 36) load8f(a->in[7] + 8 * (lane - 32), mu);
    else {
#pragma unroll
        for (int i = 0; i < 8; ++i) mu[i] = 0.f; }
    for (int rb = gw; rb < 2048; rb += NGW)
        for (int rr = 0; rr < 32; ++rr) {
            const size_t m = (size_t)rb * 32 + rr; const int s = (int)(m & 8191);
            if (lane < 32 || (l && lane < 36)) {
                const bf16* src = lane < 32 ? ZR + m * 1792 + 1536 + c8 : LV + m * 32 + 8 * (lane - 32); const int ldp = lane < 32 ? 1792 : 32;
                float zt[8], zp[8]; unpack8(*(const u32x4*)src, zt);
                if (s > 0) unpack8(*(const u32x4*)(src - ldp), zp); else {
#pragma unroll
                    for (int i = 0; i < 8; ++i) zp[i] = 0.f; }
#pragma unroll
                for (int i = 0; i < 8; ++i) { float z = zt[i] + (zp[i] - zt[i]) * mu[i];
                    if (lane < 8) z = 1.f - 2.f / (1.f + __expf(2.f * z)); else if (lane >= 16 && lane < 32) z = sigm(z);
                    zt[i] = z; }
                *(u32x4*)(LA + m * ldA + (lane < 32 ? c8 : 256 + 8 * (lane - 32))) = pack8(zt);
            } else if (l && lane < 48) { *(u32x4*)(LA + m * ldA + c8) = (u32x4){0u, 0u, 0u, 0u}; }
            { float acc[8];
#pragma unroll
              for (int i = 0; i < 8; ++i) acc[i] = cvb[i];
              const int j0 = s >= 30 ? 0 : 30 - s;
              for (int j = j0; j < 31; ++j) { float x[8]; unpack8(*(const u32x4*)(CG + (m - 30 + j) * 512 + c8), x);
                  const f32x4 w0 = *(const LAS f32x4*)(cw + j * 512 + c8), w1 = *(const LAS f32x4*)(cw + j * 512 + c8 + 4);
#pragma unroll
                  for (int i = 0; i < 4; ++i) { acc[i] += x[i] * w0[i]; acc[4 + i] += x[4 + i] * w1[i]; } }
              float s1 = 0.f;
#pragma unroll
              for (int i = 0; i < 8; ++i) s1 += acc[i];
              const float mean = wave_sum(s1) * (1.f / 512.f); float q = 0.f;
#pragma unroll
              for (int i = 0; i < 8; ++i) { acc[i] -= mean; q += acc[i] * acc[i]; }
              const float rstd = 1.0f / sqrtf(wave_sum(q) * (1.f / 512.f) + LN_EPS);
#pragma unroll
              for (int i = 0; i < 8; ++i) { const float y = acc[i] * rstd * lng[i] + lnb[i]; acc[i] = y * sigm(y); }
              *(u32x4*)(YCV + m * 512 + c8) = pack8(acc); }
            { const int win = 2 << (lane >> 4), cnt = (s + 1) < win ? (s + 1) : win; float x0[8], sum[8]; unpack8(*(const u32x4*)(PL + m * 512 + c8), x0);
#pragma unroll
              for (int i = 0; i < 8; ++i) sum[i] = x0[i];
              for (int i = 1; i < 16; ++i) if (i < cnt) { float x[8]; unpack8(*(const u32x4*)(PL + (m - i) * 512 + c8), x);
#pragma unroll
                  for (int q = 0; q < 8; ++q) sum[q] += x[q]; }
              const float inv = 1.f / (float)cnt;
#pragma unroll
              for (int i = 0; i < 8; ++i) sum[i] = sum[i] * inv - x0[i];
              *(u32x4*)(POOL + m * 512 + c8) = pack8(sum); }
        }
    __syncthreads();
}
struct HSet { u32x2 rt[2], kt[2], rp[2], kp[2], ee[2], aa[2]; unsigned short vt[2], vp[2], vm[2], vf[2]; };
constexpr int SC_OPS = 0, SC_VV = 81920, SC_YP = 86016;
__device__ __forceinline__ void sc_load(HSet& S, int c, int l, int b, int h, int rg, int hl, const bf16* ZR, const bf16* LO, int ldlo, const bf16* VF) {
    if (c >= 256) return;
    const int cg = hl & 15, vc = h * 64 + 16 * rg + cg;
#pragma unroll
    for (int p = 0; p < 2; ++p) {
        const int t = (hl >> 4) + 16 * p, s = c * 32 + t; const size_t m = (size_t)b * 8192 + s;
        const bf16* zr = ZR + m * 1792; const bf16* lo = LO + m * ldlo;
        S.rt[p] = *(const u32x2*)(zr + h * 64 + 4 * cg); S.kt[p] = *(const u32x2*)(zr + 512 + h * 64 + 4 * cg); S.vt[p] = zr[1024 + vc];
        if (s > 0) { S.rp[p] = *(const u32x2*)(zr - 1792 + h * 64 + 4 * cg); S.kp[p] = *(const u32x2*)(zr - 1792 + 512 + h * 64 + 4 * cg); S.vp[p] = zr[-1792 + 1024 + vc]; }
        else { S.rp[p] = (u32x2){0u, 0u}; S.kp[p] = (u32x2){0u, 0u}; S.vp[p] = 0; }
        S.ee[p] = *(const u32x2*)(lo + h * 64 + 4 * cg); S.aa[p] = *(const u32x2*)(lo + 512 + h * 64 + 4 * cg);
        if (l) { S.vm[p] = lo[1536 + vc]; S.vf[p] = VF[m * 512 + vc]; } else { S.vm[p] = 0; S.vf[p] = 0; }
    }
}
__device__ __forceinline__ void sc_prep(const HSet& S, int c, int buf, int l, int b, int h, int rg, int hl, LAS unsigned char* lds, bf16* VF,
                                        const f32x4 mur, const f32x4 muk, const f32x4 kkc, const f32x4 kac, const float muv) {
    if (c >= 256) return;
    const int cg = hl & 15, vc = h * 64 + 16 * rg + cg;
#pragma unroll
    for (int p = 0; p < 2; ++p) {
        const int t = (hl >> 4) + 16 * p; const size_t m = (size_t)b * 8192 + c * 32 + t;
        f32x4 rt = {bflo(S.rt[p].x), bfhi(S.rt[p].x), bflo(S.rt[p].y), bfhi(S.rt[p].y)}, rp = {bflo(S.rp[p].x), bfhi(S.rp[p].x), bflo(S.rp[p].y), bfhi(S.rp[p].y)};
        f32x4 kt = {bflo(S.kt[p].x), bfhi(S.kt[p].x), bflo(S.kt[p].y), bfhi(S.kt[p].y)}, kp = {bflo(S.kp[p].x), bfhi(S.kp[p].x), bflo(S.kp[p].y), bfhi(S.kp[p].y)};
        const f32x4 e = {bflo(S.ee[p].x), bfhi(S.ee[p].x), bflo(S.ee[p].y), bfhi(S.ee[p].y)}, av = {bflo(S.aa[p].x), bfhi(S.aa[p].x), bflo(S.aa[p].y), bfhi(S.aa[p].y)};
        const f32x4 r = rt + (rp - rt) * mur, k = kt + (kp - kt) * muk;
        f32x4 w; w[0] = __expf(-e[0]); w[1] = __expf(-e[1]); w[2] = __expf(-e[2]); w[3] = __expf(-e[3]);
        f32x4 kk = k * kkc; const float ss = red16((kk[0] * kk[0] + kk[1] * kk[1]) + (kk[2] * kk[2] + kk[3] * kk[3]));
        kk = kk * (1.0f / fmaxf(sqrtf(ss), 1e-12f));
        const f32x4 kh = k * ((av - 1.f) * kac + 1.f);
        LAS float* o = (LAS float*)(lds + SC_OPS) + (buf * 32 + t) * 320 + 4 * cg;
        *(LAS f32x4*)(o) = w; *(LAS f32x4*)(o + 64) = -kk; *(LAS f32x4*)(o + 128) = kk * av; *(LAS f32x4*)(o + 192) = kh; *(LAS f32x4*)(o + 256) = r;
        const float vt = bf1(S.vt[p]), vp = bf1(S.vp[p]); float v = vt + (vp - vt) * muv;
        if (l) v = v + (bf1(S.vf[p]) - v) * bf1(S.vm[p]); else VF[m * 512 + vc] = (bf16)f2bf(v);
        ((LAS float*)(lds + SC_VV))[(buf * 32 + t) * 16 + cg] = v;
    }
}
__device__ __forceinline__ void sc_yred(int c, int buf, int b, int h, int rg, int hl, LAS unsigned char* lds, bf16* YRW) {
    const int i = hl & 15;
#pragma unroll
    for (int p = 0; p < 2; ++p) { const int t = (hl >> 4) + 16 * p; const size_t m = (size_t)b * 8192 + c * 32 + t;
        const f32x4 q = *(const LAS f32x4*)((LAS float*)(lds + SC_YP) + ((buf * 32 + t) * 16 + i) * 4);
        YRW[m * 512 + h * 64 + 16 * rg + i] = (bf16)f2bf((q[0] + q[1]) + (q[2] + q[3])); }
}
__device__ __forceinline__ void sc_scan(f32x4& st, int buf, int row, int seg, int lane, LAS unsigned char* lds) {
    const LAS float* ops = (const LAS float*)(lds + SC_OPS) + buf * 32 * 320 + 4 * seg;
    const LAS float* vv = (const LAS float*)(lds + SC_VV) + buf * 32 * 16 + row;
    LAS float* yp = (LAS float*)(lds + SC_YP) + (buf * 32 * 16 + row) * 4 + (seg >> 2);
#pragma unroll 4
    for (int t = 0; t < 32; ++t) {
        const f32x4 w = *(const LAS f32x4*)(ops + t * 320), av = *(const LAS f32x4*)(ops + t * 320 + 64), bv = *(const LAS f32x4*)(ops + t * 320 + 128),
                    kv = *(const LAS f32x4*)(ops + t * 320 + 192), rv = *(const LAS f32x4*)(ops + t * 320 + 256);
        const float v = vv[t * 16];
        const float sa = red16((st[0] * av[0] + st[1] * av[1]) + (st[2] * av[2] + st[3] * av[3]));
        st = st * w + bv * sa + kv * v;
        const float q = red4((st[0] * rv[0] + st[1] * rv[1]) + (st[2] * rv[2] + st[3] * rv[3]));
        if ((lane & 3) == 0) yp[t * 64] = q;
    }
}
__device__ __forceinline__ void scan_phase(ArgsP a_, int l, LAS unsigned char* lds) {
    const ArgsP a = launder(a_);
    const int tid = opq_tid(), lane = tid & 63, wave = __builtin_amdgcn_readfirstlane(tid >> 6);
    unsigned char* ar = a->ws + WS_AR;
    const bf16* ZR = (const bf16*)(ar + AR_ZR); const bf16* LO = (const bf16*)(ar + AR_LO); const int ldlo = l ? 2048 : 1536;
    bf16* VF = (bf16*)(a->ws + WS_VFIRST); bf16* YRW = (bf16*)(ar + AR_YRW);
    for (int u = opq_bid(); u < 256; u += opq_gdim()) {
        const int b = u >> 5, h = (u >> 2) & 7, rg = u & 3;
        if (wave < 4) {
            f32x4 st = {0.f, 0.f, 0.f, 0.f}; const int row = 4 * wave + (lane >> 4), seg = lane & 15;
            __syncthreads();
            for (int c = 0; c < 256; c += 2) { sc_scan(st, 0, row, seg, lane, lds); __syncthreads(); sc_scan(st, 1, row, seg, lane, lds); __syncthreads(); }
        } else {
            const int hl = tid - 256, cg = hl & 15, ch = h * 64 + 4 * cg, vc = h * 64 + 16 * rg + cg;
            const f32x4 mur = *(const f32x4*)(a->in[6] + l * 1792 + ch), muk = *(const f32x4*)(a->in[6] + l * 1792 + 512 + ch);
            const f32x4 kkc = *(const f32x4*)(a->in[15] + l * 512 + ch), kac = *(const f32x4*)(a->in[16] + l * 512 + ch);
            const float muv = a->in[6][l * 1792 + 1024 + vc];
            HSet SA, SB;
            sc_load(SA, 0, l, b, h, rg, hl, ZR, LO, ldlo, VF); sc_prep(SA, 0, 0, l, b, h, rg, hl, lds, VF, mur, muk, kkc, kac, muv);
            sc_load(SA, 1, l, b, h, rg, hl, ZR, LO, ldlo, VF); sc_load(SB, 2, l, b, h, rg, hl, ZR, LO, ldlo, VF);
            __syncthreads();
            for (int c = 0; c < 256; c += 2) {
                if (c > 0) sc_yred(c - 1, 1, b, h, rg, hl, lds, YRW);
                sc_prep(SA, c + 1, 1, l, b, h, rg, hl, lds, VF, mur, muk, kkc, kac, muv); sc_load(SA, c + 3, l, b, h, rg, hl, ZR, LO, ldlo, VF);
                __syncthreads();
                sc_yred(c, 0, b, h, rg, hl, lds, YRW);
                sc_prep(SB, c + 2, 0, l, b, h, rg, hl, lds, VF, mur, muk, kkc, kac, muv); sc_load(SB, c + 4, l, b, h, rg, hl, ZR, LO, ldlo, VF);
                __syncthreads();
            }
            sc_yred(255, 1, b, h, rg, hl, lds, YRW);
        }
        __syncthreads();
    }
}
__device__ __forceinline__ void post_phase(ArgsP a_, int l) {
    const ArgsP a = launder(a_);
    const int tid = opq_tid(), lane = tid & 63, wave = tid >> 6, gw = opq_bid() * 8 + wave, NGW = opq_gdim() * 8, c8 = 8 * lane;
    unsigned char* ar = a->ws + WS_AR;
    const bf16* ZR = (const bf16*)(ar + AR_ZR); const bf16* LO = (const bf16*)(ar + AR_LO); const int ldlo = l ? 2048 : 1536;
    const bf16* VF = (const bf16*)(a->ws + WS_VFIRST); bf16* YRW = (bf16*)(ar + AR_YRW);
    float mur[8], muk[8], muv[8], ka[8], rk[8], gng[8], gnb[8];
    load8f(a->in[6] + l * 1792 + c8, mur); load8f(a->in[6] + l * 1792 + 512 + c8, muk); load8f(a->in[6] + l * 1792 + 1024 + c8, muv);
    load8f(a->in[16] + l * 512 + c8, ka); load8f(a->in[17] + l * 512 + c8, rk); load8f(a->in[18] + l * 512 + c8, gng); load8f(a->in[19] + l * 512 + c8, gnb);
    for (int rb = gw; rb < 2048; rb += NGW)
        for (int rr = 0; rr < 32; ++rr) {
            const size_t m = (size_t)rb * 32 + rr; const int s = (int)(m & 8191);
            const bf16* zr = ZR + m * 1792 + c8; const bf16* lo = LO + m * ldlo + c8;
            float y[8], rt[8], kt[8], vt[8], rp[8], kp[8], vp[8], av[8], g[8];
            unpack8(*(const u32x4*)(YRW + m * 512 + c8), y);
            unpack8(*(const u32x4*)zr, rt); unpack8(*(const u32x4*)(zr + 512), kt); unpack8(*(const u32x4*)(zr + 1024), vt);
            if (s > 0) { unpack8(*(const u32x4*)(zr - 1792), rp); unpack8(*(const u32x4*)(zr - 1792 + 512), kp); unpack8(*(const u32x4*)(zr - 1792 + 1024), vp); }
            else {
#pragma unroll
                for (int i = 0; i < 8; ++i) { rp[i] = 0.f; kp[i] = 0.f; vp[i] = 0.f; } }
            unpack8(*(const u32x4*)(lo + 512), av); unpack8(*(const u32x4*)(lo + 1024), g);
            float bon = 0.f, sy = 0.f;
#pragma unroll
            for (int i = 0; i < 8; ++i) { const float r = rt[i] + (rp[i] - rt[i]) * mur[i], k = kt[i] + (kp[i] - kt[i]) * muk[i]; vt[i] = vt[i] + (vp[i] - vt[i]) * muv[i];
                bon += r * (k * (1.f + (av[i] - 1.f) * ka[i])) * rk[i]; sy += y[i]; }
            if (l) { float vm[8], vf[8]; unpack8(*(const u32x4*)(lo + 1536), vm); unpack8(*(const u32x4*)(VF + m * 512 + c8), vf);
#pragma unroll
                for (int i = 0; i < 8; ++i) vt[i] = vt[i] + (vf[i] - vt[i]) * vm[i]; }
            bon = red8(bon); const float mean = red8(sy) * (1.f / 64.f); float q = 0.f;
#pragma unroll
            for (int i = 0; i < 8; ++i) { y[i] -= mean; q += y[i] * y[i]; }
            const float rstd = 1.0f / sqrtf(red8(q) * (1.f / 64.f) + GN_EPS);
#pragma unroll
            for (int i = 0; i < 8; ++i) y[i] = (y[i] * rstd * gng[i] + gnb[i] + bon * vt[i]) * g[i];
            *(u32x4*)(YRW + m * 512 + c8) = pack8(y);
        }
}
__device__ __forceinline__ void combine_phase(ArgsP a_) {
    const ArgsP a = launder(a_);
    const int gt = opq_bid() * 512 + opq_tid(), NT = opq_gdim() * 512;
    const bf16* P = (const bf16*)(a->ws + WS_AR + AR_P); bf16* Hm = (bf16*)(a->ws + WS_H);
    for (int i = gt; i < M * 128; i += NT) { const size_t m = (size_t)(i >> 7); const int c8 = (i & 127) * 8; float p0[8], p1[8], p2[8];
        unpack8(*(const u32x4*)(P + m * 3072 + c8), p0); unpack8(*(const u32x4*)(P + m * 3072 + 1024 + c8), p1); unpack8(*(const u32x4*)(P + m * 3072 + 2048 + c8), p2);
#pragma unroll
        for (int q = 0; q < 8; ++q) p0[q] = (p0[q] + p1[q]) + p2[q];
        *(u32x4*)(Hm + m * 1024 + c8) = pack8(p0); }
}

#ifndef PHM
#define PHM 0x7fff
#endif
__global__ void __launch_bounds__(512, 2) fwd_kernel(Args kargs) {
    extern __shared__ __attribute__((aligned(16))) unsigned char lds_raw[];
    LAS unsigned char* lds = (LAS unsigned char*)lds_raw;
    cg::grid_group grid = cg::this_grid();
    const ArgsP ak = (ArgsP)__builtin_amdgcn_kernarg_segment_ptr();

    if (PHM & 1) p0_phase(ak, lds); grid.sync();
    if (PHM & 2) p0b_phase(ak); grid.sync();
#pragma unroll 1
    for (int l = 0; l < 2; ++l) {
        if (PHM & 4) { const ArgsP a = launder(ak); const int G = opq_gdim(), bx = opq_bid(); unsigned char* ws = a->ws; unsigned char* ar = ws + WS_AR; bf16* H = (bf16*)(ws + WS_H); const float* adal = (const float*)(ws + WS_ADA) + l * 49152; (void)ar; (void)H; (void)adal;
          pg8::Gemm g{H, nullptr, nullptr, 0, (const bf16*)(ws + (l ? WS_WINA1 : WS_WINA0)), M, l ? 3584 : 3328, 1024};
          pg8::StaticOrder S; S.init(M, g.N, G, bx);
          EpiG1 E{(bf16*)(ar + AR_ZR), (bf16*)(ar + AR_CG), (bf16*)(ar + AR_PL), (bf16*)(ar + AR_LV)};
          pg8::gemm_phase<EpiG1, pg8::StaticOrder, true, true>(lds, g, S, E); }
        grid.sync();
        if (PHM & 8) prep_phase(ak, l, lds); grid.sync();
        if (PHM & 16) { const ArgsP a = launder(ak); const int G = opq_gdim(), bx = opq_bid(); unsigned char* ws = a->ws; unsigned char* ar = ws + WS_AR; bf16* H = (bf16*)(ws + WS_H); const float* adal = (const float*)(ws + WS_ADA) + l * 49152; (void)ar; (void)H; (void)adal;
          pg8::Gemm g{(const bf16*)(ar + AR_LA), nullptr, nullptr, 0, (const bf16*)(ws + (l ? WS_WLORA1 : WS_WLORA0)), M, l ? 2048 : 1536, l ? 384 : 256};
          pg8::StaticOrder S; S.init(M, g.N, G, bx);
          EpiLora E{(bf16*)(ar + AR_LO), l ? 2048 : 1536, a->in[8] + l * 512, a->in[10] + l * 512, a->in[13]};
          pg8::gemm_phase<EpiLora, pg8::StaticOrder, true, true>(lds, g, S, E); }
        grid.sync();
        if (PHM & 32) scan_phase(ak, l, lds); grid.sync();
        if (PHM & 64) post_phase(ak, l); grid.sync();
        if (PHM & 128) { const ArgsP a = launder(ak); const int G = opq_gdim(), bx = opq_bid(); unsigned char* ws = a->ws; unsigned char* ar = ws + WS_AR; bf16* H = (bf16*)(ws + WS_H); const float* adal = (const float*)(ws + WS_ADA) + l * 49152; (void)ar; (void)H; (void)adal;
          pg8::Gemm g{(const bf16*)(ar + AR_YRW), (const bf16*)(ar + AR_YCV), (const bf16*)(ar + AR_POOL), 4, (const bf16*)(ws + (l ? WS_WBR1 : WS_WBR0)), M, 3072, 512};
          pg8::StaticOrder S; S.init(M, g.N, G, bx);
          EpiBf<0> E{(bf16*)(ar + AR_P), 3072};
          pg8::gemm_phase<EpiBf<0>, pg8::StaticOrder, true, true>(lds, g, S, E); }
        grid.sync();
        if (PHM & 256) { const ArgsP a = launder(ak); const int G = opq_gdim(), bx = opq_bid(); unsigned char* ws = a->ws; unsigned char* ar = ws + WS_AR; bf16* H = (bf16*)(ws + WS_H); const float* adal = (const float*)(ws + WS_ADA) + l * 49152; (void)ar; (void)H; (void)adal;
          pg8::Gemm g{H, nullptr, nullptr, 0, (const bf16*)(ws + (l ? WS_WG1 : WS_WG0)), M, 3072, 1024};
          pg8::StaticOrder S; S.init(M, g.N, G, bx);
          EpiBf<2> E{(bf16*)(ar + AR_P), 3072};
          pg8::gemm_phase<EpiBf<2>, pg8::StaticOrder, true, true>(lds, g, S, E); }
        grid.sync();
        if (PHM & 512) combine_phase(ak); grid.sync();
        if (PHM & 1024) { const ArgsP a = launder(ak); const int G = opq_gdim(), bx = opq_bid(); unsigned char* ws = a->ws; unsigned char* ar = ws + WS_AR; bf16* H = (bf16*)(ws + WS_H); const float* adal = (const float*)(ws + WS_ADA) + l * 49152; (void)ar; (void)H; (void)adal;
          pg8::Gemm g{H, nullptr, nullptr, 0, (const bf16*)(ws + (l ? WS_WOUT1 : WS_WOUT0)), M, 1024, 1024};
          pg8::StaticOrder S; S.init(M, g.N, G, bx);
          EpiRes E{l ? (const float*)a->out : a->in[0], a->out, adal + 2 * 1024};
          pg8::gemm_phase<EpiRes, pg8::StaticOrder, true, true>(lds, g, S, E); }
        grid.sync();
        if (PHM & 2048) { const ArgsP a = launder(ak); const float* adal = (const float*)(a->ws + WS_ADA) + l * 49152;
          ln_phase(a->out, (bf16*)(a->ws + WS_H), a->in[30] + l * 1024, a->in[31] + l * 1024, adal + 3 * 1024, adal + 4 * 1024, true); }
        grid.sync();
        if (PHM & 4096) { const ArgsP a = launder(ak); const int G = opq_gdim(), bx = opq_bid(); unsigned char* ws = a->ws; unsigned char* ar = ws + WS_AR; bf16* H = (bf16*)(ws + WS_H); const float* adal = (const float*)(ws + WS_ADA) + l * 49152; (void)ar; (void)H; (void)adal;
          pg8::Gemm g{H, nullptr, nullptr, 0, (const bf16*)(ws + (l ? WS_W1_1 : WS_W1_0)), M, 4096, 1024};
          pg8::StaticOrder S; S.init(M, g.N, G, bx);
          EpiBf<1> E{(bf16*)(ar + AR_HID), 4096};
          pg8::gemm_phase<EpiBf<1>, pg8::StaticOrder, true, true>(lds, g, S, E); }
        grid.sync();
        if (PHM & 8192) { const ArgsP a = launder(ak); const int G = opq_gdim(), bx = opq_bid(); unsigned char* ws = a->ws; unsigned char* ar = ws + WS_AR; bf16* H = (bf16*)(ws + WS_H); const float* adal = (const float*)(ws + WS_ADA) + l * 49152; (void)ar; (void)H; (void)adal;
          pg8::Gemm g{(const bf16*)(ar + AR_HID), nullptr, nullptr, 0, (const bf16*)(ws + (l ? WS_W2_1 : WS_W2_0)), M, 1024, 4096};
          pg8::StaticOrder S; S.init(M, g.N, G, bx);
          EpiRes E{a->out, a->out, adal + 5 * 1024};
          pg8::gemm_phase<EpiRes, pg8::StaticOrder, true, true>(lds, g, S, E); }
        grid.sync();
        if (PHM & 16384) { const ArgsP a = launder(ak); const float* ada1 = (const float*)(a->ws + WS_ADA) + 49152;
          ln_phase(a->out, (bf16*)(a->ws + WS_H), a->in[34] + l * 1024, a->in[35] + l * 1024, ada1, ada1 + 1024, l == 0); }
        if (l == 0) grid.sync();
    }
}

extern "C" void kernel_launch(void* const* d_in, const int* in_sizes, int n_in, void* d_out, int out_size, void* d_ws, size_t ws_size, hipStream_t stream) {
    static int grid = 0;
    if (grid == 0) {
        if (n_in != 36 || out_size != M * D || ws_size < WS_END) { fprintf(stderr, "kernel_launch: unexpected shapes (n_in %d, out %d, ws %zu)\n", n_in, out_size, ws_size); grid = -1; return; }
        int dev = 0, cus = 0, per_cu = 0;
        hipGetDevice(&dev); hipDeviceGetAttribute(&cus, hipDeviceAttributeMultiprocessorCount, dev);
        hipFuncSetAttribute((const void*)fwd_kernel, hipFuncAttributeMaxDynamicSharedMemorySize, LDS_BYTES);
        hipOccupancyMaxActiveBlocksPerMultiprocessor(&per_cu, (const void*)fwd_kernel, 512, LDS_BYTES);
        (void)hipGetLastError();
        if (per_cu < 1) per_cu = 1;
        grid = cus;
        if (grid > 256) grid = 256;
    }
    if (grid < 0) return;
    Args ha{};
    for (int i = 0; i < 36; ++i) ha.in[i] = (const float*)d_in[i];
    ha.out = (float*)d_out; ha.ws = (unsigned char*)d_ws;
    void* params[] = {&ha};
    hipError_t e = hipLaunchCooperativeKernel((const void*)fwd_kernel, dim3(grid), dim3(512), params, LDS_BYTES, stream);
    if (e != hipSuccess) fprintf(stderr, "cooperative launch failed: %s (grid %d)\n", hipGetErrorString(e), grid);
}
```

```cpp
#include <hip/hip_runtime.h>
#include <hip/hip_cooperative_groups.h>
#include <cstdio>
#include <cstdint>
namespace cg = cooperative_groups;
__device__ __forceinline__ int opq_tid() { int t = threadIdx.x; asm volatile("" : "+v"(t)); return t; }
__device__ __forceinline__ int opq_bid() { int t = blockIdx.x; asm volatile("" : "+s"(t)); return t; }
__device__ __forceinline__ int opq_gdim() { int t = gridDim.x; asm volatile("" : "+s"(t)); return t; }
namespace pg8 {
#define PG8_LAS __attribute__((address_space(3)))
typedef unsigned short bf16_t;
typedef short bf16x8 __attribute__((ext_vector_type(8)));
typedef float f32x4 __attribute__((ext_vector_type(4)));
typedef unsigned u32x4 __attribute__((ext_vector_type(4)));
constexpr int BM = 256, BK = 64, HALF = 128, HTB = HALF * BK * 2  , STAGE_BYTES = 8 * HTB, NXCD = 8, WGM = 8;

__host__ __device__ __forceinline__ int lds_byte(int r, int c) { const int st = (r >> 4) * 2 + (c >> 5), rr = r & 15, cc = c & 31, ob = rr * 64 + cc * 2; return st * 1024 + (ob ^ (((ob >> 9) & 1) << 5)); }
__host__ __device__ __forceinline__ void stage_rc(int b, int& R, int& C) { const int st = b / 1024, sb = b % 1024, swz = sb ^ (((sb >> 9) & 1) << 5); R = (st >> 1) * 16 + swz / 64; C = (st & 1) * 32 + (swz % 64) / 2; }
__host__ __device__ __forceinline__ int perm32(int rho) { const int n = rho >> 4, i = rho & 15; return 8 * (i >> 2) + 4 * n + (i & 3); }

struct Unit { int pm, pn; };
struct Gemm { const bf16_t* A; const bf16_t* A1; const bf16_t* A2; int segt; const bf16_t* Bt; int M, N, K;
    __device__ __forceinline__ const bf16_t* a_of(int pn) const { return segt == 0 ? A : (pn < segt ? A : (pn < 2 * segt ? A1 : A2)); } };

struct StaticOrder {
    int nM, nN, nwg, G, c;
    __host__ __device__ void init(int M, int N, int G_, int c_) { nM = M / BM; nN = N / BM; nwg = nM * nN; G = G_; c = c_; }
    __host__ __device__ bool next(int i, Unit& u) const {
        const long L = (long)i * G + c; if (L >= nwg) return false;
        int wgid = (int)L; { const int q = nwg / NXCD, r = nwg % NXCD, xcd = wgid % NXCD, off = wgid / NXCD; wgid = (xcd < r ? xcd * (q + 1) : r * (q + 1) + (xcd - r) * q) + off; }
        const int nig = WGM * nN, gid = wgid / nig, fm = gid * WGM, gsz = (nM - fm) < WGM ? (nM - fm) : WGM;
        u.pm = fm + ((wgid % nig) % gsz); u.pn = (wgid % nig) / gsz; return true;
    }
    __device__ __forceinline__ void a_ready(const Unit&) const {}
    __device__ __forceinline__ void done(const Unit&) const {}
};
__device__ __forceinline__ unsigned cvt_pk_bf16(float lo, float hi) { unsigned r; asm volatile("v_cvt_pk_bf16_f32 %0, %1, %2" : "=v"(r) : "v"(lo), "v"(hi)); return r; }
template <class Epi, class Sched, bool ALIGN_EPI = false, bool SP2 = false>
__device__ __forceinline__ void gemm_phase(PG8_LAS unsigned char* lds, const Gemm g, const Sched& S, const Epi& E) {
    const int tid = opq_tid(), wid = __builtin_amdgcn_readfirstlane(tid >> 6), lane = tid & 63, wr = wid >> 2, wc = wid & 3, fr = lane & 15, fq = lane >> 4;
    const int K = g.K, nt = K / BK;
    unsigned voffA[2], voffB[2];
#pragma unroll
    for (int i = 0; i < 2; ++i) { int R, C; stage_rc(tid * 16 + i * 8192, R, C); const int Rb = Epi::PERM ? ((R & ~31) + perm32(R & 31)) : R;
        voffA[i] = (unsigned)(R * K + C) * 2u; voffB[i] = (unsigned)(Rb * K + C) * 2u; }
    const size_t kstep = (size_t)(BK * 2);
    const size_t hstep = (size_t)HALF * K * 2;
    const size_t tstep = 2 * hstep;
    const unsigned ldsw = (unsigned)wid * 1024u;
    const int aoff = lds_byte(wr * 64 + fr, fq * 8), boff = lds_byte(wc * 32 + fr, fq * 8);
#define PG8_SA(b, h) (((b) * 2 + (h)) * HTB)
#define PG8_SB(b, h) ((4 + (b) * 2 + (h)) * HTB)
#define PG8_STAGE(bufoff, gbase, voff) do { _Pragma("unroll") for (int _i = 0; _i < 2; ++_i) \
        __builtin_amdgcn_global_load_lds((const unsigned*)((const char*)(gbase) + (voff)[_i]), (PG8_LAS unsigned*)(lds + (bufoff) + ldsw + _i * 8192), 16, 0, 0); } while (0)
#define PG8_LDA(dst, b, h) do { _Pragma("unroll") for (int m = 0; m < 4; ++m) _Pragma("unroll") for (int k = 0; k < 2; ++k) dst[m][k] = *(const PG8_LAS bf16x8*)(lds + PG8_SA(b, h) + aoff + m * 2048 + k * 1024); } while (0)
#define PG8_LDB(dst, b, h) do { _Pragma("unroll") for (int n = 0; n < 2; ++n) _Pragma("unroll") for (int k = 0; k < 2; ++k) dst[n][k] = *(const PG8_LAS bf16x8*)(lds + PG8_SB(b, h) + boff + n * 2048 + k * 1024); } while (0)
#define PG8_MMA(ai, bj, At, Bt) do { __builtin_amdgcn_s_setprio(1); _Pragma("unroll") for (int m = 0; m < 4; ++m) _Pragma("unroll") for (int n = 0; n < 2; ++n) _Pragma("unroll") for (int k = 0; k < 2; ++k) \
        acc[ai][bj][m][n] = __builtin_amdgcn_mfma_f32_16x16x32_bf16(Bt[n][k], At[m][k], acc[ai][bj][m][n], 0, 0, 0); __builtin_amdgcn_s_setprio(0); } while (0)
#define PG8_WAIT_V(n) asm volatile("s_waitcnt vmcnt(" #n ")" ::: "memory")
#define PG8_WAIT_L(n) asm volatile("s_waitcnt lgkmcnt(" #n ")" ::: "memory")
#define PG8_BAR __builtin_amdgcn_s_barrier()
#define PG8_SCHED __builtin_amdgcn_sched_barrier(0)
    Unit cur, nxt; int ui = 0;
    if (!S.next(0, cur)) return;
    f32x4 acc[2][2][4][2];
#pragma unroll
    for (int a = 0; a < 2; ++a)
#pragma unroll
        for (int b = 0; b < 2; ++b)
#pragma unroll
            for (int m = 0; m < 4; ++m)
#pragma unroll
                for (int n = 0; n < 2; ++n) acc[a][b][m][n] = (f32x4){0.f, 0.f, 0.f, 0.f};
    bf16x8 At[4][2], B0[2][2], B1[2][2];
    const char* cA = (const char*)g.a_of(cur.pn) + (size_t)cur.pm * tstep; const char* cB = (const char*)g.Bt + (size_t)cur.pn * tstep;
    S.a_ready(cur);
    if constexpr (SP2) {
        PG8_STAGE(PG8_SB(0, 0), cB, voffB); PG8_STAGE(PG8_SB(0, 1), cB + hstep, voffB); PG8_STAGE(PG8_SA(0, 0), cA, voffA); PG8_STAGE(PG8_SA(0, 1), cA + hstep, voffA);
        if (wr == 1) PG8_BAR;
        PG8_WAIT_V(2); PG8_BAR;
        PG8_STAGE(PG8_SB(1, 0), cB + kstep, voffB); PG8_STAGE(PG8_SA(1, 0), cA + kstep, voffA); PG8_STAGE(PG8_SB(1, 1), cB + hstep + kstep, voffB);
        PG8_WAIT_V(6); PG8_BAR;
    } else {
        PG8_STAGE(PG8_SB(0, 0), cB, voffB); PG8_STAGE(PG8_SA(0, 0), cA, voffA); PG8_STAGE(PG8_SB(0, 1), cB + hstep, voffB); PG8_STAGE(PG8_SA(0, 1), cA + hstep, voffA);
        if (wr == 1) PG8_BAR;
        PG8_WAIT_V(4); PG8_BAR;
        PG8_STAGE(PG8_SB(1, 0), cB + kstep, voffB); PG8_STAGE(PG8_SA(1, 0), cA + kstep, voffA); PG8_STAGE(PG8_SB(1, 1), cB + hstep + kstep, voffB);
        PG8_WAIT_V(6); PG8_BAR;
    }
    for (;;) {
        const bool has_next = S.next(ui + 1, nxt);
        const char* nA = has_next ? (const char*)g.a_of(nxt.pn) + (size_t)nxt.pm * tstep : cA; const char* nB = has_next ? (const char*)g.Bt + (size_t)nxt.pn * tstep : cB;
        for (int t = 0; t < nt; t += 2) {
            const bool last = (t == nt - 2);
            const char* a1 = cA + (size_t)(t + 1) * kstep;
            const char* a2 = last ? nA : cA + (size_t)(t + 2) * kstep; const char* b2 = last ? nB : cB + (size_t)(t + 2) * kstep;
            const char* a3 = a2 + kstep; const char* b3 = b2 + kstep;
            if (last && has_next) S.a_ready(nxt);
            if constexpr (SP2) {
            PG8_LDB(B0, 0, 0); PG8_LDB(B1, 0, 1); PG8_SCHED; PG8_LDA(At, 0, 0); PG8_STAGE(PG8_SA(1, 1), a1 + hstep, voffA);
            PG8_WAIT_V(8); PG8_WAIT_L(0); PG8_BAR; PG8_MMA(0, 0, At, B0); PG8_MMA(0, 1, At, B1); PG8_BAR; PG8_SCHED;
            PG8_LDA(At, 0, 1); PG8_STAGE(PG8_SB(0, 0), b2, voffB); PG8_STAGE(PG8_SB(0, 1), b2 + hstep, voffB); PG8_STAGE(PG8_SA(0, 0), a2, voffA);
            PG8_WAIT_V(8); PG8_WAIT_L(0); PG8_BAR; PG8_MMA(1, 0, At, B0); PG8_MMA(1, 1, At, B1); PG8_BAR; PG8_SCHED;
            PG8_LDB(B0, 1, 0); PG8_LDB(B1, 1, 1); PG8_SCHED; PG8_LDA(At, 1, 0); PG8_STAGE(PG8_SA(0, 1), a2 + hstep, voffA);
            PG8_WAIT_V(8); PG8_WAIT_L(0); PG8_BAR; PG8_MMA(0, 0, At, B0); PG8_MMA(0, 1, At, B1); PG8_BAR; PG8_SCHED;
            PG8_LDA(At, 1, 1); PG8_STAGE(PG8_SB(1, 0), b3, voffB); PG8_STAGE(PG8_SB(1, 1), b3 + hstep, voffB); PG8_STAGE(PG8_SA(1, 0), a3, voffA);
            PG8_WAIT_V(8); PG8_WAIT_L(0); PG8_BAR; PG8_MMA(1, 0, At, B0); PG8_MMA(1, 1, At, B1); PG8_BAR; PG8_SCHED;
            } else {
            PG8_LDB(B0, 0, 0); PG8_SCHED; PG8_LDA(At, 0, 0); PG8_STAGE(PG8_SA(1, 1), a1 + hstep, voffA);
            PG8_WAIT_L(8); PG8_BAR; PG8_WAIT_L(0); PG8_MMA(0, 0, At, B0); PG8_BAR; PG8_SCHED;
            PG8_LDB(B1, 0, 1); PG8_STAGE(PG8_SB(0, 0), b2, voffB);
            PG8_BAR; PG8_WAIT_L(0); PG8_MMA(0, 1, At, B1); PG8_BAR;
            PG8_LDA(At, 0, 1); PG8_STAGE(PG8_SA(0, 0), a2, voffA);
            PG8_BAR; PG8_WAIT_L(0); PG8_MMA(1, 0, At, B0); PG8_BAR; PG8_SCHED;
            PG8_STAGE(PG8_SB(0, 1), b2 + hstep, voffB);
            PG8_WAIT_V(6); PG8_BAR; PG8_MMA(1, 1, At, B1); PG8_BAR;
            PG8_LDB(B0, 1, 0); PG8_SCHED; PG8_LDA(At, 1, 0); PG8_STAGE(PG8_SA(0, 1), a2 + hstep, voffA);
            PG8_WAIT_L(8); PG8_BAR; PG8_WAIT_L(0); PG8_MMA(0, 0, At, B0); PG8_BAR; PG8_SCHED;
            PG8_LDB(B1, 1, 1); PG8_STAGE(PG8_SB(1, 0), b3, voffB);
            PG8_BAR; PG8_WAIT_L(0); PG8_MMA(0, 1, At, B1); PG8_BAR;
            PG8_LDA(At, 1, 1); PG8_STAGE(PG8_SA(1, 0), a3, voffA);
            PG8_BAR; PG8_WAIT_L(0); PG8_MMA(1, 0, At, B0); PG8_BAR; PG8_SCHED;
            PG8_STAGE(PG8_SB(1, 1), b3 + hstep, voffB);
            PG8_WAIT_V(6); PG8_BAR; PG8_MMA(1, 1, At, B1); PG8_BAR;
            }
        }
        if constexpr (ALIGN_EPI) { if (wr == 0) PG8_BAR; }
        if constexpr (!Epi::AFTER_DRAIN) { E(acc, cur, wr, wc, fr, fq); S.done(cur); }
        if (!has_next) break;
#pragma unroll
        for (int a = 0; a < 2; ++a)
#pragma unroll
            for (int b = 0; b < 2; ++b)
#pragma unroll
                for (int m = 0; m < 4; ++m)
#pragma unroll
                    for (int n = 0; n < 2; ++n) acc[a][b][m][n] = (f32x4){0.f, 0.f, 0.f, 0.f};
        cur = nxt; cA = nA; cB = nB; ++ui;
        if constexpr (ALIGN_EPI) { if (wr == 1) PG8_BAR; }
    }
    PG8_WAIT_V(0);
    if constexpr (!ALIGN_EPI) { if (wr == 0) PG8_BAR; }
    PG8_BAR;
    if constexpr (Epi::AFTER_DRAIN) { E.fused(acc, cur, wr, wc, fr, fq, lds, wid, lane); S.done(cur); }
#undef PG8_SA
#undef PG8_SB
#undef PG8_STAGE
#undef PG8_LDA
#undef PG8_LDB
#undef PG8_MMA
#undef PG8_WAIT_V
#undef PG8_WAIT_L
#undef PG8_BAR
#undef PG8_SCHED
}
}

#define LAS __attribute__((address_space(3)))
typedef unsigned short bf16;
typedef pg8::f32x4 f32x4;
typedef pg8::u32x4 u32x4;
typedef unsigned u32x2 __attribute__((ext_vector_type(2)));
using pg8::Unit;

constexpr int M = 65536, D = 1024, SEQ = 8192;
constexpr float ALPHA = 1.4142135623730951f;
constexpr float LN_EPS = 1e-5f, GN_EPS = 64e-5f;
constexpr int LDS_BYTES = 147456;

constexpr size_t MiB = (size_t)1 << 20;
constexpr size_t WS_ADAP = 1 * MiB, WS_ADA = 4 * MiB, WS_WLORA0 = 5 * MiB, WS_WLORA1 = 6 * MiB, WS_WINA0 = 8 * MiB, WS_WINA1 = 15 * MiB,
    WS_WG0 = 22 * MiB, WS_WG1 = 28 * MiB, WS_WBR0 = 34 * MiB, WS_WBR1 = 37 * MiB, WS_WOUT0 = 40 * MiB, WS_WOUT1 = 42 * MiB,
    WS_W1_0 = 44 * MiB, WS_W1_1 = 52 * MiB, WS_W2_0 = 60 * MiB, WS_W2_1 = 68 * MiB, WS_VFIRST = 76 * MiB, WS_H = 140 * MiB, WS_AR = 268 * MiB;
constexpr size_t AR_ZR = 0, AR_CG = 224 * MiB, AR_PL = 288 * MiB, AR_LV = 352 * MiB, AR_LO = 224 * MiB, AR_YCV = 480 * MiB, AR_POOL = 544 * MiB,
    AR_YRW = 608 * MiB, AR_LA = 672 * MiB, AR_P = 0, AR_HID = 0;
constexpr size_t WS_END = WS_AR + 720 * MiB;

struct Args { const float* in[36]; float* out; unsigned char* ws; };
typedef const Args __attribute__((address_space(4)))* ArgsP;
__device__ __forceinline__ ArgsP launder(ArgsP p) { asm volatile("" : "+s"(p)); return p; }

#define LDS_WAIT() asm volatile("s_waitcnt lgkmcnt(0)" ::: "memory")
__device__ __forceinline__ unsigned f2bf(float f) { unsigned u = __builtin_bit_cast(unsigned, f); return (u + 0x7fffu + ((u >> 16) & 1u)) >> 16; }
__device__ __forceinline__ unsigned pk2(float lo, float hi) { return pg8::cvt_pk_bf16(lo, hi); }
__device__ __forceinline__ float bflo(unsigned u) { return __uint_as_float(u << 16); }
__device__ __forceinline__ float bfhi(unsigned u) { return __uint_as_float(u & 0xffff0000u); }
__device__ __forceinline__ float bf1(unsigned short u) { return __uint_as_float(((unsigned)u) << 16); }
__device__ __forceinline__ float sigm(float x) { return 1.f / (1.f + __expf(-x)); }
__device__ __forceinline__ void unpack8(const u32x4 v, float (&o)[8]) { o[0] = bflo(v.x); o[1] = bfhi(v.x); o[2] = bflo(v.y); o[3] = bfhi(v.y); o[4] = bflo(v.z); o[5] = bfhi(v.z); o[6] = bflo(v.w); o[7] = bfhi(v.w); }
__device__ __forceinline__ u32x4 pack8(const float (&o)[8]) { u32x4 r; r.x = pk2(o[0], o[1]); r.y = pk2(o[2], o[3]); r.z = pk2(o[4], o[5]); r.w = pk2(o[6], o[7]); return r; }
__device__ __forceinline__ void load8f(const float* p, float (&o)[8]) { const f32x4 a = *(const f32x4*)p, b = *(const f32x4*)(p + 4); o[0] = a.x; o[1] = a.y; o[2] = a.z; o[3] = a.w; o[4] = b.x; o[5] = b.y; o[6] = b.z; o[7] = b.w; }
__device__ __forceinline__ float wave_sum(float v) {
#pragma unroll
    for (int o = 1; o < 64; o <<= 1) v += __shfl_xor(v, o);
    return v;
}
template <int CTRL> __device__ __forceinline__ float dppf(float x) { return __builtin_bit_cast(float, __builtin_amdgcn_update_dpp(0, __builtin_bit_cast(int, x), CTRL, 0xF, 0xF, true)); }
__device__ __forceinline__ float red4(float x) { x += dppf<0xB1>(x); x += dppf<0x4E>(x); return x; }
__device__ __forceinline__ float red8(float x) { x = red4(x); x += dppf<0x141>(x); return x; }
__device__ __forceinline__ float red16(float x) { x = red8(x); x += dppf<0x140>(x); return x; }

__device__ __forceinline__ void store8(bf16* p, const f32x4 v0, const f32x4 v1) {
    u32x4 w; w.x = pk2(v0[0], v0[1]); w.y = pk2(v0[2], v0[3]); w.z = pk2(v1[0], v1[1]); w.w = pk2(v1[2], v1[3]); *(u32x4*)p = w;
}
struct EpiG1 {
    static constexpr bool PERM = true, AFTER_DRAIN = false;
    bf16 *ZR, *CG, *PL, *LV;
    __device__ __forceinline__ void operator()(const f32x4 (&acc)[2][2][4][2], const Unit& u, int wr, int wc, int fr, int fq) const {
        const int row0 = u.pm * 256 + wr * 64 + fr, pn = u.pn, cin = wc * 32 + 8 * fq;
        if (pn < 7 || (pn >= 11 && pn < 13)) {
            bf16* base = pn < 7 ? ZR : PL; const int ldc = pn < 7 ? 1792 : 512, col0 = (pn < 7 ? pn : pn - 11) * 256 + cin;
#pragma unroll
            for (int ai = 0; ai < 2; ++ai)
#pragma unroll
                for (int m = 0; m < 4; ++m) { bf16* rp = base + (size_t)(row0 + ai * 128 + m * 16) * ldc + col0;
#pragma unroll
                    for (int bj = 0; bj < 2; ++bj) store8(rp + bj * 128, acc[ai][bj][m][0], acc[ai][bj][m][1]); }
        } else if (pn < 11) {
            const int col0 = (pn - 7) * 128 + cin;
#pragma unroll
            for (int ai = 0; ai < 2; ++ai)
#pragma unroll
                for (int m = 0; m < 4; ++m) { f32x4 h0, h1;
#pragma unroll
                    for (int i = 0; i < 4; ++i) { h0[i] = acc[ai][0][m][0][i] * sigm(acc[ai][1][m][0][i]); h1[i] = acc[ai][0][m][1][i] * sigm(acc[ai][1][m][1][i]); }
                    store8(CG + (size_t)(row0 + ai * 128 + m * 16) * 512 + col0, h0, h1); }
        } else {
            if (wc == 0) {
#pragma unroll
                for (int ai = 0; ai < 2; ++ai)
#pragma unroll
                    for (int m = 0; m < 4; ++m) store8(LV + (size_t)(row0 + ai * 128 + m * 16) * 32 + 8 * fq, acc[ai][0][m][0], acc[ai][0][m][1]);
            }
        }
    }
};
struct EpiLora {
    static constexpr bool PERM = true, AFTER_DRAIN = false;
    bf16* O; int ldc; const float *w0, *a0, *v0;
    __device__ __forceinline__ void operator()(const f32x4 (&acc)[2][2][4][2], const Unit& u, int wr, int wc, int fr, int fq) const {
        const int row0 = u.pm * 256 + wr * 64 + fr, type = u.pn >> 1, cin = wc * 32 + 8 * fq;
#pragma unroll
        for (int bj = 0; bj < 2; ++bj) {
            const int cb = u.pn * 256 + bj * 128 + cin, pc = cb & 511;
            f32x4 p0 = (f32x4){0.f, 0.f, 0.f, 0.f}, p1 = p0;
            if (type == 0) { p0 = *(const f32x4*)(w0 + pc); p1 = *(const f32x4*)(w0 + pc + 4); }
            else if (type == 1) { p0 = *(const f32x4*)(a0 + pc); p1 = *(const f32x4*)(a0 + pc + 4); }
            else if (type == 3) { p0 = *(const f32x4*)(v0 + pc); p1 = *(const f32x4*)(v0 + pc + 4); }
#pragma unroll
            for (int ai = 0; ai < 2; ++ai)
#pragma unroll
                for (int m = 0; m < 4; ++m) { f32x4 v0_ = acc[ai][bj][m][0] + p0, v1_ = acc[ai][bj][m][1] + p1;
                    if (type != 2) {
                        const float sc = type == 0 ? 0.60653065971f : 1.f;
#pragma unroll
                        for (int i = 0; i < 4; ++i) { v0_[i] = sc * sigm(v0_[i]); v1_[i] = sc * sigm(v1_[i]); } }
                    store8(O + (size_t)(row0 + ai * 128 + m * 16) * ldc + cb, v0_, v1_); }
        }
    }
};
template <int MODE  > struct EpiBf {
    static constexpr bool PERM = true, AFTER_DRAIN = false;
    bf16* O; int ldc;
    __device__ __forceinline__ void operator()(const f32x4 (&acc)[2][2][4][2], const Unit& u, int wr, int wc, int fr, int fq) const {
        const int row0 = u.pm * 256 + wr * 64 + fr, col0 = u.pn * 256 + wc * 32 + 8 * fq;
#pragma unroll
        for (int ai = 0; ai < 2; ++ai)
#pragma unroll
            for (int m = 0; m < 4; ++m) { bf16* rp = O + (size_t)(row0 + ai * 128 + m * 16) * ldc + col0;
#pragma unroll
                for (int bj = 0; bj < 2; ++bj) { f32x4 v0 = acc[ai][bj][m][0], v1 = acc[ai][bj][m][1];
                    if (MODE == 1) {
#pragma unroll
                        for (int i = 0; i < 4; ++i) { const float a = fmaxf(v0[i], 0.f), b = fmaxf(v1[i], 0.f); v0[i] = a * a; v1[i] = b * b; } }
                    if (MODE == 2) { float p[8]; unpack8(*(const u32x4*)(rp + bj * 128), p);
#pragma unroll
                        for (int i = 0; i < 4; ++i) { v0[i] = sigm(v0[i]) * p[i]; v1[i] = sigm(v1[i]) * p[4 + i]; } }
                    store8(rp + bj * 128, v0, v1); } }
    }
};
struct EpiRes {
    static constexpr bool PERM = false, AFTER_DRAIN = false;
    const float* xin; float* out; const float* gt;
    __device__ __forceinline__ void operator()(const f32x4 (&acc)[2][2][4][2], const Unit& u, int wr, int wc, int fr, int fq) const {
        const float* gtb = gt + (size_t)(u.pm >> 5) * 6144; const int col0 = u.pn * 256 + wc * 32 + 4 * fq;
        f32x4 g4[2][2];
#pragma unroll
        for (int bj = 0; bj < 2; ++bj)
#pragma unroll
            for (int n = 0; n < 2; ++n) g4[bj][n] = *(const f32x4*)(gtb + col0 + bj * 128 + n * 16);
#pragma unroll
        for (int ai = 0; ai < 2; ++ai)
#pragma unroll
            for (int m = 0; m < 4; ++m) { const size_t off = (size_t)(u.pm * 256 + ai * 128 + wr * 64 + m * 16 + fr) * 1024 + col0;
#pragma unroll
                for (int bj = 0; bj < 2; ++bj)
#pragma unroll
                    for (int n = 0; n < 2; ++n) { const f32x4 x4 = *(const f32x4*)(xin + off + bj * 128 + n * 16);
                        *(f32x4*)(out + off + bj * 128 + n * 16) = x4 * ALPHA + g4[bj][n] * acc[ai][bj][m][n]; } }
    }
};

__device__ __forceinline__ void tr_item(const float* W, int N, int k0, int n0, bf16* dst, int K, LAS float* scr, int lane) {
#pragma unroll 8
    for (int i = 0; i < 32; ++i) { const int kk = 2 * i + (lane >> 5); scr[kk * 33 + (lane & 31)] = W[(size_t)(k0 + kk) * N + n0 + (lane & 31)]; }
    LDS_WAIT(); asm volatile("" ::: "memory");
    const int c = lane & 7;
#pragma unroll
    for (int j = 0; j < 4; ++j) { const int n = (lane >> 3) + 8 * j; const LAS float* s = scr + (8 * c) * 33 + n;
        u32x4 o; o.x = pk2(s[0 * 33], s[1 * 33]); o.y = pk2(s[2 * 33], s[3 * 33]); o.z = pk2(s[4 * 33], s[5 * 33]); o.w = pk2(s[6 * 33], s[7 * 33]);
        *(u32x4*)(dst + (size_t)n * K + 8 * c) = o; }
    LDS_WAIT(); asm volatile("" ::: "memory");
}
__device__ __forceinline__ bf16* win_dst(unsigned char* ws, int l, int n0) {
    bf16* wina = (bf16*)(ws + (l ? WS_WINA1 : WS_WINA0)); bf16* wg = (bf16*)(ws + (l ? WS_WG1 : WS_WG0));
    if (n0 < 1792) return wina + (size_t)n0 * 1024;
    if (n0 < 2816) { const int c = n0 - 1792, half = c >> 9, cc = c & 511, j = cc >> 7, i = cc & 127; return wina + (size_t)(1792 + j * 256 + half * 128 + i) * 1024; }
    if (n0 < 3328) return wina + (size_t)n0 * 1024;
    return wg + (size_t)(n0 - 3328) * 1024;
}
__device__ __forceinline__ void p0_phase(ArgsP a_, LAS unsigned char* lds) {
    const ArgsP a = launder(a_);
    const int tid = opq_tid(), lane = tid & 63, wave = tid >> 6, G = opq_gdim();
    const int gw = opq_bid() * 8 + wave, NGW = G * 8, gt = opq_bid() * 512 + tid, NT = G * 512;
    unsigned char* ws = a->ws;
    LAS float* scr = (LAS float*)(lds + wave * 8448);
    for (int it = gw; it < 16656; it += NGW) {
        int r = it;
        if (r >= 16640) { const int kb = r - 16640; tr_item(a->in[5], 32, 64 * kb, 0, (bf16*)(ws + WS_WINA1) + (size_t)3328 * 1024 + 64 * kb, 1024, scr, lane); continue; }
        const int l = r >= 8320 ? 1 : 0; r -= l * 8320;
        if (r < 3200) { const int kb = r / 200, nb = r % 200; tr_item(a->in[4] + (size_t)l * 1024 * 6400, 6400, 64 * kb, 32 * nb, win_dst(ws, l, 32 * nb) + 64 * kb, 1024, scr, lane); continue; } r -= 3200;
        bf16* wbr = (bf16*)(ws + (l ? WS_WBR1 : WS_WBR0));
        if (r < 256) { const int kb = r >> 5, nb = r & 31; tr_item(a->in[20] + (size_t)l * 512 * 1024, 1024, 64 * kb, 32 * nb, wbr + (size_t)(32 * nb) * 512 + 64 * kb, 512, scr, lane); continue; } r -= 256;
        if (r < 256) { const int kb = r >> 5, nb = r & 31; tr_item(a->in[25] + (size_t)l * 512 * 1024, 1024, 64 * kb, 32 * nb, wbr + (size_t)(1024 + 32 * nb) * 512 + 64 * kb, 512, scr, lane); continue; } r -= 256;
        if (r < 512) { const int kb = r >> 5, nb = r & 31; tr_item(a->in[29] + (size_t)l * 1024 * 1024, 1024, 64 * kb, 32 * nb, (bf16*)(ws + (l ? WS_WOUT1 : WS_WOUT0)) + (size_t)(32 * nb) * 1024 + 64 * kb, 1024, scr, lane); continue; } r -= 512;
        if (r < 2048) { const int kb = r >> 7, nb = r & 127; tr_item(a->in[32] + (size_t)l * 1024 * 4096, 4096, 64 * kb, 32 * nb, (bf16*)(ws + (l ? WS_W1_1 : WS_W1_0)) + (size_t)(32 * nb) * 1024 + 64 * kb, 1024, scr, lane); continue; } r -= 2048;
        { const int kb = r >> 5, nb = r & 31; tr_item(a->in[33] + (size_t)l * 4096 * 1024, 1024, 64 * kb, 32 * nb, (bf16*)(ws + (l ? WS_W2_1 : WS_W2_0)) + (size_t)(32 * nb) * 4096 + 64 * kb, 4096, scr, lane); }
    }
    { u32x4* z = (u32x4*)((bf16*)(ws + WS_WINA1) + (size_t)3360 * 1024); for (int i = gt; i < 28672; i += NT) z[i] = (u32x4){0u, 0u, 0u, 0u}; }
    { bf16* w = (bf16*)(ws + WS_WLORA0);
      for (int i = gt; i < 1536 * 256; i += NT) { const int n = i >> 8, k = i & 255; float v = 0.f;
          if (n < 512) { if (k < 64) v = a->in[9][k * 512 + n]; }
          else if (n < 1024) { if (k >= 64 && k < 128) v = a->in[11][(k - 64) * 512 + n - 512]; }
          else { if (k >= 128) v = a->in[12][(k - 128) * 512 + n - 1024]; }
          w[i] = (bf16)f2bf(v); } }
    { bf16* w = (bf16*)(ws + WS_WLORA1);
      for (int i = gt; i < 2048 * 384; i += NT) { const int n = i / 384, k = i % 384; float v = 0.f;
          if (n < 512) { if (k < 64) v = a->in[9][64 * 512 + k * 512 + n]; }
          else if (n < 1024) { if (k >= 64 && k < 128) v = a->in[11][64 * 512 + (k - 64) * 512 + n - 512]; }
          else if (n < 1536) { if (k >= 128 && k < 256) v = a->in[12][128 * 512 + (k - 128) * 512 + n - 1024]; }
          else { if (k >= 256 && k < 288) v = a->in[14][(k - 256) * 512 + n - 1536]; }
          w[i] = (bf16)f2bf(v); } }
    for (int idx = gt; idx < 131072; idx += NT) {
        const int n = idx & 1023, cg8 = (idx >> 10) & 63, l = idx >> 16, g = cg8 >> 4, c0 = (cg8 & 15) * 8;
        const float* plw = a->in[26] + ((size_t)(l * 4 + g) * 128 + c0) * 128; const float* pls = a->in[27] + l * 512 + g * 128; const float* plo = a->in[28] + ((size_t)l * 512 + g * 128) * 1024 + n;
        float acc[8];
#pragma unroll
        for (int i = 0; i < 8; ++i) acc[i] = 0.f;
        for (int d = 0; d < 128; ++d) { const float bw = plo[(size_t)d * 1024] * pls[d];
#pragma unroll
            for (int i = 0; i < 8; ++i) acc[i] += plw[i * 128 + d] * bw; }
        bf16* wbr = (bf16*)(ws + (l ? WS_WBR1 : WS_WBR0));
        *(u32x4*)(wbr + (size_t)(2048 + n) * 512 + g * 128 + c0) = pack8(acc);
    }
    float* adap = (float*)(ws + WS_ADAP);
    for (int wt = gw; wt < 1536; wt += NGW) {
        const int l = wt / 768, r = wt % 768, cb = r >> 3, kc = r & 7, col = cb * 64 + lane;
#pragma unroll
        for (int i = 0; i < 16; ++i) { const int idx = lane + 64 * i, b = idx >> 7, kk = idx & 127; const float x = a->in[1][b * 1024 + kc * 128 + kk]; scr[idx] = x * sigm(x); }
        LDS_WAIT(); asm volatile("" ::: "memory");
        float acc[8];
#pragma unroll
        for (int b = 0; b < 8; ++b) acc[b] = 0.f;
        const float* wp = a->in[2] + ((size_t)l * 1024 + kc * 128) * 6144 + col;
#pragma unroll 4
        for (int kk = 0; kk < 128; ++kk) { const float w = wp[(size_t)kk * 6144];
#pragma unroll
            for (int b = 0; b < 8; ++b) acc[b] += scr[b * 128 + kk] * w; }
#pragma unroll
        for (int b = 0; b < 8; ++b) adap[((size_t)(l * 8 + kc) * 8 + b) * 6144 + col] = acc[b];
        LDS_WAIT(); asm volatile("" ::: "memory");
    }
}
__device__ __forceinline__ void p0b_phase(ArgsP a_) {
    const ArgsP a = launder(a_);
    const int tid = opq_tid(), lane = tid & 63, wave = tid >> 6, G = opq_gdim();
    const int gw = opq_bid() * 8 + wave, NGW = G * 8, gt = opq_bid() * 512 + tid, NT = G * 512;
    const float* adap = (const float*)(a->ws + WS_ADAP); float* ada = (float*)(a->ws + WS_ADA);
    for (int i = gt; i < 2 * 49152; i += NT) { const int l = i / 49152, r = i % 49152, col = r % 6144; float s = a->in[3][l * 6144 + col];
#pragma unroll
        for (int kc = 0; kc < 8; ++kc) s += adap[(size_t)(l * 8 + kc) * 49152 + r];
        ada[i] = s; }
    bf16* H = (bf16*)(a->ws + WS_H);
    for (int rb = gw; rb < 2048; rb += NGW) {
        const int b = rb >> 8; f32x4 sh[4], sc[4];
#pragma unroll
        for (int j = 0; j < 4; ++j) { const int col = 4 * lane + 256 * j; f32x4 s0 = *(const f32x4*)(a->in[3] + col), s1 = *(const f32x4*)(a->in[3] + 1024 + col);
#pragma unroll
            for (int kc = 0; kc < 8; ++kc) { s0 += *(const f32x4*)(adap + (size_t)kc * 49152 + b * 6144 + col); s1 += *(const f32x4*)(adap + (size_t)kc * 49152 + b * 6144 + 1024 + col); }
            sh[j] = s0; sc[j] = s1 + 1.f; }
        for (int rr = 0; rr < 32; ++rr) { const size_t m = (size_t)rb * 32 + rr;
#pragma unroll
            for (int j = 0; j < 4; ++j) { const int col = 4 * lane + 256 * j; const f32x4 x = *(const f32x4*)(a->in[0] + m * 1024 + col); const f32x4 h = x * sc[j] + sh[j];
                u32x2 w; w.x = pk2(h[0], h[1]); w.y = pk2(h[2], h[3]); *(u32x2*)(H + m * 1024 + col) = w; } }
    }
}
__device__ __forceinline__ void ln_phase(float* X, bf16* H, const float* gam, const float* bet, const float* adash  , const float* adasc, bool writeH) {
    const int tid = opq_tid(), lane = tid & 63, wave = tid >> 6, gw = opq_bid() * 8 + wave, NGW = opq_gdim() * 8;
    for (int rb = gw; rb < 2048; rb += NGW) {
        const int b = rb >> 8; f32x4 g4[4], b4[4], sh[4], sc[4];
#pragma unroll
        for (int j = 0; j < 4; ++j) { const int col = 4 * lane + 256 * j; g4[j] = *(const f32x4*)(gam + col); b4[j] = *(const f32x4*)(bet + col);
            if (writeH) { sh[j] = *(const f32x4*)(adash + b * 6144 + col); sc[j] = *(const f32x4*)(adasc + b * 6144 + col) + 1.f; } else { sh[j] = g4[j]; sc[j] = g4[j]; } }
        for (int rr = 0; rr < 32; ++rr) { const size_t m = (size_t)rb * 32 + rr; f32x4 v[4]; float s = 0.f;
#pragma unroll
            for (int j = 0; j < 4; ++j) { v[j] = *(const f32x4*)(X + m * 1024 + 4 * lane + 256 * j); s += (v[j][0] + v[j][1]) + (v[j][2] + v[j][3]); }
            const float mean = wave_sum(s) * (1.f / 1024.f); float q = 0.f;
#pragma unroll
            for (int j = 0; j < 4; ++j) { v[j] = v[j] - mean; q += (v[j][0] * v[j][0] + v[j][1] * v[j][1]) + (v[j][2] * v[j][2] + v[j][3] * v[j][3]); }
            const float rstd = 1.0f / sqrtf(wave_sum(q) * (1.f / 1024.f) + LN_EPS);
#pragma unroll
            for (int j = 0; j < 4; ++j) { const int col = 4 * lane + 256 * j; const f32x4 y = v[j] * rstd * g4[j] + b4[j]; *(f32x4*)(X + m * 1024 + col) = y;
                if (writeH) { const f32x4 h = y * sc[j] + sh[j]; u32x2 w; w.x = pk2(h[0], h[1]); w.y = pk2(h[2], h[3]); *(u32x2*)(H + m * 1024 + col) = w; } } }
    }
}
__device__ __forceinline__ void prep_phase(ArgsP a_, int l, LAS unsigned char* lds) {
    const ArgsP a = launder(a_);
    const int tid = opq_tid(), lane = tid & 63, wave = tid >> 6, gw = opq_bid() * 8 + wave, NGW = opq_gdim() * 8;
    unsigned char* ar = a->ws + WS_AR;
    const bf16* ZR = (const bf16*)(ar + AR_ZR); const bf16* CG = (const bf16*)(ar + AR_CG); const bf16* PL = (const bf16*)(ar + AR_PL); const bf16* LV = (const bf16*)(ar + AR_LV);
    bf16* LA = (bf16*)(ar + AR_LA); bf16* YCV = (bf16*)(ar + AR_YCV); bf16* POOL = (bf16*)(ar + AR_POOL);
    LAS float* cw = (LAS float*)lds;
    for (int i = tid; i < 31 * 512; i += 512) cw[i] = a->in[21][l * 31 * 512 + i];
    __syncthreads();
    const int c8 = 8 * lane, ldA = l ? 384 : 256;
    float cvb[8], lng[8], lnb[8], mu[8];
    load8f(a->in[22] + l * 512 + c8, cvb); load8f(a->in[23] + l * 512 + c8, lng); load8f(a->in[24] + l * 512 + c8, lnb);
    if (lane < 32) load8f(a->in[6] + l * 1792 + 1536 + c8, mu);
    else if (l && lane < 36) load8f(a->in[7] + 8 * (lane - 32), mu);
    else {
#pragma unroll
        for (int i = 0; i < 8; ++i) mu[i] = 0.f; }
    for (int rb = gw; rb < 2048; rb += NGW)
        for (int rr = 0; rr < 32; ++rr) {
            const size_t m = (size_t)rb * 32 + rr; const int s = (int)(m & 8191);
            if (lane < 32 || (l && lane < 36)) {
                const bf16* src = lane < 32 ? ZR + m * 1792 + 1536 + c8 : LV + m * 32 + 8 * (lane - 32); const int ldp = lane < 32 ? 1792 : 32;
                float zt[8], zp[8]; unpack8(*(const u32x4*)src, zt);
                if (s > 0) unpack8(*(const u32x4*)(src - ldp), zp); else {
#pragma unroll
                    for (int i = 0; i < 8; ++i) zp[i] = 0.f; }
#pragma unroll
                for (int i = 0; i < 8; ++i) { float z = zt[i] + (zp[i] - zt[i]) * mu[i];
                    if (lane < 8) z = 1.f - 2.f / (1.f + __expf(2.f * z)); else if (lane >= 16 && lane < 32) z = sigm(z);
                    zt[i] = z; }
                *(u32x4*)(LA + m * ldA + (lane < 32 ? c8 : 256 + 8 * (lane - 32))) = pack8(zt);
            } else if (l && lane < 48) { *(u32x4*)(LA + m * ldA + c8) = (u32x4){0u, 0u, 0u, 0u}; }
            { float acc[8]; u32x4 xr[31];
#pragma unroll
              for (int j = 0; j < 31; ++j) { const size_t row = (s - 30 + j >= 0) ? (m - 30 + j) : (m - s); xr[j] = *(const u32x4*)(CG + row * 512 + c8); }
#pragma unroll
              for (int i = 0; i < 8; ++i) acc[i] = cvb[i];
#pragma unroll
              for (int j = 0; j < 31; ++j) if (s - 30 + j >= 0) { float x[8]; unpack8(xr[j], x);
                  const f32x4 w0 = *(const LAS f32x4*)(cw + j * 512 + c8), w1 = *(const LAS f32x4*)(cw + j * 512 + c8 + 4);
#pragma unroll
                  for (int i = 0; i < 4; ++i) { acc[i] += x[i] * w0[i]; acc[4 + i] += x[4 + i] * w1[i]; } }
              float s1 = 0.f;
#pragma unroll
              for (int i = 0; i < 8; ++i) s1 += acc[i];
              const float mean = wave_sum(s1) * (1.f / 512.f); float q = 0.f;
#pragma unroll
              for (int i = 0; i < 8; ++i) { acc[i] -= mean; q += acc[i] * acc[i]; }
              const float rstd = 1.0f / sqrtf(wave_sum(q) * (1.f / 512.f) + LN_EPS);
#pragma unroll
              for (int i = 0; i < 8; ++i) { const float y = acc[i] * rstd * lng[i] + lnb[i]; acc[i] = y * sigm(y); }
              *(u32x4*)(YCV + m * 512 + c8) = pack8(acc); }
            { const int win = 2 << (lane >> 4), cnt = (s + 1) < win ? (s + 1) : win; u32x4 pr[16];
#pragma unroll
              for (int i = 0; i < 16; ++i) { const size_t row = (i <= s) ? (m - i) : m; pr[i] = *(const u32x4*)(PL + row * 512 + c8); }
              float x0[8], sum[8]; unpack8(pr[0], x0);
#pragma unroll
              for (int i = 0; i < 8; ++i) sum[i] = x0[i];
#pragma unroll
              for (int i = 1; i < 16; ++i) { float x[8]; unpack8(pr[i], x); const float f = i < cnt ? 1.f : 0.f;
#pragma unroll
                  for (int q = 0; q < 8; ++q) sum[q] += x[q] * f; }
              const float inv = 1.f / (float)cnt;
#pragma unroll
              for (int i = 0; i < 8; ++i) sum[i] = sum[i] * inv - x0[i];
              *(u32x4*)(POOL + m * 512 + c8) = pack8(sum); }
        }
    __syncthreads();
}
struct HSet { u32x2 rt[2], kt[2], rp[2], kp[2], ee[2], aa[2]; unsigned short vt[2], vp[2], vm[2], vf[2]; };
constexpr int SC_OPS = 0, SC_VV = 81920, SC_YP = 86016;
__device__ __forceinline__ void sc_load(HSet& S, int c, int l, int b, int h, int rg, int hl, const bf16* ZR, const bf16* LO, int ldlo, const bf16* VF) {
    if (c >= 256) return;
    const int cg = hl & 15, vc = h * 64 + 16 * rg + cg;
#pragma unroll
    for (int p = 0; p < 2; ++p) {
        const int t = (hl >> 4) + 16 * p, s = c * 32 + t; const size_t m = (size_t)b * 8192 + s;
        const bf16* zr = ZR + m * 1792; const bf16* lo = LO + m * ldlo;
        S.rt[p] = *(const u32x2*)(zr + h * 64 + 4 * cg); S.kt[p] = *(const u32x2*)(zr + 512 + h * 64 + 4 * cg); S.vt[p] = zr[1024 + vc];
        if (s > 0) { S.rp[p] = *(const u32x2*)(zr - 1792 + h * 64 + 4 * cg); S.kp[p] = *(const u32x2*)(zr - 1792 + 512 + h * 64 + 4 * cg); S.vp[p] = zr[-1792 + 1024 + vc]; }
        else { S.rp[p] = (u32x2){0u, 0u}; S.kp[p] = (u32x2){0u, 0u}; S.vp[p] = 0; }
        S.ee[p] = *(const u32x2*)(lo + h * 64 + 4 * cg); S.aa[p] = *(const u32x2*)(lo + 512 + h * 64 + 4 * cg);
        if (l) { S.vm[p] = lo[1536 + vc]; S.vf[p] = VF[m * 512 + vc]; } else { S.vm[p] = 0; S.vf[p] = 0; }
    }
}
__device__ __forceinline__ void sc_prep(const HSet& S, int c, int buf, int l, int b, int h, int rg, int hl, LAS unsigned char* lds, bf16* VF,
                                        const f32x4 mur, const f32x4 muk, const f32x4 kkc, const f32x4 kac, const float muv) {
    if (c >= 256) return;
    const int cg = hl & 15, vc = h * 64 + 16 * rg + cg;
#pragma unroll
    for (int p = 0; p < 2; ++p) {
        const int t = (hl >> 4) + 16 * p; const size_t m = (size_t)b * 8192 + c * 32 + t;
        f32x4 rt = {bflo(S.rt[p].x), bfhi(S.rt[p].x), bflo(S.rt[p].y), bfhi(S.rt[p].y)}, rp = {bflo(S.rp[p].x), bfhi(S.rp[p].x), bflo(S.rp[p].y), bfhi(S.rp[p].y)};
        f32x4 kt = {bflo(S.kt[p].x), bfhi(S.kt[p].x), bflo(S.kt[p].y), bfhi(S.kt[p].y)}, kp = {bflo(S.kp[p].x), bfhi(S.kp[p].x), bflo(S.kp[p].y), bfhi(S.kp[p].y)};
        const f32x4 e = {bflo(S.ee[p].x), bfhi(S.ee[p].x), bflo(S.ee[p].y), bfhi(S.ee[p].y)}, av = {bflo(S.aa[p].x), bfhi(S.aa[p].x), bflo(S.aa[p].y), bfhi(S.aa[p].y)};
        const f32x4 r = rt + (rp - rt) * mur, k = kt + (kp - kt) * muk;
        f32x4 w; w[0] = __expf(-e[0]); w[1] = __expf(-e[1]); w[2] = __expf(-e[2]); w[3] = __expf(-e[3]);
        f32x4 kk = k * kkc; const float ss = red16((kk[0] * kk[0] + kk[1] * kk[1]) + (kk[2] * kk[2] + kk[3] * kk[3]));
        kk = kk * (1.0f / fmaxf(sqrtf(ss), 1e-12f));
        const f32x4 kh = k * ((av - 1.f) * kac + 1.f);
        LAS float* o = (LAS float*)(lds + SC_OPS) + (buf * 32 + t) * 320 + 4 * cg;
        *(LAS f32x4*)(o) = w; *(LAS f32x4*)(o + 64) = -kk; *(LAS f32x4*)(o + 128) = kk * av; *(LAS f32x4*)(o + 192) = kh; *(LAS f32x4*)(o + 256) = r;
        const float vt = bf1(S.vt[p]), vp = bf1(S.vp[p]); float v = vt + (vp - vt) * muv;
        if (l) v = v + (bf1(S.vf[p]) - v) * bf1(S.vm[p]); else VF[m * 512 + vc] = (bf16)f2bf(v);
        ((LAS float*)(lds + SC_VV))[(buf * 32 + t) * 16 + cg] = v;
    }
}
__device__ __forceinline__ void sc_yred(int c, int buf, int b, int h, int rg, int hl, LAS unsigned char* lds, bf16* YRW) {
    const int i = hl & 15;
#pragma unroll
    for (int p = 0; p < 2; ++p) { const int t = (hl >> 4) + 16 * p; const size_t m = (size_t)b * 8192 + c * 32 + t;
        const f32x4 q = *(const LAS f32x4*)((LAS float*)(lds + SC_YP) + ((buf * 32 + t) * 16 + i) * 4);
        YRW[m * 512 + h * 64 + 16 * rg + i] = (bf16)f2bf((q[0] + q[1]) + (q[2] + q[3])); }
}
struct ScOp { f32x4 w, a, b, k, r; float v; };
__device__ __forceinline__ ScOp sc_ld(const LAS float* ops, const LAS float* vv, int t) {
    ScOp o; o.w = *(const LAS f32x4*)(ops + t * 320); o.a = *(const LAS f32x4*)(ops + t * 320 + 64); o.b = *(const LAS f32x4*)(ops + t * 320 + 128);
    o.k = *(const LAS f32x4*)(ops + t * 320 + 192); o.r = *(const LAS f32x4*)(ops + t * 320 + 256); o.v = vv[t * 16]; return o;
}
__device__ __forceinline__ void sc_step(f32x4& st, const ScOp& o, LAS float* ypt) {
    const float sa = red16((st[0] * o.a[0] + st[1] * o.a[1]) + (st[2] * o.a[2] + st[3] * o.a[3]));
    st = st * o.w + o.b * sa + o.k * o.v;
    *ypt = red4((st[0] * o.r[0] + st[1] * o.r[1]) + (st[2] * o.r[2] + st[3] * o.r[3]));
}
__device__ __forceinline__ void sc_scan(f32x4& st, int buf, int row, int seg, int lane, LAS unsigned char* lds) {
    const LAS float* ops = (const LAS float*)(lds + SC_OPS) + buf * 32 * 320 + 4 * seg;
    const LAS float* vv = (const LAS float*)(lds + SC_VV) + buf * 32 * 16 + row;
    LAS float* yp = (LAS float*)(lds + SC_YP) + (buf * 32 * 16 + row) * 4 + (seg >> 2);
    ScOp o0 = sc_ld(ops, vv, 0), o1 = sc_ld(ops, vv, 1);
#pragma unroll 2
    for (int t = 0; t < 32; t += 2) {
        const ScOp o2 = sc_ld(ops, vv, t + 2); sc_step(st, o0, yp + t * 64);
        const ScOp o3 = sc_ld(ops, vv, t + 3); sc_step(st, o1, yp + (t + 1) * 64);
        o0 = o2; o1 = o3;
    }
}
__device__ __forceinline__ void scan_phase(ArgsP a_, int l, LAS unsigned char* lds) {
    const ArgsP a = launder(a_);
    const int tid = opq_tid(), lane = tid & 63, wave = __builtin_amdgcn_readfirstlane(tid >> 6);
    unsigned char* ar = a->ws + WS_AR;
    const bf16* ZR = (const bf16*)(ar + AR_ZR); const bf16* LO = (const bf16*)(ar + AR_LO); const int ldlo = l ? 2048 : 1536;
    bf16* VF = (bf16*)(a->ws + WS_VFIRST); bf16* YRW = (bf16*)(ar + AR_YRW);
    for (int u = opq_bid(); u < 256; u += opq_gdim()) {
        const int b = u >> 5, h = (u >> 2) & 7, rg = u & 3;
        if (wave < 4) {
            f32x4 st = {0.f, 0.f, 0.f, 0.f}; const int row = 4 * wave + (lane >> 4), seg = lane & 15;
            __syncthreads();
            for (int c = 0; c < 256; c += 2) { sc_scan(st, 0, row, seg, lane, lds); __syncthreads(); sc_scan(st, 1, row, seg, lane, lds); __syncthreads(); }
        } else {
            const int hl = tid - 256, cg = hl & 15, ch = h * 64 + 4 * cg, vc = h * 64 + 16 * rg + cg;
            const f32x4 mur = *(const f32x4*)(a->in[6] + l * 1792 + ch), muk = *(const f32x4*)(a->in[6] + l * 1792 + 512 + ch);
            const f32x4 kkc = *(const f32x4*)(a->in[15] + l * 512 + ch), kac = *(const f32x4*)(a->in[16] + l * 512 + ch);
            const float muv = a->in[6][l * 1792 + 1024 + vc];
            HSet SA, SB;
            sc_load(SA, 0, l, b, h, rg, hl, ZR, LO, ldlo, VF); sc_prep(SA, 0, 0, l, b, h, rg, hl, lds, VF, mur, muk, kkc, kac, muv);
            sc_load(SA, 1, l, b, h, rg, hl, ZR, LO, ldlo, VF); sc_load(SB, 2, l, b, h, rg, hl, ZR, LO, ldlo, VF);
            __syncthreads();
            for (int c = 0; c < 256; c += 2) {
                if (c > 0) sc_yred(c - 1, 1, b, h, rg, hl, lds, YRW);
                sc_prep(SA, c + 1, 1, l, b, h, rg, hl, lds, VF, mur, muk, kkc, kac, muv); sc_load(SA, c + 3, l, b, h, rg, hl, ZR, LO, ldlo, VF);
                __syncthreads();
                sc_yred(c, 0, b, h, rg, hl, lds, YRW);
                sc_prep(SB, c + 2, 0, l, b, h, rg, hl, lds, VF, mur, muk, kkc, kac, muv); sc_load(SB, c + 4, l, b, h, rg, hl, ZR, LO, ldlo, VF);
                __syncthreads();
            }
            sc_yred(255, 1, b, h, rg, hl, lds, YRW);
        }
        __syncthreads();
    }
}
__device__ __forceinline__ void post_phase(ArgsP a_, int l) {
    const ArgsP a = launder(a_);
    const int tid = opq_tid(), lane = tid & 63, wave = tid >> 6, gw = opq_bid() * 8 + wave, NGW = opq_gdim() * 8, c8 = 8 * lane;
    unsigned char* ar = a->ws + WS_AR;
    const bf16* ZR = (const bf16*)(ar + AR_ZR); const bf16* LO = (const bf16*)(ar + AR_LO); const int ldlo = l ? 2048 : 1536;
    const bf16* VF = (const bf16*)(a->ws + WS_VFIRST); bf16* YRW = (bf16*)(ar + AR_YRW);
    float mur[8], muk[8], muv[8], ka[8], rk[8], gng[8], gnb[8];
    load8f(a->in[6] + l * 1792 + c8, mur); load8f(a->in[6] + l * 1792 + 512 + c8, muk); load8f(a->in[6] + l * 1792 + 1024 + c8, muv);
    load8f(a->in[16] + l * 512 + c8, ka); load8f(a->in[17] + l * 512 + c8, rk); load8f(a->in[18] + l * 512 + c8, gng); load8f(a->in[19] + l * 512 + c8, gnb);
    for (int rb = gw; rb < 2048; rb += NGW)
        for (int rr = 0; rr < 32; ++rr) {
            const size_t m = (size_t)rb * 32 + rr; const int s = (int)(m & 8191);
            const bf16* zr = ZR + m * 1792 + c8; const bf16* lo = LO + m * ldlo + c8;
            float y[8], rt[8], kt[8], vt[8], rp[8], kp[8], vp[8], av[8], g[8];
            unpack8(*(const u32x4*)(YRW + m * 512 + c8), y);
            unpack8(*(const u32x4*)zr, rt); unpack8(*(const u32x4*)(zr + 512), kt); unpack8(*(const u32x4*)(zr + 1024), vt);
            if (s > 0) { unpack8(*(const u32x4*)(zr - 1792), rp); unpack8(*(const u32x4*)(zr - 1792 + 512), kp); unpack8(*(const u32x4*)(zr - 1792 + 1024), vp); }
            else {
#pragma unroll
                for (int i = 0; i < 8; ++i) { rp[i] = 0.f; kp[i] = 0.f; vp[i] = 0.f; } }
            unpack8(*(const u32x4*)(lo + 512), av); unpack8(*(const u32x4*)(lo + 1024), g);
            float bon = 0.f, sy = 0.f;
#pragma unroll
            for (int i = 0; i < 8; ++i) { const float r = rt[i] + (rp[i] - rt[i]) * mur[i], k = kt[i] + (kp[i] - kt[i]) * muk[i]; vt[i] = vt[i] + (vp[i] - vt[i]) * muv[i];
                bon += r * (k * (1.f + (av[i] - 1.f) * ka[i])) * rk[i]; sy += y[i]; }
            if (l) { float vm[8], vf[8]; unpack8(*(const u32x4*)(lo + 1536), vm); unpack8(*(const u32x4*)(VF + m * 512 + c8), vf);
#pragma unroll
                for (int i = 0; i < 8; ++i) vt[i] = vt[i] + (vf[i] - vt[i]) * vm[i]; }
            bon = red8(bon); const float mean = red8(sy) * (1.f / 64.f); float q = 0.f;
#pragma unroll
            for (int i = 0; i < 8; ++i) { y[i] -= mean; q += y[i] * y[i]; }
            const float rstd = 1.0f / sqrtf(red8(q) * (1.f / 64.f) + GN_EPS);
#pragma unroll
            for (int i = 0; i < 8; ++i) y[i] = (y[i] * rstd * gng[i] + gnb[i] + bon * vt[i]) * g[i];
            *(u32x4*)(YRW + m * 512 + c8) = pack8(y);
        }
}
__device__ __forceinline__ void combine_phase(ArgsP a_) {
    const ArgsP a = launder(a_);
    const int gt = opq_bid() * 512 + opq_tid(), NT = opq_gdim() * 512;
    const bf16* P = (const bf16*)(a->ws + WS_AR + AR_P); bf16* Hm = (bf16*)(a->ws + WS_H);
    for (int i = gt; i < M * 128; i += NT) { const size_t m = (size_t)(i >> 7); const int c8 = (i & 127) * 8; float p0[8], p1[8], p2[8];
        unpack8(*(const u32x4*)(P + m * 3072 + c8), p0); unpack8(*(const u32x4*)(P + m * 3072 + 1024 + c8), p1); unpack8(*(const u32x4*)(P + m * 3072 + 2048 + c8), p2);
#pragma unroll
        for (int q = 0; q < 8; ++q) p0[q] = (p0[q] + p1[q]) + p2[q];
        *(u32x4*)(Hm + m * 1024 + c8) = pack8(p0); }
}

#ifndef DUPM
#define DUPM 0
#endif
#ifndef PHM
#define PHM 0x7fff
#endif
__global__ void __launch_bounds__(512, 2) fwd_kernel(Args kargs) {
    extern __shared__ __attribute__((aligned(16))) unsigned char lds_raw[];
    LAS unsigned char* lds = (LAS unsigned char*)lds_raw;
    cg::grid_group grid = cg::this_grid();
    const ArgsP ak = (ArgsP)__builtin_amdgcn_kernarg_segment_ptr();

    if (PHM & 1) p0_phase(ak, lds); grid.sync();
    if (PHM & 2) p0b_phase(ak); grid.sync();
#pragma unroll 1
    for (int l = 0; l < 2; ++l) {
        if (PHM & 4) { const ArgsP a = launder(ak); const int G = opq_gdim(), bx = opq_bid(); unsigned char* ws = a->ws; unsigned char* ar = ws + WS_AR; bf16* H = (bf16*)(ws + WS_H); const float* adal = (const float*)(ws + WS_ADA) + l * 49152; (void)ar; (void)H; (void)adal;
          pg8::Gemm g{H, nullptr, nullptr, 0, (const bf16*)(ws + (l ? WS_WINA1 : WS_WINA0)), M, l ? 3584 : 3328, 1024};
          pg8::StaticOrder S; S.init(M, g.N, G, bx);
          EpiG1 E{(bf16*)(ar + AR_ZR), (bf16*)(ar + AR_CG), (bf16*)(ar + AR_PL), (bf16*)(ar + AR_LV)};
          pg8::gemm_phase<EpiG1, pg8::StaticOrder, true, true>(lds, g, S, E); }
        grid.sync();
        if (PHM & 8) prep_phase(ak, l, lds); grid.sync();
        if (DUPM & 1) { prep_phase(ak, l, lds); grid.sync(); }
        if (PHM & 16) { const ArgsP a = launder(ak); const int G = opq_gdim(), bx = opq_bid(); unsigned char* ws = a->ws; unsigned char* ar = ws + WS_AR; bf16* H = (bf16*)(ws + WS_H); const float* adal = (const float*)(ws + WS_ADA) + l * 49152; (void)ar; (void)H; (void)adal;
          pg8::Gemm g{(const bf16*)(ar + AR_LA), nullptr, nullptr, 0, (const bf16*)(ws + (l ? WS_WLORA1 : WS_WLORA0)), M, l ? 2048 : 1536, l ? 384 : 256};
          pg8::StaticOrder S; S.init(M, g.N, G, bx);
          EpiLora E{(bf16*)(ar + AR_LO), l ? 2048 : 1536, a->in[8] + l * 512, a->in[10] + l * 512, a->in[13]};
          pg8::gemm_phase<EpiLora, pg8::StaticOrder, true, true>(lds, g, S, E); }
        grid.sync();
        if (PHM & 32) scan_phase(ak, l, lds); grid.sync();
        if (PHM & 64) post_phase(ak, l); grid.sync();
        if (DUPM & 2) { scan_phase(ak, l, lds); grid.sync(); post_phase(ak, l); grid.sync(); }
        if (DUPM & 4) { for (int q = 0; q < 16; ++q) grid.sync(); }
        if (PHM & 128) { const ArgsP a = launder(ak); const int G = opq_gdim(), bx = opq_bid(); unsigned char* ws = a->ws; unsigned char* ar = ws + WS_AR; bf16* H = (bf16*)(ws + WS_H); const float* adal = (const float*)(ws + WS_ADA) + l * 49152; (void)ar; (void)H; (void)adal;
          pg8::Gemm g{(const bf16*)(ar + AR_YRW), (const bf16*)(ar + AR_YCV), (const bf16*)(ar + AR_POOL), 4, (const bf16*)(ws + (l ? WS_WBR1 : WS_WBR0)), M, 3072, 512};
          pg8::StaticOrder S; S.init(M, g.N, G, bx);
          EpiBf<0> E{(bf16*)(ar + AR_P), 3072};
          pg8::gemm_phase<EpiBf<0>, pg8::StaticOrder, true, true>(lds, g, S, E); }
        grid.sync();
        if (PHM & 256) { const ArgsP a = launder(ak); const int G = opq_gdim(), bx = opq_bid(); unsigned char* ws = a->ws; unsigned char* ar = ws + WS_AR; bf16* H = (bf16*)(ws + WS_H); const float* adal = (const float*)(ws + WS_ADA) + l * 49152; (void)ar; (void)H; (void)adal;
          pg8::Gemm g{H, nullptr, nullptr, 0, (const bf16*)(ws + (l ? WS_WG1 : WS_WG0)), M, 3072, 1024};
          pg8::StaticOrder S; S.init(M, g.N, G, bx);
          EpiBf<2> E{(bf16*)(ar + AR_P), 3072};
          pg8::gemm_phase<EpiBf<2>, pg8::StaticOrder, true, true>(lds, g, S, E); }
        grid.sync();
        if (PHM & 512) combine_phase(ak); grid.sync();
        if (PHM & 1024) { const ArgsP a = launder(ak); const int G = opq_gdim(), bx = opq_bid(); unsigned char* ws = a->ws; unsigned char* ar = ws + WS_AR; bf16* H = (bf16*)(ws + WS_H); const float* adal = (const float*)(ws + WS_ADA) + l * 49152; (void)ar; (void)H; (void)adal;
          pg8::Gemm g{H, nullptr, nullptr, 0, (const bf16*)(ws + (l ? WS_WOUT1 : WS_WOUT0)), M, 1024, 1024};
          pg8::StaticOrder S; S.init(M, g.N, G, bx);
          EpiRes E{l ? (const float*)a->out : a->in[0], a->out, adal + 2 * 1024};
          pg8::gemm_phase<EpiRes, pg8::StaticOrder, true, true>(lds, g, S, E); }
        grid.sync();
        if (PHM & 2048) { const ArgsP a = launder(ak); const float* adal = (const float*)(a->ws + WS_ADA) + l * 49152;
          ln_phase(a->out, (bf16*)(a->ws + WS_H), a->in[30] + l * 1024, a->in[31] + l * 1024, adal + 3 * 1024, adal + 4 * 1024, true); }
        grid.sync();
        if (PHM & 4096) { const ArgsP a = launder(ak); const int G = opq_gdim(), bx = opq_bid(); unsigned char* ws = a->ws; unsigned char* ar = ws + WS_AR; bf16* H = (bf16*)(ws + WS_H); const float* adal = (const float*)(ws + WS_ADA) + l * 49152; (void)ar; (void)H; (void)adal;
          pg8::Gemm g{H, nullptr, nullptr, 0, (const bf16*)(ws + (l ? WS_W1_1 : WS_W1_0)), M, 4096, 1024};
          pg8::StaticOrder S; S.init(M, g.N, G, bx);
          EpiBf<1> E{(bf16*)(ar + AR_HID), 4096};
          pg8::gemm_phase<EpiBf<1>, pg8::StaticOrder, true, true>(lds, g, S, E); }
        grid.sync();
        if (PHM & 8192) { const ArgsP a = launder(ak); const int G = opq_gdim(), bx = opq_bid(); unsigned char* ws = a->ws; unsigned char* ar = ws + WS_AR; bf16* H = (bf16*)(ws + WS_H); const float* adal = (const float*)(ws + WS_ADA) + l * 49152; (void)ar; (void)H; (void)adal;
          pg8::Gemm g{(const bf16*)(ar + AR_HID), nullptr, nullptr, 0, (const bf16*)(ws + (l ? WS_W2_1 : WS_W2_0)), M, 1024, 4096};
          pg8::StaticOrder S; S.init(M, g.N, G, bx);
          EpiRes E{a->out, a->out, adal + 5 * 1024};
          pg8::gemm_phase<EpiRes, pg8::StaticOrder, true, true>(lds, g, S, E); }
        grid.sync();
        if (PHM & 16384) { const ArgsP a = launder(ak); const float* ada1 = (const float*)(a->ws + WS_ADA) + 49152;
          ln_phase(a->out, (bf16*)(a->ws + WS_H), a->in[34] + l * 1024, a->in[35] + l * 1024, ada1, ada1 + 1024, l == 0); }
        if (l == 0) grid.sync();
    }
}

extern "C" void kernel_launch(void* const* d_in, const int* in_sizes, int n_in, void* d_out, int out_size, void* d_ws, size_t ws_size, hipStream_t stream) {
    static int grid = 0;
    if (grid == 0) {
        if (n_in != 36 || out_size != M * D || ws_size < WS_END) { fprintf(stderr, "kernel_launch: unexpected shapes (n_in %d, out %d, ws %zu)\n", n_in, out_size, ws_size); grid = -1; return; }
        int dev = 0, cus = 0, per_cu = 0;
        hipGetDevice(&dev); hipDeviceGetAttribute(&cus, hipDeviceAttributeMultiprocessorCount, dev);
        hipFuncSetAttribute((const void*)fwd_kernel, hipFuncAttributeMaxDynamicSharedMemorySize, LDS_BYTES);
        hipOccupancyMaxActiveBlocksPerMultiprocessor(&per_cu, (const void*)fwd_kernel, 512, LDS_BYTES);
        (void)hipGetLastError();
        if (per_cu < 1) per_cu = 1;
        grid = cus;
        if (grid > 256) grid = 256;
    }
    if (grid < 0) return;
    Args ha{};
    for (int i = 0; i < 36; ++i) ha.in[i] = (const float*)d_in[i];
    ha.out = (float*)d_out; ha.ws = (unsigned char*)d_ws;
    void* params[] = {&ha};
    hipError_t e = hipLaunchCooperativeKernel((const void*)fwd_kernel, dim3(grid), dim3(512), params, LDS_BYTES, stream);
    if (e != hipSuccess) fprintf(stderr, "cooperative launch failed: %s (grid %d)\n", hipGetErrorString(e), grid);
}
```

```cpp
#include <hip/hip_runtime.h>
#include <hip/hip_cooperative_groups.h>
#include <cstdio>
#include <cstdint>
namespace cg = cooperative_groups;
__device__ __forceinline__ int opq_tid() { int t = threadIdx.x; asm volatile("" : "+v"(t)); return t; }
__device__ __forceinline__ int opq_bid() { int t = blockIdx.x; asm volatile("" : "+s"(t)); return t; }
__device__ __forceinline__ int opq_gdim() { int t = gridDim.x; asm volatile("" : "+s"(t)); return t; }
#ifndef DUPM
#define DUPM 0
#endif
#ifndef PHM
#define PHM 0x7fff
#endif
namespace pg8 {
#define PG8_LAS __attribute__((address_space(3)))
typedef unsigned short bf16_t;
typedef short bf16x8 __attribute__((ext_vector_type(8)));
typedef float f32x4 __attribute__((ext_vector_type(4)));
typedef unsigned u32x4 __attribute__((ext_vector_type(4)));
constexpr int BM = 256, BK = 64, HALF = 128, HTB = HALF * BK * 2  , STAGE_BYTES = 8 * HTB, NXCD = 8, WGM = 8;

__host__ __device__ __forceinline__ int lds_byte(int r, int c) { const int st = (r >> 4) * 2 + (c >> 5), rr = r & 15, cc = c & 31, ob = rr * 64 + cc * 2; return st * 1024 + (ob ^ (((ob >> 9) & 1) << 5)); }
__host__ __device__ __forceinline__ void stage_rc(int b, int& R, int& C) { const int st = b / 1024, sb = b % 1024, swz = sb ^ (((sb >> 9) & 1) << 5); R = (st >> 1) * 16 + swz / 64; C = (st & 1) * 32 + (swz % 64) / 2; }
__host__ __device__ __forceinline__ int perm32(int rho) { const int n = rho >> 4, i = rho & 15; return 8 * (i >> 2) + 4 * n + (i & 3); }

struct Unit { int pm, pn; };
struct Gemm { const bf16_t* A; const bf16_t* A1; const bf16_t* A2; int segt; const bf16_t* Bt; int M, N, K;
    __device__ __forceinline__ const bf16_t* a_of(int pn) const { return segt == 0 ? A : (pn < segt ? A : (pn < 2 * segt ? A1 : A2)); } };

struct StaticOrder {
    int nM, nN, nwg, G, c;
    __host__ __device__ void init(int M, int N, int G_, int c_) { nM = M / BM; nN = N / BM; nwg = nM * nN; G = G_; c = c_; }
    __host__ __device__ bool next(int i, Unit& u) const {
        const long L = (long)i * G + c; if (L >= nwg) return false;
        int wgid = (int)L; { const int q = nwg / NXCD, r = nwg % NXCD, xcd = wgid % NXCD, off = wgid / NXCD; wgid = (xcd < r ? xcd * (q + 1) : r * (q + 1) + (xcd - r) * q) + off; }
        const int nig = WGM * nN, gid = wgid / nig, fm = gid * WGM, gsz = (nM - fm) < WGM ? (nM - fm) : WGM;
        u.pm = fm + ((wgid % nig) % gsz); u.pn = (wgid % nig) / gsz; return true;
    }
    __device__ __forceinline__ void a_ready(const Unit&) const {}
    __device__ __forceinline__ void done(const Unit&) const {}
};
__device__ __forceinline__ unsigned cvt_pk_bf16(float lo, float hi) { unsigned r; asm volatile("v_cvt_pk_bf16_f32 %0, %1, %2" : "=v"(r) : "v"(lo), "v"(hi)); return r; }
template <class Epi, class Sched, bool ALIGN_EPI = false, bool SP2 = false>
__device__ __forceinline__ void gemm_phase(PG8_LAS unsigned char* lds, const Gemm g, const Sched& S, const Epi& E) {
    const int tid = opq_tid(), wid = __builtin_amdgcn_readfirstlane(tid >> 6), lane = tid & 63, wr = wid >> 2, wc = wid & 3, fr = lane & 15, fq = lane >> 4;
    const int K = g.K, nt = K / BK;
    unsigned voffA[2], voffB[2];
#pragma unroll
    for (int i = 0; i < 2; ++i) { int R, C; stage_rc(tid * 16 + i * 8192, R, C); const int Rb = Epi::PERM ? ((R & ~31) + perm32(R & 31)) : R;
        voffA[i] = (unsigned)(R * K + C) * 2u; voffB[i] = (unsigned)(Rb * K + C) * 2u; }
    const size_t kstep = (size_t)(BK * 2);
    const size_t hstep = (size_t)HALF * K * 2;
    const size_t tstep = 2 * hstep;
    const unsigned ldsw = (unsigned)wid * 1024u;
    const int aoff = lds_byte(wr * 64 + fr, fq * 8), boff = lds_byte(wc * 32 + fr, fq * 8);
#define PG8_SA(b, h) (((b) * 2 + (h)) * HTB)
#define PG8_SB(b, h) ((4 + (b) * 2 + (h)) * HTB)
#define PG8_STAGE(bufoff, gbase, voff) do { _Pragma("unroll") for (int _i = 0; _i < 2; ++_i) \
        __builtin_amdgcn_global_load_lds((const unsigned*)((const char*)(gbase) + (voff)[_i]), (PG8_LAS unsigned*)(lds + (bufoff) + ldsw + _i * 8192), 16, 0, 0); } while (0)
#define PG8_LDA(dst, b, h) do { _Pragma("unroll") for (int m = 0; m < 4; ++m) _Pragma("unroll") for (int k = 0; k < 2; ++k) dst[m][k] = *(const PG8_LAS bf16x8*)(lds + PG8_SA(b, h) + aoff + m * 2048 + k * 1024); } while (0)
#define PG8_LDB(dst, b, h) do { _Pragma("unroll") for (int n = 0; n < 2; ++n) _Pragma("unroll") for (int k = 0; k < 2; ++k) dst[n][k] = *(const PG8_LAS bf16x8*)(lds + PG8_SB(b, h) + boff + n * 2048 + k * 1024); } while (0)
#define PG8_MMA(ai, bj, At, Bt) do { __builtin_amdgcn_s_setprio(1); _Pragma("unroll") for (int m = 0; m < 4; ++m) _Pragma("unroll") for (int n = 0; n < 2; ++n) _Pragma("unroll") for (int k = 0; k < 2; ++k) \
        acc[ai][bj][m][n] = __builtin_amdgcn_mfma_f32_16x16x32_bf16(Bt[n][k], At[m][k], acc[ai][bj][m][n], 0, 0, 0); __builtin_amdgcn_s_setprio(0); } while (0)
#define PG8_WAIT_V(n) asm volatile("s_waitcnt vmcnt(" #n ")" ::: "memory")
#define PG8_WAIT_L(n) asm volatile("s_waitcnt lgkmcnt(" #n ")" ::: "memory")
#define PG8_BAR __builtin_amdgcn_s_barrier()
#define PG8_SCHED __builtin_amdgcn_sched_barrier(0)
    Unit cur, nxt; int ui = 0;
    if (!S.next(0, cur)) return;
    f32x4 acc[2][2][4][2];
#pragma unroll
    for (int a = 0; a < 2; ++a)
#pragma unroll
        for (int b = 0; b < 2; ++b)
#pragma unroll
            for (int m = 0; m < 4; ++m)
#pragma unroll
                for (int n = 0; n < 2; ++n) acc[a][b][m][n] = (f32x4){0.f, 0.f, 0.f, 0.f};
    bf16x8 At[4][2], B0[2][2], B1[2][2];
    const char* cA = (const char*)g.a_of(cur.pn) + (size_t)cur.pm * tstep; const char* cB = (const char*)g.Bt + (size_t)cur.pn * tstep;
    S.a_ready(cur);
    if constexpr (SP2) {
        PG8_STAGE(PG8_SB(0, 0), cB, voffB); PG8_STAGE(PG8_SB(0, 1), cB + hstep, voffB); PG8_STAGE(PG8_SA(0, 0), cA, voffA); PG8_STAGE(PG8_SA(0, 1), cA + hstep, voffA);
        if (wr == 1) PG8_BAR;
        PG8_WAIT_V(2); PG8_BAR;
        PG8_STAGE(PG8_SB(1, 0), cB + kstep, voffB); PG8_STAGE(PG8_SA(1, 0), cA + kstep, voffA); PG8_STAGE(PG8_SB(1, 1), cB + hstep + kstep, voffB);
        PG8_WAIT_V(6); PG8_BAR;
    } else {
        PG8_STAGE(PG8_SB(0, 0), cB, voffB); PG8_STAGE(PG8_SA(0, 0), cA, voffA); PG8_STAGE(PG8_SB(0, 1), cB + hstep, voffB); PG8_STAGE(PG8_SA(0, 1), cA + hstep, voffA);
        if (wr == 1) PG8_BAR;
        PG8_WAIT_V(4); PG8_BAR;
        PG8_STAGE(PG8_SB(1, 0), cB + kstep, voffB); PG8_STAGE(PG8_SA(1, 0), cA + kstep, voffA); PG8_STAGE(PG8_SB(1, 1), cB + hstep + kstep, voffB);
        PG8_WAIT_V(6); PG8_BAR;
    }
    for (;;) {
        const bool has_next = S.next(ui + 1, nxt);
        const char* nA = has_next ? (const char*)g.a_of(nxt.pn) + (size_t)nxt.pm * tstep : cA; const char* nB = has_next ? (const char*)g.Bt + (size_t)nxt.pn * tstep : cB;
        for (int t = 0; t < nt; t += 2) {
            const bool last = (t == nt - 2);
            const char* a1 = cA + (size_t)(t + 1) * kstep;
            const char* a2 = last ? nA : cA + (size_t)(t + 2) * kstep; const char* b2 = last ? nB : cB + (size_t)(t + 2) * kstep;
            const char* a3 = a2 + kstep; const char* b3 = b2 + kstep;
            if (last && has_next) S.a_ready(nxt);
            if constexpr (SP2) {
            PG8_LDB(B0, 0, 0); PG8_LDB(B1, 0, 1); PG8_SCHED; PG8_LDA(At, 0, 0); PG8_STAGE(PG8_SA(1, 1), a1 + hstep, voffA);
            PG8_WAIT_V(8); PG8_WAIT_L(0); PG8_BAR; PG8_MMA(0, 0, At, B0); PG8_MMA(0, 1, At, B1); PG8_BAR; PG8_SCHED;
            PG8_LDA(At, 0, 1); PG8_STAGE(PG8_SB(0, 0), b2, voffB); PG8_STAGE(PG8_SB(0, 1), b2 + hstep, voffB); PG8_STAGE(PG8_SA(0, 0), a2, voffA);
            PG8_WAIT_V(8); PG8_WAIT_L(0); PG8_BAR; PG8_MMA(1, 0, At, B0); PG8_MMA(1, 1, At, B1); PG8_BAR; PG8_SCHED;
            PG8_LDB(B0, 1, 0); PG8_LDB(B1, 1, 1); PG8_SCHED; PG8_LDA(At, 1, 0); PG8_STAGE(PG8_SA(0, 1), a2 + hstep, voffA);
            PG8_WAIT_V(8); PG8_WAIT_L(0); PG8_BAR; PG8_MMA(0, 0, At, B0); PG8_MMA(0, 1, At, B1); PG8_BAR; PG8_SCHED;
            PG8_LDA(At, 1, 1); PG8_STAGE(PG8_SB(1, 0), b3, voffB); PG8_STAGE(PG8_SB(1, 1), b3 + hstep, voffB); PG8_STAGE(PG8_SA(1, 0), a3, voffA);
            PG8_WAIT_V(8); PG8_WAIT_L(0); PG8_BAR; PG8_MMA(1, 0, At, B0); PG8_MMA(1, 1, At, B1); PG8_BAR; PG8_SCHED;
            } else {
            PG8_LDB(B0, 0, 0); PG8_SCHED; PG8_LDA(At, 0, 0); PG8_STAGE(PG8_SA(1, 1), a1 + hstep, voffA);
            PG8_WAIT_L(8); PG8_BAR; PG8_WAIT_L(0); PG8_MMA(0, 0, At, B0); PG8_BAR; PG8_SCHED;
            PG8_LDB(B1, 0, 1); PG8_STAGE(PG8_SB(0, 0), b2, voffB);
            PG8_BAR; PG8_WAIT_L(0); PG8_MMA(0, 1, At, B1); PG8_BAR;
            PG8_LDA(At, 0, 1); PG8_STAGE(PG8_SA(0, 0), a2, voffA);
            PG8_BAR; PG8_WAIT_L(0); PG8_MMA(1, 0, At, B0); PG8_BAR; PG8_SCHED;
            PG8_STAGE(PG8_SB(0, 1), b2 + hstep, voffB);
            PG8_WAIT_V(6); PG8_BAR; PG8_MMA(1, 1, At, B1); PG8_BAR;
            PG8_LDB(B0, 1, 0); PG8_SCHED; PG8_LDA(At, 1, 0); PG8_STAGE(PG8_SA(0, 1), a2 + hstep, voffA);
            PG8_WAIT_L(8); PG8_BAR; PG8_WAIT_L(0); PG8_MMA(0, 0, At, B0); PG8_BAR; PG8_SCHED;
            PG8_LDB(B1, 1, 1); PG8_STAGE(PG8_SB(1, 0), b3, voffB);
            PG8_BAR; PG8_WAIT_L(0); PG8_MMA(0, 1, At, B1); PG8_BAR;
            PG8_LDA(At, 1, 1); PG8_STAGE(PG8_SA(1, 0), a3, voffA);
            PG8_BAR; PG8_WAIT_L(0); PG8_MMA(1, 0, At, B0); PG8_BAR; PG8_SCHED;
            PG8_STAGE(PG8_SB(1, 1), b3 + hstep, voffB);
            PG8_WAIT_V(6); PG8_BAR; PG8_MMA(1, 1, At, B1); PG8_BAR;
            }
        }
        if constexpr (ALIGN_EPI) { if (wr == 0) PG8_BAR; }
        if constexpr (!Epi::AFTER_DRAIN) { E(acc, cur, wr, wc, fr, fq); S.done(cur); }
        if (!has_next) break;
#pragma unroll
        for (int a = 0; a < 2; ++a)
#pragma unroll
            for (int b = 0; b < 2; ++b)
#pragma unroll
                for (int m = 0; m < 4; ++m)
#pragma unroll
                    for (int n = 0; n < 2; ++n) acc[a][b][m][n] = (f32x4){0.f, 0.f, 0.f, 0.f};
        cur = nxt; cA = nA; cB = nB; ++ui;
        if constexpr (ALIGN_EPI) { if (wr == 1) PG8_BAR; }
    }
    PG8_WAIT_V(0);
    if constexpr (!ALIGN_EPI) { if (wr == 0) PG8_BAR; }
    PG8_BAR;
    if constexpr (Epi::AFTER_DRAIN) { E.fused(acc, cur, wr, wc, fr, fq, lds, wid, lane); S.done(cur); }
#undef PG8_SA
#undef PG8_SB
#undef PG8_STAGE
#undef PG8_LDA
#undef PG8_LDB
#undef PG8_MMA
#undef PG8_WAIT_V
#undef PG8_WAIT_L
#undef PG8_BAR
#undef PG8_SCHED
}
}

#define LAS __attribute__((address_space(3)))
typedef unsigned short bf16;
typedef pg8::f32x4 f32x4;
typedef pg8::u32x4 u32x4;
typedef unsigned u32x2 __attribute__((ext_vector_type(2)));
using pg8::Unit;

constexpr int M = 65536, D = 1024, SEQ = 8192;
constexpr float ALPHA = 1.4142135623730951f;
constexpr float LN_EPS = 1e-5f, GN_EPS = 64e-5f;
constexpr int LDS_BYTES = 147456;

constexpr size_t MiB = (size_t)1 << 20;
constexpr size_t WS_ADAP = 1 * MiB, WS_ADA = 4 * MiB, WS_WLORA0 = 5 * MiB, WS_WLORA1 = 6 * MiB, WS_WINA0 = 8 * MiB, WS_WINA1 = 15 * MiB,
    WS_WG0 = 22 * MiB, WS_WG1 = 28 * MiB, WS_WBR0 = 34 * MiB, WS_WBR1 = 37 * MiB, WS_WOUT0 = 40 * MiB, WS_WOUT1 = 42 * MiB,
    WS_W1_0 = 44 * MiB, WS_W1_1 = 52 * MiB, WS_W2_0 = 60 * MiB, WS_W2_1 = 68 * MiB, WS_VFIRST = 76 * MiB, WS_H = 140 * MiB, WS_AR = 268 * MiB;
constexpr size_t AR_ZR = 0, AR_CG = 224 * MiB, AR_PL = 288 * MiB, AR_LV = 352 * MiB, AR_LO = 224 * MiB, AR_YCV = 480 * MiB, AR_POOL = 544 * MiB,
    AR_YRW = 608 * MiB, AR_LA = 672 * MiB, AR_P = 0, AR_HID = 0;
constexpr size_t WS_END = WS_AR + 720 * MiB;

struct Args { const float* in[36]; float* out; unsigned char* ws; };
typedef const Args __attribute__((address_space(4)))* ArgsP;
__device__ __forceinline__ ArgsP launder(ArgsP p) { asm volatile("" : "+s"(p)); return p; }

#define LDS_WAIT() asm volatile("s_waitcnt lgkmcnt(0)" ::: "memory")
__device__ __forceinline__ unsigned f2bf(float f) { unsigned u = __builtin_bit_cast(unsigned, f); return (u + 0x7fffu + ((u >> 16) & 1u)) >> 16; }
__device__ __forceinline__ unsigned pk2(float lo, float hi) { return pg8::cvt_pk_bf16(lo, hi); }
__device__ __forceinline__ float bflo(unsigned u) { return __uint_as_float(u << 16); }
__device__ __forceinline__ float bfhi(unsigned u) { return __uint_as_float(u & 0xffff0000u); }
__device__ __forceinline__ float bf1(unsigned short u) { return __uint_as_float(((unsigned)u) << 16); }
__device__ __forceinline__ float sigm(float x) { return 1.f / (1.f + __expf(-x)); }
__device__ __forceinline__ void unpack8(const u32x4 v, float (&o)[8]) { o[0] = bflo(v.x); o[1] = bfhi(v.x); o[2] = bflo(v.y); o[3] = bfhi(v.y); o[4] = bflo(v.z); o[5] = bfhi(v.z); o[6] = bflo(v.w); o[7] = bfhi(v.w); }
__device__ __forceinline__ u32x4 pack8(const float (&o)[8]) { u32x4 r; r.x = pk2(o[0], o[1]); r.y = pk2(o[2], o[3]); r.z = pk2(o[4], o[5]); r.w = pk2(o[6], o[7]); return r; }
__device__ __forceinline__ void load8f(const float* p, float (&o)[8]) { const f32x4 a = *(const f32x4*)p, b = *(const f32x4*)(p + 4); o[0] = a.x; o[1] = a.y; o[2] = a.z; o[3] = a.w; o[4] = b.x; o[5] = b.y; o[6] = b.z; o[7] = b.w; }
__device__ __forceinline__ float wave_sum(float v) {
#pragma unroll
    for (int o = 1; o < 64; o <<= 1) v += __shfl_xor(v, o);
    return v;
}
template <int CTRL> __device__ __forceinline__ float dppf(float x) { return __builtin_bit_cast(float, __builtin_amdgcn_update_dpp(0, __builtin_bit_cast(int, x), CTRL, 0xF, 0xF, true)); }
__device__ __forceinline__ float red4(float x) { x += dppf<0xB1>(x); x += dppf<0x4E>(x); return x; }
__device__ __forceinline__ float red8(float x) { x = red4(x); x += dppf<0x141>(x); return x; }
__device__ __forceinline__ float red16(float x) { x = red8(x); x += dppf<0x140>(x); return x; }

__device__ __forceinline__ void store8(bf16* p, const f32x4 v0, const f32x4 v1) {
    u32x4 w; w.x = pk2(v0[0], v0[1]); w.y = pk2(v0[2], v0[3]); w.z = pk2(v1[0], v1[1]); w.w = pk2(v1[2], v1[3]); *(u32x4*)p = w;
}
struct EpiG1 {
    static constexpr bool PERM = true, AFTER_DRAIN = false;
    bf16 *ZR, *CG, *PL, *LV;
    __device__ __forceinline__ void operator()(const f32x4 (&acc)[2][2][4][2], const Unit& u, int wr, int wc, int fr, int fq) const {
        const int row0 = u.pm * 256 + wr * 64 + fr, pn = u.pn, cin = wc * 32 + 8 * fq;
        if (pn < 7 || (pn >= 11 && pn < 13)) {
            bf16* base = pn < 7 ? ZR : PL; const int ldc = pn < 7 ? 1792 : 512, col0 = (pn < 7 ? pn : pn - 11) * 256 + cin;
#pragma unroll
            for (int ai = 0; ai < 2; ++ai)
#pragma unroll
                for (int m = 0; m < 4; ++m) { bf16* rp = base + (size_t)(row0 + ai * 128 + m * 16) * ldc + col0;
#pragma unroll
                    for (int bj = 0; bj < 2; ++bj) store8(rp + bj * 128, acc[ai][bj][m][0], acc[ai][bj][m][1]); }
        } else if (pn < 11) {
            const int col0 = (pn - 7) * 128 + cin;
#pragma unroll
            for (int ai = 0; ai < 2; ++ai)
#pragma unroll
                for (int m = 0; m < 4; ++m) { f32x4 h0, h1;
#pragma unroll
                    for (int i = 0; i < 4; ++i) { h0[i] = acc[ai][0][m][0][i] * sigm(acc[ai][1][m][0][i]); h1[i] = acc[ai][0][m][1][i] * sigm(acc[ai][1][m][1][i]); }
                    store8(CG + (size_t)(row0 + ai * 128 + m * 16) * 512 + col0, h0, h1); }
        } else {
            if (wc == 0) {
#pragma unroll
                for (int ai = 0; ai < 2; ++ai)
#pragma unroll
                    for (int m = 0; m < 4; ++m) store8(LV + (size_t)(row0 + ai * 128 + m * 16) * 32 + 8 * fq, acc[ai][0][m][0], acc[ai][0][m][1]);
            }
        }
    }
};
struct EpiLora {
    static constexpr bool PERM = true, AFTER_DRAIN = false;
    bf16* O; int ldc; const float *w0, *a0, *v0;
    __device__ __forceinline__ void operator()(const f32x4 (&acc)[2][2][4][2], const Unit& u, int wr, int wc, int fr, int fq) const {
        const int row0 = u.pm * 256 + wr * 64 + fr, type = u.pn >> 1, cin = wc * 32 + 8 * fq;
#pragma unroll
        for (int bj = 0; bj < 2; ++bj) {
            const int cb = u.pn * 256 + bj * 128 + cin, pc = cb & 511;
            f32x4 p0 = (f32x4){0.f, 0.f, 0.f, 0.f}, p1 = p0;
            if (type == 0) { p0 = *(const f32x4*)(w0 + pc); p1 = *(const f32x4*)(w0 + pc + 4); }
            else if (type == 1) { p0 = *(const f32x4*)(a0 + pc); p1 = *(const f32x4*)(a0 + pc + 4); }
            else if (type == 3) { p0 = *(const f32x4*)(v0 + pc); p1 = *(const f32x4*)(v0 + pc + 4); }
#pragma unroll
            for (int ai = 0; ai < 2; ++ai)
#pragma unroll
                for (int m = 0; m < 4; ++m) { f32x4 v0_ = acc[ai][bj][m][0] + p0, v1_ = acc[ai][bj][m][1] + p1;
                    if (type != 2) {
                        const float sc = type == 0 ? 0.60653065971f : 1.f;
#pragma unroll
                        for (int i = 0; i < 4; ++i) { v0_[i] = sc * sigm(v0_[i]); v1_[i] = sc * sigm(v1_[i]); } }
                    store8(O + (size_t)(row0 + ai * 128 + m * 16) * ldc + cb, v0_, v1_); }
        }
    }
};
template <int MODE  > struct EpiBf {
    static constexpr bool PERM = true, AFTER_DRAIN = false;
    bf16* O; int ldc;
    __device__ __forceinline__ void operator()(const f32x4 (&acc)[2][2][4][2], const Unit& u, int wr, int wc, int fr, int fq) const {
        const int row0 = u.pm * 256 + wr * 64 + fr, col0 = u.pn * 256 + wc * 32 + 8 * fq;
#pragma unroll
        for (int ai = 0; ai < 2; ++ai)
#pragma unroll
            for (int m = 0; m < 4; ++m) { bf16* rp = O + (size_t)(row0 + ai * 128 + m * 16) * ldc + col0;
#pragma unroll
                for (int bj = 0; bj < 2; ++bj) { f32x4 v0 = acc[ai][bj][m][0], v1 = acc[ai][bj][m][1];
                    if (MODE == 1) {
#pragma unroll
                        for (int i = 0; i < 4; ++i) { const float a = fmaxf(v0[i], 0.f), b = fmaxf(v1[i], 0.f); v0[i] = a * a; v1[i] = b * b; } }
                    if (MODE == 2) { float p[8]; unpack8(*(const u32x4*)(rp + bj * 128), p);
#pragma unroll
                        for (int i = 0; i < 4; ++i) { v0[i] = sigm(v0[i]) * p[i]; v1[i] = sigm(v1[i]) * p[4 + i]; } }
                    store8(rp + bj * 128, v0, v1); } }
    }
};
struct EpiRes {
    static constexpr bool PERM = false, AFTER_DRAIN = false;
    const float* xin; float* out; const float* gt;
    __device__ __forceinline__ void operator()(const f32x4 (&acc)[2][2][4][2], const Unit& u, int wr, int wc, int fr, int fq) const {
        const float* gtb = gt + (size_t)(u.pm >> 5) * 6144; const int col0 = u.pn * 256 + wc * 32 + 4 * fq;
        f32x4 g4[2][2];
#pragma unroll
        for (int bj = 0; bj < 2; ++bj)
#pragma unroll
            for (int n = 0; n < 2; ++n) g4[bj][n] = *(const f32x4*)(gtb + col0 + bj * 128 + n * 16);
#pragma unroll
        for (int ai = 0; ai < 2; ++ai)
#pragma unroll
            for (int m = 0; m < 4; ++m) { const size_t off = (size_t)(u.pm * 256 + ai * 128 + wr * 64 + m * 16 + fr) * 1024 + col0;
#pragma unroll
                for (int bj = 0; bj < 2; ++bj)
#pragma unroll
                    for (int n = 0; n < 2; ++n) { const f32x4 x4 = *(const f32x4*)(xin + off + bj * 128 + n * 16);
                        *(f32x4*)(out + off + bj * 128 + n * 16) = x4 * ALPHA + g4[bj][n] * acc[ai][bj][m][n]; } }
    }
};

__device__ __forceinline__ void tr_item(const float* W, int N, int k0, int n0, bf16* dst, int K, LAS float* scr, int lane) {
#pragma unroll 8
    for (int i = 0; i < 32; ++i) { const int kk = 2 * i + (lane >> 5); scr[kk * 33 + (lane & 31)] = W[(size_t)(k0 + kk) * N + n0 + (lane & 31)]; }
    LDS_WAIT(); asm volatile("" ::: "memory");
    const int c = lane & 7;
#pragma unroll
    for (int j = 0; j < 4; ++j) { const int n = (lane >> 3) + 8 * j; const LAS float* s = scr + (8 * c) * 33 + n;
        u32x4 o; o.x = pk2(s[0 * 33], s[1 * 33]); o.y = pk2(s[2 * 33], s[3 * 33]); o.z = pk2(s[4 * 33], s[5 * 33]); o.w = pk2(s[6 * 33], s[7 * 33]);
        *(u32x4*)(dst + (size_t)n * K + 8 * c) = o; }
    LDS_WAIT(); asm volatile("" ::: "memory");
}
__device__ __forceinline__ bf16* win_dst(unsigned char* ws, int l, int n0) {
    bf16* wina = (bf16*)(ws + (l ? WS_WINA1 : WS_WINA0)); bf16* wg = (bf16*)(ws + (l ? WS_WG1 : WS_WG0));
    if (n0 < 1792) return wina + (size_t)n0 * 1024;
    if (n0 < 2816) { const int c = n0 - 1792, half = c >> 9, cc = c & 511, j = cc >> 7, i = cc & 127; return wina + (size_t)(1792 + j * 256 + half * 128 + i) * 1024; }
    if (n0 < 3328) return wina + (size_t)n0 * 1024;
    return wg + (size_t)(n0 - 3328) * 1024;
}
__device__ __forceinline__ void p0_phase(ArgsP a_, LAS unsigned char* lds) {
    const ArgsP a = launder(a_);
    const int tid = opq_tid(), lane = tid & 63, wave = tid >> 6, G = opq_gdim();
    const int gw = opq_bid() * 8 + wave, NGW = G * 8, gt = opq_bid() * 512 + tid, NT = G * 512;
    unsigned char* ws = a->ws;
    LAS float* scr = (LAS float*)(lds + wave * 8448);
    for (int it = gw; it < 16656; it += NGW) {
        int r = it;
        if (r >= 16640) { const int kb = r - 16640; tr_item(a->in[5], 32, 64 * kb, 0, (bf16*)(ws + WS_WINA1) + (size_t)3328 * 1024 + 64 * kb, 1024, scr, lane); continue; }
        const int l = r >= 8320 ? 1 : 0; r -= l * 8320;
        if (r < 3200) { const int kb = r / 200, nb = r % 200; tr_item(a->in[4] + (size_t)l * 1024 * 6400, 6400, 64 * kb, 32 * nb, win_dst(ws, l, 32 * nb) + 64 * kb, 1024, scr, lane); continue; } r -= 3200;
        bf16* wbr = (bf16*)(ws + (l ? WS_WBR1 : WS_WBR0));
        if (r < 256) { const int kb = r >> 5, nb = r & 31; tr_item(a->in[20] + (size_t)l * 512 * 1024, 1024, 64 * kb, 32 * nb, wbr + (size_t)(32 * nb) * 512 + 64 * kb, 512, scr, lane); continue; } r -= 256;
        if (r < 256) { const int kb = r >> 5, nb = r & 31; tr_item(a->in[25] + (size_t)l * 512 * 1024, 1024, 64 * kb, 32 * nb, wbr + (size_t)(1024 + 32 * nb) * 512 + 64 * kb, 512, scr, lane); continue; } r -= 256;
        if (r < 512) { const int kb = r >> 5, nb = r & 31; tr_item(a->in[29] + (size_t)l * 1024 * 1024, 1024, 64 * kb, 32 * nb, (bf16*)(ws + (l ? WS_WOUT1 : WS_WOUT0)) + (size_t)(32 * nb) * 1024 + 64 * kb, 1024, scr, lane); continue; } r -= 512;
        if (r < 2048) { const int kb = r >> 7, nb = r & 127; tr_item(a->in[32] + (size_t)l * 1024 * 4096, 4096, 64 * kb, 32 * nb, (bf16*)(ws + (l ? WS_W1_1 : WS_W1_0)) + (size_t)(32 * nb) * 1024 + 64 * kb, 1024, scr, lane); continue; } r -= 2048;
        { const int kb = r >> 5, nb = r & 31; tr_item(a->in[33] + (size_t)l * 4096 * 1024, 1024, 64 * kb, 32 * nb, (bf16*)(ws + (l ? WS_W2_1 : WS_W2_0)) + (size_t)(32 * nb) * 4096 + 64 * kb, 4096, scr, lane); }
    }
    { u32x4* z = (u32x4*)((bf16*)(ws + WS_WINA1) + (size_t)3360 * 1024); for (int i = gt; i < 28672; i += NT) z[i] = (u32x4){0u, 0u, 0u, 0u}; }
    { bf16* w = (bf16*)(ws + WS_WLORA0);
      for (int i = gt; i < 1536 * 256; i += NT) { const int n = i >> 8, k = i & 255; float v = 0.f;
          if (n < 512) { if (k < 64) v = a->in[9][k * 512 + n]; }
          else if (n < 1024) { if (k >= 64 && k < 128) v = a->in[11][(k - 64) * 512 + n - 512]; }
          else { if (k >= 128) v = a->in[12][(k - 128) * 512 + n - 1024]; }
          w[i] = (bf16)f2bf(v); } }
    { bf16* w = (bf16*)(ws + WS_WLORA1);
      for (int i = gt; i < 2048 * 384; i += NT) { const int n = i / 384, k = i % 384; float v = 0.f;
          if (n < 512) { if (k < 64) v = a->in[9][64 * 512 + k * 512 + n]; }
          else if (n < 1024) { if (k >= 64 && k < 128) v = a->in[11][64 * 512 + (k - 64) * 512 + n - 512]; }
          else if (n < 1536) { if (k >= 128 && k < 256) v = a->in[12][128 * 512 + (k - 128) * 512 + n - 1024]; }
          else { if (k >= 256 && k < 288) v = a->in[14][(k - 256) * 512 + n - 1536]; }
          w[i] = (bf16)f2bf(v); } }
    for (int idx = gt; idx < 131072; idx += NT) {
        const int n = idx & 1023, cg8 = (idx >> 10) & 63, l = idx >> 16, g = cg8 >> 4, c0 = (cg8 & 15) * 8;
        const float* plw = a->in[26] + ((size_t)(l * 4 + g) * 128 + c0) * 128; const float* pls = a->in[27] + l * 512 + g * 128; const float* plo = a->in[28] + ((size_t)l * 512 + g * 128) * 1024 + n;
        float acc[8];
#pragma unroll
        for (int i = 0; i < 8; ++i) acc[i] = 0.f;
        for (int d = 0; d < 128; ++d) { const float bw = plo[(size_t)d * 1024] * pls[d];
#pragma unroll
            for (int i = 0; i < 8; ++i) acc[i] += plw[i * 128 + d] * bw; }
        bf16* wbr = (bf16*)(ws + (l ? WS_WBR1 : WS_WBR0));
        *(u32x4*)(wbr + (size_t)(2048 + n) * 512 + g * 128 + c0) = pack8(acc);
    }
    float* adap = (float*)(ws + WS_ADAP);
    for (int wt = gw; wt < 1536; wt += NGW) {
        const int l = wt / 768, r = wt % 768, cb = r >> 3, kc = r & 7, col = cb * 64 + lane;
#pragma unroll
        for (int i = 0; i < 16; ++i) { const int idx = lane + 64 * i, b = idx >> 7, kk = idx & 127; const float x = a->in[1][b * 1024 + kc * 128 + kk]; scr[idx] = x * sigm(x); }
        LDS_WAIT(); asm volatile("" ::: "memory");
        float acc[8];
#pragma unroll
        for (int b = 0; b < 8; ++b) acc[b] = 0.f;
        const float* wp = a->in[2] + ((size_t)l * 1024 + kc * 128) * 6144 + col;
#pragma unroll 4
        for (int kk = 0; kk < 128; ++kk) { const float w = wp[(size_t)kk * 6144];
#pragma unroll
            for (int b = 0; b < 8; ++b) acc[b] += scr[b * 128 + kk] * w; }
#pragma unroll
        for (int b = 0; b < 8; ++b) adap[((size_t)(l * 8 + kc) * 8 + b) * 6144 + col] = acc[b];
        LDS_WAIT(); asm volatile("" ::: "memory");
    }
}
__device__ __forceinline__ void p0b_phase(ArgsP a_) {
    const ArgsP a = launder(a_);
    const int tid = opq_tid(), lane = tid & 63, wave = tid >> 6, G = opq_gdim();
    const int gw = opq_bid() * 8 + wave, NGW = G * 8, gt = opq_bid() * 512 + tid, NT = G * 512;
    const float* adap = (const float*)(a->ws + WS_ADAP); float* ada = (float*)(a->ws + WS_ADA);
    for (int i = gt; i < 2 * 49152; i += NT) { const int l = i / 49152, r = i % 49152, col = r % 6144; float s = a->in[3][l * 6144 + col];
#pragma unroll
        for (int kc = 0; kc < 8; ++kc) s += adap[(size_t)(l * 8 + kc) * 49152 + r];
        ada[i] = s; }
    bf16* H = (bf16*)(a->ws + WS_H);
    for (int rb = gw; rb < 2048; rb += NGW) {
        const int b = rb >> 8; f32x4 sh[4], sc[4];
#pragma unroll
        for (int j = 0; j < 4; ++j) { const int col = 4 * lane + 256 * j; f32x4 s0 = *(const f32x4*)(a->in[3] + col), s1 = *(const f32x4*)(a->in[3] + 1024 + col);
#pragma unroll
            for (int kc = 0; kc < 8; ++kc) { s0 += *(const f32x4*)(adap + (size_t)kc * 49152 + b * 6144 + col); s1 += *(const f32x4*)(adap + (size_t)kc * 49152 + b * 6144 + 1024 + col); }
            sh[j] = s0; sc[j] = s1 + 1.f; }
        for (int rr = 0; rr < 32; ++rr) { const size_t m = (size_t)rb * 32 + rr;
#pragma unroll
            for (int j = 0; j < 4; ++j) { const int col = 4 * lane + 256 * j; const f32x4 x = *(const f32x4*)(a->in[0] + m * 1024 + col); const f32x4 h = x * sc[j] + sh[j];
                u32x2 w; w.x = pk2(h[0], h[1]); w.y = pk2(h[2], h[3]); *(u32x2*)(H + m * 1024 + col) = w; } }
    }
}
__device__ __forceinline__ void ln_phase(float* X, bf16* H, const float* gam, const float* bet, const float* adash  , const float* adasc, bool writeH) {
    const int tid = opq_tid(), lane = tid & 63, wave = tid >> 6, gw = opq_bid() * 8 + wave, NGW = opq_gdim() * 8;
    for (int rb = gw; rb < 2048; rb += NGW) {
        const int b = rb >> 8; f32x4 g4[4], b4[4], sh[4], sc[4];
#pragma unroll
        for (int j = 0; j < 4; ++j) { const int col = 4 * lane + 256 * j; g4[j] = *(const f32x4*)(gam + col); b4[j] = *(const f32x4*)(bet + col);
            if (writeH) { sh[j] = *(const f32x4*)(adash + b * 6144 + col); sc[j] = *(const f32x4*)(adasc + b * 6144 + col) + 1.f; } else { sh[j] = g4[j]; sc[j] = g4[j]; } }
        for (int rr = 0; rr < 32; ++rr) { const size_t m = (size_t)rb * 32 + rr; f32x4 v[4]; float s = 0.f;
#pragma unroll
            for (int j = 0; j < 4; ++j) { v[j] = *(const f32x4*)(X + m * 1024 + 4 * lane + 256 * j); s += (v[j][0] + v[j][1]) + (v[j][2] + v[j][3]); }
            const float mean = wave_sum(s) * (1.f / 1024.f); float q = 0.f;
#pragma unroll
            for (int j = 0; j < 4; ++j) { v[j] = v[j] - mean; q += (v[j][0] * v[j][0] + v[j][1] * v[j][1]) + (v[j][2] * v[j][2] + v[j][3] * v[j][3]); }
            const float rstd = 1.0f / sqrtf(wave_sum(q) * (1.f / 1024.f) + LN_EPS);
#pragma unroll
            for (int j = 0; j < 4; ++j) { const int col = 4 * lane + 256 * j; const f32x4 y = v[j] * rstd * g4[j] + b4[j]; *(f32x4*)(X + m * 1024 + col) = y;
                if (writeH) { const f32x4 h = y * sc[j] + sh[j]; u32x2 w; w.x = pk2(h[0], h[1]); w.y = pk2(h[2], h[3]); *(u32x2*)(H + m * 1024 + col) = w; } } }
    }
}
__device__ __forceinline__ void prep_phase(ArgsP a_, int l, LAS unsigned char* lds) {
    const ArgsP a = launder(a_);
    const int tid = opq_tid(), lane = tid & 63, wave = tid >> 6, gw = opq_bid() * 8 + wave, NGW = opq_gdim() * 8;
    unsigned char* ar = a->ws + WS_AR;
    const bf16* ZR = (const bf16*)(ar + AR_ZR); const bf16* CG = (const bf16*)(ar + AR_CG); const bf16* PL = (const bf16*)(ar + AR_PL); const bf16* LV = (const bf16*)(ar + AR_LV);
    bf16* LA = (bf16*)(ar + AR_LA); bf16* YCV = (bf16*)(ar + AR_YCV); bf16* POOL = (bf16*)(ar + AR_POOL);
    LAS float* cw = (LAS float*)lds;
    for (int i = tid; i < 31 * 512; i += 512) cw[i] = a->in[21][l * 31 * 512 + i];
    __syncthreads();
    const int c8 = 8 * lane, ldA = l ? 384 : 256;
    float cvb[8], lng[8], lnb[8], mu[8];
    load8f(a->in[22] + l * 512 + c8, cvb); load8f(a->in[23] + l * 512 + c8, lng); load8f(a->in[24] + l * 512 + c8, lnb);
    if (lane < 32) load8f(a->in[6] + l * 1792 + 1536 + c8, mu);
    else if (l && lane < 36) load8f(a->in[7] + 8 * (lane - 32), mu);
    else {
#pragma unroll
        for (int i = 0; i < 8; ++i) mu[i] = 0.f; }
    for (int rb = gw; rb < 2048; rb += NGW)
        for (int rr = 0; rr < 32; ++rr) {
            const size_t m = (size_t)rb * 32 + rr; const int s = (int)(m & 8191);
            if (lane < 32 || (l && lane < 36)) {
                const bf16* src = lane < 32 ? ZR + m * 1792 + 1536 + c8 : LV + m * 32 + 8 * (lane - 32); const int ldp = lane < 32 ? 1792 : 32;
                float zt[8], zp[8]; unpack8(*(const u32x4*)src, zt);
                if (s > 0) unpack8(*(const u32x4*)(src - ldp), zp); else {
#pragma unroll
                    for (int i = 0; i < 8; ++i) zp[i] = 0.f; }
#pragma unroll
                for (int i = 0; i < 8; ++i) { float z = zt[i] + (zp[i] - zt[i]) * mu[i];
                    if (lane < 8) z = 1.f - 2.f / (1.f + __expf(2.f * z)); else if (lane >= 16 && lane < 32) z = sigm(z);
                    zt[i] = z; }
                *(u32x4*)(LA + m * ldA + (lane < 32 ? c8 : 256 + 8 * (lane - 32))) = pack8(zt);
            } else if (l && lane < 48) { *(u32x4*)(LA + m * ldA + c8) = (u32x4){0u, 0u, 0u, 0u}; }
            { float acc[8]; u32x4 xr[31];
#pragma unroll
              for (int j = 0; j < 31; ++j) { const size_t row = (s - 30 + j >= 0) ? (m - 30 + j) : (m - s); xr[j] = *(const u32x4*)(CG + row * 512 + c8); }
#pragma unroll
              for (int i = 0; i < 8; ++i) acc[i] = cvb[i];
#pragma unroll
              for (int j = 0; j < 31; ++j) if (s - 30 + j >= 0) { float x[8]; unpack8(xr[j], x);
                  const f32x4 w0 = *(const LAS f32x4*)(cw + j * 512 + c8), w1 = *(const LAS f32x4*)(cw + j * 512 + c8 + 4);
#pragma unroll
                  for (int i = 0; i < 4; ++i) { acc[i] += x[i] * w0[i]; acc[4 + i] += x[4 + i] * w1[i]; } }
              float s1 = 0.f;
#pragma unroll
              for (int i = 0; i < 8; ++i) s1 += acc[i];
              const float mean = wave_sum(s1) * (1.f / 512.f); float q = 0.f;
#pragma unroll
              for (int i = 0; i < 8; ++i) { acc[i] -= mean; q += acc[i] * acc[i]; }
              const float rstd = 1.0f / sqrtf(wave_sum(q) * (1.f / 512.f) + LN_EPS);
#pragma unroll
              for (int i = 0; i < 8; ++i) { const float y = acc[i] * rstd * lng[i] + lnb[i]; acc[i] = y * sigm(y); }
              *(u32x4*)(YCV + m * 512 + c8) = pack8(acc); }
            { const int win = 2 << (lane >> 4), cnt = (s + 1) < win ? (s + 1) : win; u32x4 pr[16];
#pragma unroll
              for (int i = 0; i < 16; ++i) { const size_t row = (i <= s) ? (m - i) : m; pr[i] = *(const u32x4*)(PL + row * 512 + c8); }
              float x0[8], sum[8]; unpack8(pr[0], x0);
#pragma unroll
              for (int i = 0; i < 8; ++i) sum[i] = x0[i];
#pragma unroll
              for (int i = 1; i < 16; ++i) { float x[8]; unpack8(pr[i], x); const float f = i < cnt ? 1.f : 0.f;
#pragma unroll
                  for (int q = 0; q < 8; ++q) sum[q] += x[q] * f; }
              const float inv = 1.f / (float)cnt;
#pragma unroll
              for (int i = 0; i < 8; ++i) sum[i] = sum[i] * inv - x0[i];
              *(u32x4*)(POOL + m * 512 + c8) = pack8(sum); }
        }
    __syncthreads();
}
struct HSet { u32x2 rt[2], kt[2], rp[2], kp[2], ee[2], aa[2]; unsigned short vt[2], vp[2], vm[2], vf[2]; };
constexpr int SC_VV = 0, SC_YP = 4096, SC_OPS = 20480;
__device__ __forceinline__ void sc_load(HSet& S, int c, int l, int b, int h, int rg, int hl, const bf16* ZR, const bf16* LO, int ldlo, const bf16* VF) {
    if (c >= 256) return;
    const int cg = hl & 15, vc = h * 64 + 16 * rg + cg;
#pragma unroll
    for (int p = 0; p < 2; ++p) {
        const int t = (hl >> 4) + 16 * p, s = c * 32 + t; const size_t m = (size_t)b * 8192 + s;
        const bf16* zr = ZR + m * 1792; const bf16* lo = LO + m * ldlo;
        S.rt[p] = *(const u32x2*)(zr + h * 64 + 4 * cg); S.kt[p] = *(const u32x2*)(zr + 512 + h * 64 + 4 * cg); S.vt[p] = zr[1024 + vc];
        if (s > 0) { S.rp[p] = *(const u32x2*)(zr - 1792 + h * 64 + 4 * cg); S.kp[p] = *(const u32x2*)(zr - 1792 + 512 + h * 64 + 4 * cg); S.vp[p] = zr[-1792 + 1024 + vc]; }
        else { S.rp[p] = (u32x2){0u, 0u}; S.kp[p] = (u32x2){0u, 0u}; S.vp[p] = 0; }
        S.ee[p] = *(const u32x2*)(lo + h * 64 + 4 * cg); S.aa[p] = *(const u32x2*)(lo + 512 + h * 64 + 4 * cg);
        if (l) { S.vm[p] = lo[1536 + vc]; S.vf[p] = VF[m * 512 + vc]; } else { S.vm[p] = 0; S.vf[p] = 0; }
    }
}
__device__ __forceinline__ void sc_prep(const HSet& S, int c, int buf, int l, int b, int h, int rg, int hl, LAS unsigned char* lds, bf16* VF,
                                        const f32x4 mur, const f32x4 muk, const f32x4 kkc, const f32x4 kac, const float muv) {
    if (c >= 256) return;
    const int cg = hl & 15, vc = h * 64 + 16 * rg + cg;
#pragma unroll
    for (int p = 0; p < 2; ++p) {
        const int t = (hl >> 4) + 16 * p; const size_t m = (size_t)b * 8192 + c * 32 + t;
        f32x4 rt = {bflo(S.rt[p].x), bfhi(S.rt[p].x), bflo(S.rt[p].y), bfhi(S.rt[p].y)}, rp = {bflo(S.rp[p].x), bfhi(S.rp[p].x), bflo(S.rp[p].y), bfhi(S.rp[p].y)};
        f32x4 kt = {bflo(S.kt[p].x), bfhi(S.kt[p].x), bflo(S.kt[p].y), bfhi(S.kt[p].y)}, kp = {bflo(S.kp[p].x), bfhi(S.kp[p].x), bflo(S.kp[p].y), bfhi(S.kp[p].y)};
        const f32x4 e = {bflo(S.ee[p].x), bfhi(S.ee[p].x), bflo(S.ee[p].y), bfhi(S.ee[p].y)}, av = {bflo(S.aa[p].x), bfhi(S.aa[p].x), bflo(S.aa[p].y), bfhi(S.aa[p].y)};
        const f32x4 r = rt + (rp - rt) * mur, k = kt + (kp - kt) * muk;
        f32x4 w; w[0] = __expf(-e[0]); w[1] = __expf(-e[1]); w[2] = __expf(-e[2]); w[3] = __expf(-e[3]);
        f32x4 kk = k * kkc; const float ss = red16((kk[0] * kk[0] + kk[1] * kk[1]) + (kk[2] * kk[2] + kk[3] * kk[3]));
        kk = kk * __builtin_amdgcn_rsqf(fmaxf(ss, 1e-24f));
        const f32x4 kh = k * ((av - 1.f) * kac + 1.f);
        LAS float* o = (LAS float*)(lds + SC_OPS) + (buf * 32 + t) * 320 + 4 * cg;
        *(LAS f32x4*)(o) = w; *(LAS f32x4*)(o + 64) = -kk; *(LAS f32x4*)(o + 128) = kk * av; *(LAS f32x4*)(o + 192) = kh; *(LAS f32x4*)(o + 256) = r;
        const float vt = bf1(S.vt[p]), vp = bf1(S.vp[p]); float v = vt + (vp - vt) * muv;
        if (l) v = v + (bf1(S.vf[p]) - v) * bf1(S.vm[p]); else VF[m * 512 + vc] = (bf16)pk2(v, v);
        ((LAS float*)(lds + SC_VV))[(buf * 32 + t) * 16 + cg] = v;
    }
}
__device__ __forceinline__ void sc_yred(int c, int buf, int b, int h, int rg, int hl, LAS unsigned char* lds, bf16* YRW) {
    const int i = hl & 15;
#pragma unroll
    for (int p = 0; p < 2; ++p) { const int t = (hl >> 4) + 16 * p; const size_t m = (size_t)b * 8192 + c * 32 + t;
        const f32x4 q = *(const LAS f32x4*)((LAS float*)(lds + SC_YP) + ((buf * 32 + t) * 16 + i) * 4);
        const float ys = (q[0] + q[1]) + (q[2] + q[3]); YRW[m * 512 + h * 64 + 16 * rg + i] = (bf16)pk2(ys, ys); }
}
typedef float f32x2 __attribute__((ext_vector_type(2)));
struct ScOp { f32x4 w, a, b, k, r; float v; };
__device__ __forceinline__ ScOp sc_ld(const LAS float* ops, const LAS float* vv, int t) {
    ScOp o; o.w = *(const LAS f32x4*)(ops + t * 320); o.a = *(const LAS f32x4*)(ops + t * 320 + 64); o.b = *(const LAS f32x4*)(ops + t * 320 + 128);
    o.k = *(const LAS f32x4*)(ops + t * 320 + 192); o.r = *(const LAS f32x4*)(ops + t * 320 + 256); o.v = vv[t * 16]; return o;
}
__device__ __forceinline__ void sc_step(f32x2& s0, f32x2& s1, const ScOp& o, LAS float* ypt) {
    f32x2 p = s0 * o.a.xy; p = s1 * o.a.zw + p;
    const f32x2 vv = {o.v, o.v};
    const f32x2 t0 = s0 * o.w.xy + o.k.xy * vv, t1 = s1 * o.w.zw + o.k.zw * vv;
    const float sa = red16(p.x + p.y);
    const f32x2 sav = {sa, sa};
    s0 = o.b.xy * sav + t0;
    s1 = o.b.zw * sav + t1;
    f32x2 q = s0 * o.r.xy; q = s1 * o.r.zw + q;
    *ypt = red4(q.x + q.y);
}
__device__ __forceinline__ void sc_scan(f32x2& s0, f32x2& s1, int buf, int row, int seg, int lane, LAS unsigned char* lds) {
    const LAS float* ops = (const LAS float*)(lds + SC_OPS) + buf * 32 * 320 + 4 * seg;
    const LAS float* vv = (const LAS float*)(lds + SC_VV) + buf * 32 * 16 + row;
    LAS float* yp = (LAS float*)(lds + SC_YP) + (buf * 32 * 16 + row) * 4 + (seg >> 2);
    ScOp o0 = sc_ld(ops, vv, 0), o1 = sc_ld(ops, vv, 1);
#pragma unroll
    for (int t = 0; t < 32; t += 2) {
        const ScOp o2 = sc_ld(ops, vv, t + 2); sc_step(s0, s1, o0, yp + t * 64);
        const ScOp o3 = sc_ld(ops, vv, t + 3); sc_step(s0, s1, o1, yp + (t + 1) * 64);
        o0 = o2; o1 = o3;
    }
}
__device__ __forceinline__ void scan_phase(ArgsP a_, int l, LAS unsigned char* lds) {
    const ArgsP a = launder(a_);
    const int tid = opq_tid(), lane = tid & 63, wave = __builtin_amdgcn_readfirstlane(tid >> 6);
    unsigned char* ar = a->ws + WS_AR;
    const bf16* ZR = (const bf16*)(ar + AR_ZR); const bf16* LO = (const bf16*)(ar + AR_LO); const int ldlo = l ? 2048 : 1536;
    bf16* VF = (bf16*)(a->ws + WS_VFIRST); bf16* YRW = (bf16*)(ar + AR_YRW);
    for (int u = opq_bid(); u < 256; u += opq_gdim()) {
        const int b = u >> 5, h = (u >> 2) & 7, rg = u & 3;
        if (wave < 4) {
            f32x2 s0 = {0.f, 0.f}, s1 = {0.f, 0.f}; const int row = 4 * wave + (lane >> 4), seg = lane & 15;
            __syncthreads();
            for (int c = 0; c < 256; c += 2) { sc_scan(s0, s1, 0, row, seg, lane, lds); __syncthreads(); sc_scan(s0, s1, 1, row, seg, lane, lds); __syncthreads(); }
        } else {
            const int hl = tid - 256, cg = hl & 15, ch = h * 64 + 4 * cg, vc = h * 64 + 16 * rg + cg;
            const f32x4 mur = *(const f32x4*)(a->in[6] + l * 1792 + ch), muk = *(const f32x4*)(a->in[6] + l * 1792 + 512 + ch);
            const f32x4 kkc = *(const f32x4*)(a->in[15] + l * 512 + ch), kac = *(const f32x4*)(a->in[16] + l * 512 + ch);
            const float muv = a->in[6][l * 1792 + 1024 + vc];
            HSet SA, SB;
            sc_load(SA, 0, l, b, h, rg, hl, ZR, LO, ldlo, VF); sc_prep(SA, 0, 0, l, b, h, rg, hl, lds, VF, mur, muk, kkc, kac, muv);
            sc_load(SA, 1, l, b, h, rg, hl, ZR, LO, ldlo, VF); sc_load(SB, 2, l, b, h, rg, hl, ZR, LO, ldlo, VF);
            __syncthreads();
            for (int c = 0; c < 256; c += 2) {
                if (c > 0) sc_yred(c - 1, 1, b, h, rg, hl, lds, YRW);
                sc_prep(SA, c + 1, 1, l, b, h, rg, hl, lds, VF, mur, muk, kkc, kac, muv);
                if (DUPM & 32) { f32x4 m2 = mur; asm volatile("" : "+v"(m2) :: "memory"); sc_prep(SA, c + 1, 1, l, b, h, rg, hl, lds, VF, m2, muk, kkc, kac, muv); }
                sc_load(SA, c + 3, l, b, h, rg, hl, ZR, LO, ldlo, VF);
                __syncthreads();
                sc_yred(c, 0, b, h, rg, hl, lds, YRW);
                sc_prep(SB, c + 2, 0, l, b, h, rg, hl, lds, VF, mur, muk, kkc, kac, muv);
                if (DUPM & 32) { f32x4 m2 = mur; asm volatile("" : "+v"(m2) :: "memory"); sc_prep(SB, c + 2, 0, l, b, h, rg, hl, lds, VF, m2, muk, kkc, kac, muv); }
                sc_load(SB, c + 4, l, b, h, rg, hl, ZR, LO, ldlo, VF);
                __syncthreads();
            }
            sc_yred(255, 1, b, h, rg, hl, lds, YRW);
        }
        __syncthreads();
    }
}
__device__ __forceinline__ void post_phase(ArgsP a_, int l) {
    const ArgsP a = launder(a_);
    const int tid = opq_tid(), lane = tid & 63, wave = tid >> 6, gw = opq_bid() * 8 + wave, NGW = opq_gdim() * 8, c8 = 8 * lane;
    unsigned char* ar = a->ws + WS_AR;
    const bf16* ZR = (const bf16*)(ar + AR_ZR); const bf16* LO = (const bf16*)(ar + AR_LO); const int ldlo = l ? 2048 : 1536;
    const bf16* VF = (const bf16*)(a->ws + WS_VFIRST); bf16* YRW = (bf16*)(ar + AR_YRW);
    float mur[8], muk[8], muv[8], ka[8], rk[8], gng[8], gnb[8];
    load8f(a->in[6] + l * 1792 + c8, mur); load8f(a->in[6] + l * 1792 + 512 + c8, muk); load8f(a->in[6] + l * 1792 + 1024 + c8, muv);
    load8f(a->in[16] + l * 512 + c8, ka); load8f(a->in[17] + l * 512 + c8, rk); load8f(a->in[18] + l * 512 + c8, gng); load8f(a->in[19] + l * 512 + c8, gnb);
    for (int rb = gw; rb < 2048; rb += NGW)
        for (int rr = 0; rr < 32; ++rr) {
            const size_t m = (size_t)rb * 32 + rr; const int s = (int)(m & 8191);
            const bf16* zr = ZR + m * 1792 + c8; const bf16* lo = LO + m * ldlo + c8;
            float y[8], rt[8], kt[8], vt[8], rp[8], kp[8], vp[8], av[8], g[8];
            unpack8(*(const u32x4*)(YRW + m * 512 + c8), y);
            unpack8(*(const u32x4*)zr, rt); unpack8(*(const u32x4*)(zr + 512), kt); unpack8(*(const u32x4*)(zr + 1024), vt);
            if (s > 0) { unpack8(*(const u32x4*)(zr - 1792), rp); unpack8(*(const u32x4*)(zr - 1792 + 512), kp); unpack8(*(const u32x4*)(zr - 1792 + 1024), vp); }
            else {
#pragma unroll
                for (int i = 0; i < 8; ++i) { rp[i] = 0.f; kp[i] = 0.f; vp[i] = 0.f; } }
            unpack8(*(const u32x4*)(lo + 512), av); unpack8(*(const u32x4*)(lo + 1024), g);
            float bon = 0.f, sy = 0.f;
#pragma unroll
            for (int i = 0; i < 8; ++i) { const float r = rt[i] + (rp[i] - rt[i]) * mur[i], k = kt[i] + (kp[i] - kt[i]) * muk[i]; vt[i] = vt[i] + (vp[i] - vt[i]) * muv[i];
                bon += r * (k * (1.f + (av[i] - 1.f) * ka[i])) * rk[i]; sy += y[i]; }
            if (l) { float vm[8], vf[8]; unpack8(*(const u32x4*)(lo + 1536), vm); unpack8(*(const u32x4*)(VF + m * 512 + c8), vf);
#pragma unroll
                for (int i = 0; i < 8; ++i) vt[i] = vt[i] + (vf[i] - vt[i]) * vm[i]; }
            bon = red8(bon); const float mean = red8(sy) * (1.f / 64.f); float q = 0.f;
#pragma unroll
            for (int i = 0; i < 8; ++i) { y[i] -= mean; q += y[i] * y[i]; }
            const float rstd = 1.0f / sqrtf(red8(q) * (1.f / 64.f) + GN_EPS);
#pragma unroll
            for (int i = 0; i < 8; ++i) y[i] = (y[i] * rstd * gng[i] + gnb[i] + bon * vt[i]) * g[i];
            *(u32x4*)(YRW + m * 512 + c8) = pack8(y);
        }
}
__device__ __forceinline__ void combine_phase(ArgsP a_) {
    const ArgsP a = launder(a_);
    const int gt = opq_bid() * 512 + opq_tid(), NT = opq_gdim() * 512;
    const bf16* P = (const bf16*)(a->ws + WS_AR + AR_P); bf16* Hm = (bf16*)(a->ws + WS_H);
    for (int i = gt; i < M * 128; i += NT) { const size_t m = (size_t)(i >> 7); const int c8 = (i & 127) * 8; float p0[8], p1[8], p2[8];
        unpack8(*(const u32x4*)(P + m * 3072 + c8), p0); unpack8(*(const u32x4*)(P + m * 3072 + 1024 + c8), p1); unpack8(*(const u32x4*)(P + m * 3072 + 2048 + c8), p2);
#pragma unroll
        for (int q = 0; q < 8; ++q) p0[q] = (p0[q] + p1[q]) + p2[q];
        *(u32x4*)(Hm + m * 1024 + c8) = pack8(p0); }
}

#ifndef DUPM
#define DUPM 0
#endif
#ifndef PHM
#define PHM 0x7fff
#endif
__global__ void __launch_bounds__(512, 2) fwd_kernel(Args kargs) {
    extern __shared__ __attribute__((aligned(16))) unsigned char lds_raw[];
    LAS unsigned char* lds = (LAS unsigned char*)lds_raw;
    cg::grid_group grid = cg::this_grid();
    const ArgsP ak = (ArgsP)__builtin_amdgcn_kernarg_segment_ptr();

    if (PHM & 1) p0_phase(ak, lds); grid.sync();
    if (PHM & 2) p0b_phase(ak); grid.sync();
#pragma unroll 1
    for (int l = 0; l < 2; ++l) {
        if (PHM & 4) { const ArgsP a = launder(ak); const int G = opq_gdim(), bx = opq_bid(); unsigned char* ws = a->ws; unsigned char* ar = ws + WS_AR; bf16* H = (bf16*)(ws + WS_H); const float* adal = (const float*)(ws + WS_ADA) + l * 49152; (void)ar; (void)H; (void)adal;
          pg8::Gemm g{H, nullptr, nullptr, 0, (const bf16*)(ws + (l ? WS_WINA1 : WS_WINA0)), M, l ? 3584 : 3328, 1024};
          pg8::StaticOrder S; S.init(M, g.N, G, bx);
          EpiG1 E{(bf16*)(ar + AR_ZR), (bf16*)(ar + AR_CG), (bf16*)(ar + AR_PL), (bf16*)(ar + AR_LV)};
          pg8::gemm_phase<EpiG1, pg8::StaticOrder, true, true>(lds, g, S, E); }
        grid.sync();
        if (PHM & 8) prep_phase(ak, l, lds); grid.sync();
        if (DUPM & 1) { prep_phase(ak, l, lds); grid.sync(); }
        if (PHM & 16) { const ArgsP a = launder(ak); const int G = opq_gdim(), bx = opq_bid(); unsigned char* ws = a->ws; unsigned char* ar = ws + WS_AR; bf16* H = (bf16*)(ws + WS_H); const float* adal = (const float*)(ws + WS_ADA) + l * 49152; (void)ar; (void)H; (void)adal;
          pg8::Gemm g{(const bf16*)(ar + AR_LA), nullptr, nullptr, 0, (const bf16*)(ws + (l ? WS_WLORA1 : WS_WLORA0)), M, l ? 2048 : 1536, l ? 384 : 256};
          pg8::StaticOrder S; S.init(M, g.N, G, bx);
          EpiLora E{(bf16*)(ar + AR_LO), l ? 2048 : 1536, a->in[8] + l * 512, a->in[10] + l * 512, a->in[13]};
          pg8::gemm_phase<EpiLora, pg8::StaticOrder, true, true>(lds, g, S, E); }
        grid.sync();
        if (PHM & 32) scan_phase(ak, l, lds); grid.sync();
        if (DUPM & 16) { scan_phase(ak, l, lds); grid.sync(); }
        if (PHM & 64) post_phase(ak, l); grid.sync();
        if (DUPM & 2) { scan_phase(ak, l, lds); grid.sync(); post_phase(ak, l); grid.sync(); }
        if (DUPM & 4) { for (int q = 0; q < 16; ++q) grid.sync(); }
        if (PHM & 128) { const ArgsP a = launder(ak); const int G = opq_gdim(), bx = opq_bid(); unsigned char* ws = a->ws; unsigned char* ar = ws + WS_AR; bf16* H = (bf16*)(ws + WS_H); const float* adal = (const float*)(ws + WS_ADA) + l * 49152; (void)ar; (void)H; (void)adal;
          pg8::Gemm g{(const bf16*)(ar + AR_YRW), (const bf16*)(ar + AR_YCV), (const bf16*)(ar + AR_POOL), 4, (const bf16*)(ws + (l ? WS_WBR1 : WS_WBR0)), M, 3072, 512};
          pg8::StaticOrder S; S.init(M, g.N, G, bx);
          EpiBf<0> E{(bf16*)(ar + AR_P), 3072};
          pg8::gemm_phase<EpiBf<0>, pg8::StaticOrder, true, true>(lds, g, S, E); }
        grid.sync();
        if (PHM & 256) { const ArgsP a = launder(ak); const int G = opq_gdim(), bx = opq_bid(); unsigned char* ws = a->ws; unsigned char* ar = ws + WS_AR; bf16* H = (bf16*)(ws + WS_H); const float* adal = (const float*)(ws + WS_ADA) + l * 49152; (void)ar; (void)H; (void)adal;
          pg8::Gemm g{H, nullptr, nullptr, 0, (const bf16*)(ws + (l ? WS_WG1 : WS_WG0)), M, 3072, 1024};
          pg8::StaticOrder S; S.init(M, g.N, G, bx);
          EpiBf<2> E{(bf16*)(ar + AR_P), 3072};
          pg8::gemm_phase<EpiBf<2>, pg8::StaticOrder, true, true>(lds, g, S, E); }
        grid.sync();
        if (PHM & 512) combine_phase(ak); grid.sync();
        if (PHM & 1024) { const ArgsP a = launder(ak); const int G = opq_gdim(), bx = opq_bid(); unsigned char* ws = a->ws; unsigned char* ar = ws + WS_AR; bf16* H = (bf16*)(ws + WS_H); const float* adal = (const float*)(ws + WS_ADA) + l * 49152; (void)ar; (void)H; (void)adal;
          pg8::Gemm g{H, nullptr, nullptr, 0, (const bf16*)(ws + (l ? WS_WOUT1 : WS_WOUT0)), M, 1024, 1024};
          pg8::StaticOrder S; S.init(M, g.N, G, bx);
          EpiRes E{l ? (const float*)a->out : a->in[0], a->out, adal + 2 * 1024};
          pg8::gemm_phase<EpiRes, pg8::StaticOrder, true, true>(lds, g, S, E); }
        grid.sync();
        if (PHM & 2048) { const ArgsP a = launder(ak); const float* adal = (const float*)(a->ws + WS_ADA) + l * 49152;
          ln_phase(a->out, (bf16*)(a->ws + WS_H), a->in[30] + l * 1024, a->in[31] + l * 1024, adal + 3 * 1024, adal + 4 * 1024, true); }
        grid.sync();
        if (PHM & 4096) { const ArgsP a = launder(ak); const int G = opq_gdim(), bx = opq_bid(); unsigned char* ws = a->ws; unsigned char* ar = ws + WS_AR; bf16* H = (bf16*)(ws + WS_H); const float* adal = (const float*)(ws + WS_ADA) + l * 49152; (void)ar; (void)H; (void)adal;
          pg8::Gemm g{H, nullptr, nullptr, 0, (const bf16*)(ws + (l ? WS_W1_1 : WS_W1_0)), M, 4096, 1024};
          pg8::StaticOrder S; S.init(M, g.N, G, bx);
          EpiBf<1> E{(bf16*)(ar + AR_HID), 4096};
          pg8::gemm_phase<EpiBf<1>, pg8::StaticOrder, true, true>(lds, g, S, E); }
        grid.sync();
        if (PHM & 8192) { const ArgsP a = launder(ak); const int G = opq_gdim(), bx = opq_bid(); unsigned char* ws = a->ws; unsigned char* ar = ws + WS_AR; bf16* H = (bf16*)(ws + WS_H); const float* adal = (const float*)(ws + WS_ADA) + l * 49152; (void)ar; (void)H; (void)adal;
          pg8::Gemm g{(const bf16*)(ar + AR_HID), nullptr, nullptr, 0, (const bf16*)(ws + (l ? WS_W2_1 : WS_W2_0)), M, 1024, 4096};
          pg8::StaticOrder S; S.init(M, g.N, G, bx);
          EpiRes E{a->out, a->out, adal + 5 * 1024};
          pg8::gemm_phase<EpiRes, pg8::StaticOrder, true, true>(lds, g, S, E); }
        grid.sync();
        if (PHM & 16384) { const ArgsP a = launder(ak); const float* ada1 = (const float*)(a->ws + WS_ADA) + 49152;
          ln_phase(a->out, (bf16*)(a->ws + WS_H), a->in[34] + l * 1024, a->in[35] + l * 1024, ada1, ada1 + 1024, l == 0); }
        if (l == 0) grid.sync();
    }
}

extern "C" void kernel_launch(void* const* d_in, const int* in_sizes, int n_in, void* d_out, int out_size, void* d_ws, size_t ws_size, hipStream_t stream) {
    static int grid = 0;
    if (grid == 0) {
        if (n_in != 36 || out_size != M * D || ws_size < WS_END) { fprintf(stderr, "kernel_launch: unexpected shapes (n_in %d, out %d, ws %zu)\n", n_in, out_size, ws_size); grid = -1; return; }
        int dev = 0, cus = 0, per_cu = 0;
        hipGetDevice(&dev); hipDeviceGetAttribute(&cus, hipDeviceAttributeMultiprocessorCount, dev);
        hipFuncSetAttribute((const void*)fwd_kernel, hipFuncAttributeMaxDynamicSharedMemorySize, LDS_BYTES);
        hipOccupancyMaxActiveBlocksPerMultiprocessor(&per_cu, (const void*)fwd_kernel, 512, LDS_BYTES);
        (void)hipGetLastError();
        if (per_cu < 1) per_cu = 1;
        grid = cus;
        if (grid > 256) grid = 256;
    }
    if (grid < 0) return;
    Args ha{};
    for (int i = 0; i < 36; ++i) ha.in[i] = (const float*)d_in[i];
    ha.out = (float*)d_out; ha.ws = (unsigned char*)d_ws;
    void* params[] = {&ha};
    hipError_t e = hipLaunchCooperativeKernel((const void*)fwd_kernel, dim3(grid), dim3(512), params, LDS_BYTES, stream);
    if (e != hipSuccess) fprintf(stderr, "cooperative launch failed: %s (grid %d)\n", hipGetErrorString(e), grid);
}
```

```cpp
#include <hip/hip_runtime.h>
#include <hip/hip_cooperative_groups.h>
#include <cstdio>
#include <cstdint>
namespace cg = cooperative_groups;
__device__ __forceinline__ int opq_tid() { int t = threadIdx.x; asm volatile("" : "+v"(t)); return t; }
__device__ __forceinline__ int opq_bid() { int t = blockIdx.x; asm volatile("" : "+s"(t)); return t; }
__device__ __forceinline__ int opq_gdim() { int t = gridDim.x; asm volatile("" : "+s"(t)); return t; }
#ifndef DUPM
#define DUPM 0
#endif
#ifndef PHM
#define PHM 0x7fff
#endif
namespace pg8 {
#define PG8_LAS __attribute__((address_space(3)))
typedef unsigned short bf16_t;
typedef short bf16x8 __attribute__((ext_vector_type(8)));
typedef float f32x4 __attribute__((ext_vector_type(4)));
typedef unsigned u32x4 __attribute__((ext_vector_type(4)));
constexpr int BM = 256, BK = 64, HALF = 128, HTB = HALF * BK * 2  , STAGE_BYTES = 8 * HTB, NXCD = 8, WGM = 8;

__host__ __device__ __forceinline__ int lds_byte(int r, int c) { const int st = (r >> 4) * 2 + (c >> 5), rr = r & 15, cc = c & 31, ob = rr * 64 + cc * 2; return st * 1024 + (ob ^ (((ob >> 9) & 1) << 5)); }
__host__ __device__ __forceinline__ void stage_rc(int b, int& R, int& C) { const int st = b / 1024, sb = b % 1024, swz = sb ^ (((sb >> 9) & 1) << 5); R = (st >> 1) * 16 + swz / 64; C = (st & 1) * 32 + (swz % 64) / 2; }
__host__ __device__ __forceinline__ int perm32(int rho) { const int n = rho >> 4, i = rho & 15; return 8 * (i >> 2) + 4 * n + (i & 3); }

struct Unit { int pm, pn; };
struct Gemm { const bf16_t* A; const bf16_t* A1; const bf16_t* A2; int segt; const bf16_t* Bt; int M, N, K;
    __device__ __forceinline__ const bf16_t* a_of(int pn) const { return segt == 0 ? A : (pn < segt ? A : (pn < 2 * segt ? A1 : A2)); } };

struct StaticOrder {
    int nM, nN, nwg, G, c;
    __host__ __device__ void init(int M, int N, int G_, int c_) { nM = M / BM; nN = N / BM; nwg = nM * nN; G = G_; c = c_; }
    __host__ __device__ bool next(int i, Unit& u) const {
        const long L = (long)i * G + c; if (L >= nwg) return false;
        int wgid = (int)L; { const int q = nwg / NXCD, r = nwg % NXCD, xcd = wgid % NXCD, off = wgid / NXCD; wgid = (xcd < r ? xcd * (q + 1) : r * (q + 1) + (xcd - r) * q) + off; }
        const int nig = WGM * nN, gid = wgid / nig, fm = gid * WGM, gsz = (nM - fm) < WGM ? (nM - fm) : WGM;
        u.pm = fm + ((wgid % nig) % gsz); u.pn = (wgid % nig) / gsz; return true;
    }
    __device__ __forceinline__ void a_ready(const Unit&) const {}
    __device__ __forceinline__ void done(const Unit&) const {}
};
__device__ __forceinline__ unsigned cvt_pk_bf16(float lo, float hi) { unsigned r; asm volatile("v_cvt_pk_bf16_f32 %0, %1, %2" : "=v"(r) : "v"(lo), "v"(hi)); return r; }
template <class Epi, class Sched, bool ALIGN_EPI = false, bool SP2 = false>
__device__ __forceinline__ void gemm_phase(PG8_LAS unsigned char* lds, const Gemm g, const Sched& S, const Epi& E) {
    const int tid = opq_tid(), wid = __builtin_amdgcn_readfirstlane(tid >> 6), lane = tid & 63, wr = wid >> 2, wc = wid & 3, fr = lane & 15, fq = lane >> 4;
    const int K = g.K, nt = K / BK;
    unsigned voffA[2], voffB[2];
#pragma unroll
    for (int i = 0; i < 2; ++i) { int R, C; stage_rc(tid * 16 + i * 8192, R, C); const int Rb = Epi::PERM ? ((R & ~31) + perm32(R & 31)) : R;
        voffA[i] = (unsigned)(R * K + C) * 2u; voffB[i] = (unsigned)(Rb * K + C) * 2u; }
    const size_t kstep = (size_t)(BK * 2);
    const size_t hstep = (size_t)HALF * K * 2;
    const size_t tstep = 2 * hstep;
    const unsigned ldsw = (unsigned)wid * 1024u;
    const int aoff = lds_byte(wr * 64 + fr, fq * 8), boff = lds_byte(wc * 32 + fr, fq * 8);
#define PG8_SA(b, h) (((b) * 2 + (h)) * HTB)
#define PG8_SB(b, h) ((4 + (b) * 2 + (h)) * HTB)
#define PG8_STAGE(bufoff, gbase, voff) do { _Pragma("unroll") for (int _i = 0; _i < 2; ++_i) \
        __builtin_amdgcn_global_load_lds((const unsigned*)((const char*)(gbase) + (voff)[_i]), (PG8_LAS unsigned*)(lds + (bufoff) + ldsw + _i * 8192), 16, 0, 0); } while (0)
#define PG8_LDA(dst, b, h) do { _Pragma("unroll") for (int m = 0; m < 4; ++m) _Pragma("unroll") for (int k = 0; k < 2; ++k) dst[m][k] = *(const PG8_LAS bf16x8*)(lds + PG8_SA(b, h) + aoff + m * 2048 + k * 1024); } while (0)
#define PG8_LDB(dst, b, h) do { _Pragma("unroll") for (int n = 0; n < 2; ++n) _Pragma("unroll") for (int k = 0; k < 2; ++k) dst[n][k] = *(const PG8_LAS bf16x8*)(lds + PG8_SB(b, h) + boff + n * 2048 + k * 1024); } while (0)
#define PG8_MMA(ai, bj, At, Bt) do { __builtin_amdgcn_s_setprio(1); _Pragma("unroll") for (int m = 0; m < 4; ++m) _Pragma("unroll") for (int n = 0; n < 2; ++n) _Pragma("unroll") for (int k = 0; k < 2; ++k) \
        acc[ai][bj][m][n] = __builtin_amdgcn_mfma_f32_16x16x32_bf16(Bt[n][k], At[m][k], acc[ai][bj][m][n], 0, 0, 0); __builtin_amdgcn_s_setprio(0); } while (0)
#define PG8_WAIT_V(n) asm volatile("s_waitcnt vmcnt(" #n ")" ::: "memory")
#define PG8_WAIT_L(n) asm volatile("s_waitcnt lgkmcnt(" #n ")" ::: "memory")
#define PG8_BAR __builtin_amdgcn_s_barrier()
#define PG8_SCHED __builtin_amdgcn_sched_barrier(0)
    Unit cur, nxt; int ui = 0;
    if (!S.next(0, cur)) return;
    f32x4 acc[2][2][4][2];
#pragma unroll
    for (int a = 0; a < 2; ++a)
#pragma unroll
        for (int b = 0; b < 2; ++b)
#pragma unroll
            for (int m = 0; m < 4; ++m)
#pragma unroll
                for (int n = 0; n < 2; ++n) acc[a][b][m][n] = (f32x4){0.f, 0.f, 0.f, 0.f};
    bf16x8 At[4][2], B0[2][2], B1[2][2];
    const char* cA = (const char*)g.a_of(cur.pn) + (size_t)cur.pm * tstep; const char* cB = (const char*)g.Bt + (size_t)cur.pn * tstep;
    S.a_ready(cur);
    if constexpr (SP2) {
        PG8_STAGE(PG8_SB(0, 0), cB, voffB); PG8_STAGE(PG8_SB(0, 1), cB + hstep, voffB); PG8_STAGE(PG8_SA(0, 0), cA, voffA); PG8_STAGE(PG8_SA(0, 1), cA + hstep, voffA);
        if (wr == 1) PG8_BAR;
        PG8_WAIT_V(2); PG8_BAR;
        PG8_STAGE(PG8_SB(1, 0), cB + kstep, voffB); PG8_STAGE(PG8_SA(1, 0), cA + kstep, voffA); PG8_STAGE(PG8_SB(1, 1), cB + hstep + kstep, voffB);
        PG8_WAIT_V(6); PG8_BAR;
    } else {
        PG8_STAGE(PG8_SB(0, 0), cB, voffB); PG8_STAGE(PG8_SA(0, 0), cA, voffA); PG8_STAGE(PG8_SB(0, 1), cB + hstep, voffB); PG8_STAGE(PG8_SA(0, 1), cA + hstep, voffA);
        if (wr == 1) PG8_BAR;
        PG8_WAIT_V(4); PG8_BAR;
        PG8_STAGE(PG8_SB(1, 0), cB + kstep, voffB); PG8_STAGE(PG8_SA(1, 0), cA + kstep, voffA); PG8_STAGE(PG8_SB(1, 1), cB + hstep + kstep, voffB);
        PG8_WAIT_V(6); PG8_BAR;
    }
    for (;;) {
        const bool has_next = S.next(ui + 1, nxt);
        const char* nA = has_next ? (const char*)g.a_of(nxt.pn) + (size_t)nxt.pm * tstep : cA; const char* nB = has_next ? (const char*)g.Bt + (size_t)nxt.pn * tstep : cB;
        for (int t = 0; t < nt; t += 2) {
            const bool last = (t == nt - 2);
            const char* a1 = cA + (size_t)(t + 1) * kstep;
            const char* a2 = last ? nA : cA + (size_t)(t + 2) * kstep; const char* b2 = last ? nB : cB + (size_t)(t + 2) * kstep;
            const char* a3 = a2 + kstep; const char* b3 = b2 + kstep;
            if (last && has_next) S.a_ready(nxt);
            if constexpr (SP2) {
            PG8_LDB(B0, 0, 0); PG8_LDB(B1, 0, 1); PG8_SCHED; PG8_LDA(At, 0, 0); PG8_STAGE(PG8_SA(1, 1), a1 + hstep, voffA);
            PG8_WAIT_V(8); PG8_WAIT_L(0); PG8_BAR; PG8_MMA(0, 0, At, B0); PG8_MMA(0, 1, At, B1); PG8_BAR; PG8_SCHED;
            PG8_LDA(At, 0, 1); PG8_STAGE(PG8_SB(0, 0), b2, voffB); PG8_STAGE(PG8_SB(0, 1), b2 + hstep, voffB); PG8_STAGE(PG8_SA(0, 0), a2, voffA);
            PG8_WAIT_V(8); PG8_WAIT_L(0); PG8_BAR; PG8_MMA(1, 0, At, B0); PG8_MMA(1, 1, At, B1); PG8_BAR; PG8_SCHED;
            PG8_LDB(B0, 1, 0); PG8_LDB(B1, 1, 1); PG8_SCHED; PG8_LDA(At, 1, 0); PG8_STAGE(PG8_SA(0, 1), a2 + hstep, voffA);
            PG8_WAIT_V(8); PG8_WAIT_L(0); PG8_BAR; PG8_MMA(0, 0, At, B0); PG8_MMA(0, 1, At, B1); PG8_BAR; PG8_SCHED;
            PG8_LDA(At, 1, 1); PG8_STAGE(PG8_SB(1, 0), b3, voffB); PG8_STAGE(PG8_SB(1, 1), b3 + hstep, voffB); PG8_STAGE(PG8_SA(1, 0), a3, voffA);
            PG8_WAIT_V(8); PG8_WAIT_L(0); PG8_BAR; PG8_MMA(1, 0, At, B0); PG8_MMA(1, 1, At, B1); PG8_BAR; PG8_SCHED;
            } else {
            PG8_LDB(B0, 0, 0); PG8_SCHED; PG8_LDA(At, 0, 0); PG8_STAGE(PG8_SA(1, 1), a1 + hstep, voffA);
            PG8_WAIT_L(8); PG8_BAR; PG8_WAIT_L(0); PG8_MMA(0, 0, At, B0); PG8_BAR; PG8_SCHED;
            PG8_LDB(B1, 0, 1); PG8_STAGE(PG8_SB(0, 0), b2, voffB);
            PG8_BAR; PG8_WAIT_L(0); PG8_MMA(0, 1, At, B1); PG8_BAR;
            PG8_LDA(At, 0, 1); PG8_STAGE(PG8_SA(0, 0), a2, voffA);
            PG8_BAR; PG8_WAIT_L(0); PG8_MMA(1, 0, At, B0); PG8_BAR; PG8_SCHED;
            PG8_STAGE(PG8_SB(0, 1), b2 + hstep, voffB);
            PG8_WAIT_V(6); PG8_BAR; PG8_MMA(1, 1, At, B1); PG8_BAR;
            PG8_LDB(B0, 1, 0); PG8_SCHED; PG8_LDA(At, 1, 0); PG8_STAGE(PG8_SA(0, 1), a2 + hstep, voffA);
            PG8_WAIT_L(8); PG8_BAR; PG8_WAIT_L(0); PG8_MMA(0, 0, At, B0); PG8_BAR; PG8_SCHED;
            PG8_LDB(B1, 1, 1); PG8_STAGE(PG8_SB(1, 0), b3, voffB);
            PG8_BAR; PG8_WAIT_L(0); PG8_MMA(0, 1, At, B1); PG8_BAR;
            PG8_LDA(At, 1, 1); PG8_STAGE(PG8_SA(1, 0), a3, voffA);
            PG8_BAR; PG8_WAIT_L(0); PG8_MMA(1, 0, At, B0); PG8_BAR; PG8_SCHED;
            PG8_STAGE(PG8_SB(1, 1), b3 + hstep, voffB);
            PG8_WAIT_V(6); PG8_BAR; PG8_MMA(1, 1, At, B1); PG8_BAR;
            }
        }
        if constexpr (ALIGN_EPI) { if (wr == 0) PG8_BAR; }
        if constexpr (!Epi::AFTER_DRAIN) { E(acc, cur, wr, wc, fr, fq); S.done(cur); }
        if (!has_next) break;
#pragma unroll
        for (int a = 0; a < 2; ++a)
#pragma unroll
            for (int b = 0; b < 2; ++b)
#pragma unroll
                for (int m = 0; m < 4; ++m)
#pragma unroll
                    for (int n = 0; n < 2; ++n) acc[a][b][m][n] = (f32x4){0.f, 0.f, 0.f, 0.f};
        cur = nxt; cA = nA; cB = nB; ++ui;
        if constexpr (ALIGN_EPI) { if (wr == 1) PG8_BAR; }
    }
    PG8_WAIT_V(0);
    if constexpr (!ALIGN_EPI) { if (wr == 0) PG8_BAR; }
    PG8_BAR;
    if constexpr (Epi::AFTER_DRAIN) { E.fused(acc, cur, wr, wc, fr, fq, lds, wid, lane); S.done(cur); }
#undef PG8_SA
#undef PG8_SB
#undef PG8_STAGE
#undef PG8_LDA
#undef PG8_LDB
#undef PG8_MMA
#undef PG8_WAIT_V
#undef PG8_WAIT_L
#undef PG8_BAR
#undef PG8_SCHED
}
}

#define LAS __attribute__((address_space(3)))
typedef unsigned short bf16;
typedef pg8::f32x4 f32x4;
typedef pg8::u32x4 u32x4;
typedef unsigned u32x2 __attribute__((ext_vector_type(2)));
using pg8::Unit;

constexpr int M = 65536, D = 1024, SEQ = 8192;
constexpr float ALPHA = 1.4142135623730951f;
constexpr float LN_EPS = 1e-5f, GN_EPS = 64e-5f;
constexpr int LDS_BYTES = 147456;

constexpr size_t MiB = (size_t)1 << 20;
constexpr size_t WS_ADAP = 1 * MiB, WS_ADA = 4 * MiB, WS_WLORA0 = 5 * MiB, WS_WLORA1 = 6 * MiB, WS_WINA0 = 8 * MiB, WS_WINA1 = 15 * MiB,
    WS_WG0 = 22 * MiB, WS_WG1 = 28 * MiB, WS_WBR0 = 34 * MiB, WS_WBR1 = 37 * MiB, WS_WOUT0 = 40 * MiB, WS_WOUT1 = 42 * MiB,
    WS_W1_0 = 44 * MiB, WS_W1_1 = 52 * MiB, WS_W2_0 = 60 * MiB, WS_W2_1 = 68 * MiB, WS_VFIRST = 76 * MiB, WS_H = 140 * MiB, WS_AR = 268 * MiB;
constexpr size_t AR_ZR = 0, AR_CG = 224 * MiB, AR_PL = 288 * MiB, AR_LV = 352 * MiB, AR_LO = 224 * MiB, AR_YCV = 480 * MiB, AR_POOL = 544 * MiB,
    AR_YRW = 608 * MiB, AR_LA = 672 * MiB, AR_P = 0, AR_HID = 0;
constexpr size_t WS_END = WS_AR + 720 * MiB;

struct Args { const float* in[36]; float* out; unsigned char* ws; };
typedef const Args __attribute__((address_space(4)))* ArgsP;
__device__ __forceinline__ ArgsP launder(ArgsP p) { asm volatile("" : "+s"(p)); return p; }

#define XB_TMO      128
#define XB_XCNT(j)  (256  + 64 * (j))
#define XB_XSUB(j)  (1280 + 64 * (j))
#define XB_XGEN(j)  (2304 + 64 * (j))
#define XB_TOP      3328
#define XB_TOPGEN   3392
#define XCD_BAR_WORDS 3456
#define XB_SPIN_CAP (1u << 18)

__device__ __forceinline__ unsigned xb_ld(unsigned* p)              { return __hip_atomic_load(p, __ATOMIC_RELAXED, __HIP_MEMORY_SCOPE_AGENT); }
__device__ __forceinline__ unsigned xb_add(unsigned* p, unsigned v) { return __hip_atomic_fetch_add(p, v, __ATOMIC_RELAXED, __HIP_MEMORY_SCOPE_AGENT); }
__device__ __forceinline__ unsigned xb_xcc_id() { return (unsigned)__builtin_amdgcn_s_getreg((3 << 11) | 20) & 0xFu; }
#define XB_SPIN(cond, bar) do { unsigned _sp = 0; while (cond) { __builtin_amdgcn_s_sleep(1); \
    if ((++_sp & 255u) == 0u) { if (xb_ld(&(bar)[XB_TMO])) break; if (_sp > XB_SPIN_CAP) { atomicAdd(&(bar)[XB_TMO], 1u); break; } } } } while (0)

struct XcdBarrier {
    unsigned* bar; unsigned x;
    volatile LAS unsigned* st;
};

__device__ __forceinline__ XcdBarrier xcd_barrier_post(unsigned* bar, volatile LAS unsigned* st) {
    XcdBarrier b; b.bar = bar; b.x = xb_xcc_id(); b.st = st;
    if (threadIdx.x == 0) (void)xb_add(&bar[XB_XCNT(b.x)], 1u);
    return b;
}
__device__ __forceinline__ void xcd_barrier_complete(unsigned* bar, unsigned x, unsigned& nloc, unsigned& nx) {
    const unsigned G = gridDim.x * gridDim.y * gridDim.z;
    unsigned sum, cnt, mine, sp = 0u;
    for (;;) {
        sum = 0u; cnt = 0u; mine = 0u;
#pragma unroll
        for (unsigned j = 0; j < 16; ++j) { const unsigned c = xb_ld(&bar[XB_XCNT(j)]); sum += c; cnt += (c > 0u) ? 1u : 0u; mine = (j == x) ? c : mine; }
        if (sum == G) break;
        __builtin_amdgcn_s_sleep(1);
        if ((++sp & 255u) == 0u) { if (xb_ld(&bar[XB_TMO])) break; if (sp > XB_SPIN_CAP) { atomicAdd(&bar[XB_TMO], 1u); break; } }
    }
    nloc = mine > 0u ? mine : 1u; nx = cnt > 0u ? cnt : 1u;
}

__device__ __forceinline__ void xcd_barrier(const XcdBarrier& b) {
    asm volatile("s_waitcnt vmcnt(0)" ::: "memory");
    __syncthreads();
    if (threadIdx.x == 0) {
        unsigned* bar = b.bar;
        __builtin_amdgcn_s_waitcnt(0);
        unsigned nloc = b.st[0], nx = b.st[1];
        if (nloc == 0u) { xcd_barrier_complete(bar, b.x, nloc, nx); b.st[0] = nloc; b.st[1] = nx; }
        const unsigned old = xb_add(&bar[XB_XSUB(b.x)], 1u);
        const unsigned gen = old / nloc;
        if (old + 1u == (gen + 1u) * nloc) {
            __builtin_amdgcn_fence(__ATOMIC_RELEASE, "agent");
            asm volatile("s_waitcnt vmcnt(0)" ::: "memory");
            const unsigned og = xb_add(&bar[XB_TOP], 1u);
            const unsigned tg = og / nx;
            if (og + 1u == (tg + 1u) * nx) xb_add(&bar[XB_TOPGEN], 1u);
            else XB_SPIN(xb_ld(&bar[XB_TOPGEN]) == tg, bar);
            __builtin_amdgcn_fence(__ATOMIC_ACQUIRE, "agent");
            xb_add(&bar[XB_XGEN(b.x)], 1u);
            asm volatile("s_waitcnt vmcnt(0)" ::: "memory");
        } else {
            XB_SPIN(xb_ld(&bar[XB_XGEN(b.x)]) == gen, bar);
            __builtin_amdgcn_fence(__ATOMIC_ACQUIRE, "agent");
            asm volatile("s_waitcnt vmcnt(0)" ::: "memory");
        }
    }
    __syncthreads();
}
#define LDS_WAIT() asm volatile("s_waitcnt lgkmcnt(0)" ::: "memory")
__device__ __forceinline__ unsigned f2bf(float f) { unsigned u = __builtin_bit_cast(unsigned, f); return (u + 0x7fffu + ((u >> 16) & 1u)) >> 16; }
__device__ __forceinline__ unsigned pk2(float lo, float hi) { return pg8::cvt_pk_bf16(lo, hi); }
__device__ __forceinline__ float bflo(unsigned u) { return __uint_as_float(u << 16); }
__device__ __forceinline__ float bfhi(unsigned u) { return __uint_as_float(u & 0xffff0000u); }
__device__ __forceinline__ float bf1(unsigned short u) { return __uint_as_float(((unsigned)u) << 16); }
__device__ __forceinline__ float sigm(float x) { return 1.f / (1.f + __expf(-x)); }
__device__ __forceinline__ void unpack8(const u32x4 v, float (&o)[8]) { o[0] = bflo(v.x); o[1] = bfhi(v.x); o[2] = bflo(v.y); o[3] = bfhi(v.y); o[4] = bflo(v.z); o[5] = bfhi(v.z); o[6] = bflo(v.w); o[7] = bfhi(v.w); }
__device__ __forceinline__ u32x4 pack8(const float (&o)[8]) { u32x4 r; r.x = pk2(o[0], o[1]); r.y = pk2(o[2], o[3]); r.z = pk2(o[4], o[5]); r.w = pk2(o[6], o[7]); return r; }
__device__ __forceinline__ void load8f(const float* p, float (&o)[8]) { const f32x4 a = *(const f32x4*)p, b = *(const f32x4*)(p + 4); o[0] = a.x; o[1] = a.y; o[2] = a.z; o[3] = a.w; o[4] = b.x; o[5] = b.y; o[6] = b.z; o[7] = b.w; }
__device__ __forceinline__ float wave_sum(float v) {
#pragma unroll
    for (int o = 1; o < 64; o <<= 1) v += __shfl_xor(v, o);
    return v;
}
template <int CTRL> __device__ __forceinline__ float dppf(float x) { return __builtin_bit_cast(float, __builtin_amdgcn_update_dpp(0, __builtin_bit_cast(int, x), CTRL, 0xF, 0xF, true)); }
__device__ __forceinline__ float red4(float x) { x += dppf<0xB1>(x); x += dppf<0x4E>(x); return x; }
__device__ __forceinline__ float red8(float x) { x = red4(x); x += dppf<0x141>(x); return x; }
__device__ __forceinline__ float red16(float x) { x = red8(x); x += dppf<0x140>(x); return x; }

__device__ __forceinline__ void store8(bf16* p, const f32x4 v0, const f32x4 v1) {
    u32x4 w; w.x = pk2(v0[0], v0[1]); w.y = pk2(v0[2], v0[3]); w.z = pk2(v1[0], v1[1]); w.w = pk2(v1[2], v1[3]); *(u32x4*)p = w;
}
struct EpiG1 {
    static constexpr bool PERM = true, AFTER_DRAIN = false;
    bf16 *ZR, *CG, *PL, *LV;
    __device__ __forceinline__ void operator()(const f32x4 (&acc)[2][2][4][2], const Unit& u, int wr, int wc, int fr, int fq) const {
        const int row0 = u.pm * 256 + wr * 64 + fr, pn = u.pn, cin = wc * 32 + 8 * fq;
        if (pn < 7 || (pn >= 11 && pn < 13)) {
            bf16* base = pn < 7 ? ZR : PL; const int ldc = pn < 7 ? 1792 : 512, col0 = (pn < 7 ? pn : pn - 11) * 256 + cin;
#pragma unroll
            for (int ai = 0; ai < 2; ++ai)
#pragma unroll
                for (int m = 0; m < 4; ++m) { bf16* rp = base + (size_t)(row0 + ai * 128 + m * 16) * ldc + col0;
#pragma unroll
                    for (int bj = 0; bj < 2; ++bj) store8(rp + bj * 128, acc[ai][bj][m][0], acc[ai][bj][m][1]); }
        } else if (pn < 11) {
            const int col0 = (pn - 7) * 128 + cin;
#pragma unroll
            for (int ai = 0; ai < 2; ++ai)
#pragma unroll
                for (int m = 0; m < 4; ++m) { f32x4 h0, h1;
#pragma unroll
                    for (int i = 0; i < 4; ++i) { h0[i] = acc[ai][0][m][0][i] * sigm(acc[ai][1][m][0][i]); h1[i] = acc[ai][0][m][1][i] * sigm(acc[ai][1][m][1][i]); }
                    store8(CG + (size_t)(row0 + ai * 128 + m * 16) * 512 + col0, h0, h1); }
        } else {
            if (wc == 0) {
#pragma unroll
                for (int ai = 0; ai < 2; ++ai)
#pragma unroll
                    for (int m = 0; m < 4; ++m) store8(LV + (size_t)(row0 + ai * 128 + m * 16) * 32 + 8 * fq, acc[ai][0][m][0], acc[ai][0][m][1]);
            }
        }
    }
};
struct EpiLora {
    static constexpr bool PERM = true, AFTER_DRAIN = false;
    bf16* O; int ldc; const float *w0, *a0, *v0;
    __device__ __forceinline__ void operator()(const f32x4 (&acc)[2][2][4][2], const Unit& u, int wr, int wc, int fr, int fq) const {
        const int row0 = u.pm * 256 + wr * 64 + fr, type = u.pn >> 1, cin = wc * 32 + 8 * fq;
#pragma unroll
        for (int bj = 0; bj < 2; ++bj) {
            const int cb = u.pn * 256 + bj * 128 + cin, pc = cb & 511;
            f32x4 p0 = (f32x4){0.f, 0.f, 0.f, 0.f}, p1 = p0;
            if (type == 0) { p0 = *(const f32x4*)(w0 + pc); p1 = *(const f32x4*)(w0 + pc + 4); }
            else if (type == 1) { p0 = *(const f32x4*)(a0 + pc); p1 = *(const f32x4*)(a0 + pc + 4); }
            else if (type == 3) { p0 = *(const f32x4*)(v0 + pc); p1 = *(const f32x4*)(v0 + pc + 4); }
#pragma unroll
            for (int ai = 0; ai < 2; ++ai)
#pragma unroll
                for (int m = 0; m < 4; ++m) { f32x4 v0_ = acc[ai][bj][m][0] + p0, v1_ = acc[ai][bj][m][1] + p1;
                    if (type != 2) {
                        const float sc = type == 0 ? 0.60653065971f : 1.f;
#pragma unroll
                        for (int i = 0; i < 4; ++i) { v0_[i] = sc * sigm(v0_[i]); v1_[i] = sc * sigm(v1_[i]); } }
                    store8(O + (size_t)(row0 + ai * 128 + m * 16) * ldc + cb, v0_, v1_); }
        }
    }
};
template <int MODE  > struct EpiBf {
    static constexpr bool PERM = true, AFTER_DRAIN = false;
    bf16* O; int ldc;
    __device__ __forceinline__ void operator()(const f32x4 (&acc)[2][2][4][2], const Unit& u, int wr, int wc, int fr, int fq) const {
        const int row0 = u.pm * 256 + wr * 64 + fr, col0 = u.pn * 256 + wc * 32 + 8 * fq;
#pragma unroll
        for (int ai = 0; ai < 2; ++ai)
#pragma unroll
            for (int m = 0; m < 4; ++m) { bf16* rp = O + (size_t)(row0 + ai * 128 + m * 16) * ldc + col0;
#pragma unroll
                for (int bj = 0; bj < 2; ++bj) { f32x4 v0 = acc[ai][bj][m][0], v1 = acc[ai][bj][m][1];
                    if (MODE == 1) {
#pragma unroll
                        for (int i = 0; i < 4; ++i) { const float a = fmaxf(v0[i], 0.f), b = fmaxf(v1[i], 0.f); v0[i] = a * a; v1[i] = b * b; } }
                    if (MODE == 2) { float p[8]; unpack8(*(const u32x4*)(rp + bj * 128), p);
#pragma unroll
                        for (int i = 0; i < 4; ++i) { v0[i] = sigm(v0[i]) * p[i]; v1[i] = sigm(v1[i]) * p[4 + i]; } }
                    store8(rp + bj * 128, v0, v1); } }
    }
};
struct EpiRes {
    static constexpr bool PERM = false, AFTER_DRAIN = false;
    const float* xin; float* out; const float* gt;
    __device__ __forceinline__ void operator()(const f32x4 (&acc)[2][2][4][2], const Unit& u, int wr, int wc, int fr, int fq) const {
        const float* gtb = gt + (size_t)(u.pm >> 5) * 6144; const int col0 = u.pn * 256 + wc * 32 + 4 * fq;
        f32x4 g4[2][2];
#pragma unroll
        for (int bj = 0; bj < 2; ++bj)
#pragma unroll
            for (int n = 0; n < 2; ++n) g4[bj][n] = *(const f32x4*)(gtb + col0 + bj * 128 + n * 16);
#pragma unroll
        for (int ai = 0; ai < 2; ++ai)
#pragma unroll
            for (int m = 0; m < 4; ++m) { const size_t off = (size_t)(u.pm * 256 + ai * 128 + wr * 64 + m * 16 + fr) * 1024 + col0;
#pragma unroll
                for (int bj = 0; bj < 2; ++bj)
#pragma unroll
                    for (int n = 0; n < 2; ++n) { const f32x4 x4 = *(const f32x4*)(xin + off + bj * 128 + n * 16);
                        *(f32x4*)(out + off + bj * 128 + n * 16) = x4 * ALPHA + g4[bj][n] * acc[ai][bj][m][n]; } }
    }
};

__device__ __forceinline__ void tr_item(const float* W, int N, int k0, int n0, bf16* dst, int K, LAS float* scr, int lane) {
#pragma unroll 8
    for (int i = 0; i < 32; ++i) { const int kk = 2 * i + (lane >> 5); scr[kk * 33 + (lane & 31)] = W[(size_t)(k0 + kk) * N + n0 + (lane & 31)]; }
    LDS_WAIT(); asm volatile("" ::: "memory");
    const int c = lane & 7;
#pragma unroll
    for (int j = 0; j < 4; ++j) { const int n = (lane >> 3) + 8 * j; const LAS float* s = scr + (8 * c) * 33 + n;
        u32x4 o; o.x = pk2(s[0 * 33], s[1 * 33]); o.y = pk2(s[2 * 33], s[3 * 33]); o.z = pk2(s[4 * 33], s[5 * 33]); o.w = pk2(s[6 * 33], s[7 * 33]);
        *(u32x4*)(dst + (size_t)n * K + 8 * c) = o; }
    LDS_WAIT(); asm volatile("" ::: "memory");
}
__device__ __forceinline__ bf16* win_dst(unsigned char* ws, int l, int n0) {
    bf16* wina = (bf16*)(ws + (l ? WS_WINA1 : WS_WINA0)); bf16* wg = (bf16*)(ws + (l ? WS_WG1 : WS_WG0));
    if (n0 < 1792) return wina + (size_t)n0 * 1024;
    if (n0 < 2816) { const int c = n0 - 1792, half = c >> 9, cc = c & 511, j = cc >> 7, i = cc & 127; return wina + (size_t)(1792 + j * 256 + half * 128 + i) * 1024; }
    if (n0 < 3328) return wina + (size_t)n0 * 1024;
    return wg + (size_t)(n0 - 3328) * 1024;
}
__device__ __forceinline__ void p0_phase(ArgsP a_, LAS unsigned char* lds) {
    const ArgsP a = launder(a_);
    const int tid = opq_tid(), lane = tid & 63, wave = tid >> 6, G = opq_gdim();
    const int gw = opq_bid() * 8 + wave, NGW = G * 8, gt = opq_bid() * 512 + tid, NT = G * 512;
    unsigned char* ws = a->ws;
    LAS float* scr = (LAS float*)(lds + wave * 8448);
    for (int it = gw; it < 16656; it += NGW) {
        int r = it;
        if (r >= 16640) { const int kb = r - 16640; tr_item(a->in[5], 32, 64 * kb, 0, (bf16*)(ws + WS_WINA1) + (size_t)3328 * 1024 + 64 * kb, 1024, scr, lane); continue; }
        const int l = r >= 8320 ? 1 : 0; r -= l * 8320;
        if (r < 3200) { const int kb = r / 200, nb = r % 200; tr_item(a->in[4] + (size_t)l * 1024 * 6400, 6400, 64 * kb, 32 * nb, win_dst(ws, l, 32 * nb) + 64 * kb, 1024, scr, lane); continue; } r -= 3200;
        bf16* wbr = (bf16*)(ws + (l ? WS_WBR1 : WS_WBR0));
        if (r < 256) { const int kb = r >> 5, nb = r & 31; tr_item(a->in[20] + (size_t)l * 512 * 1024, 1024, 64 * kb, 32 * nb, wbr + (size_t)(32 * nb) * 512 + 64 * kb, 512, scr, lane); continue; } r -= 256;
        if (r < 256) { const int kb = r >> 5, nb = r & 31; tr_item(a->in[25] + (size_t)l * 512 * 1024, 1024, 64 * kb, 32 * nb, wbr + (size_t)(1024 + 32 * nb) * 512 + 64 * kb, 512, scr, lane); continue; } r -= 256;
        if (r < 512) { const int kb = r >> 5, nb = r & 31; tr_item(a->in[29] + (size_t)l * 1024 * 1024, 1024, 64 * kb, 32 * nb, (bf16*)(ws + (l ? WS_WOUT1 : WS_WOUT0)) + (size_t)(32 * nb) * 1024 + 64 * kb, 1024, scr, lane); continue; } r -= 512;
        if (r < 2048) { const int kb = r >> 7, nb = r & 127; tr_item(a->in[32] + (size_t)l * 1024 * 4096, 4096, 64 * kb, 32 * nb, (bf16*)(ws + (l ? WS_W1_1 : WS_W1_0)) + (size_t)(32 * nb) * 1024 + 64 * kb, 1024, scr, lane); continue; } r -= 2048;
        { const int kb = r >> 5, nb = r & 31; tr_item(a->in[33] + (size_t)l * 4096 * 1024, 1024, 64 * kb, 32 * nb, (bf16*)(ws + (l ? WS_W2_1 : WS_W2_0)) + (size_t)(32 * nb) * 4096 + 64 * kb, 4096, scr, lane); }
    }
    { u32x4* z = (u32x4*)((bf16*)(ws + WS_WINA1) + (size_t)3360 * 1024); for (int i = gt; i < 28672; i += NT) z[i] = (u32x4){0u, 0u, 0u, 0u}; }
    { bf16* w = (bf16*)(ws + WS_WLORA0);
      for (int i = gt; i < 1536 * 256; i += NT) { const int n = i >> 8, k = i & 255; float v = 0.f;
          if (n < 512) { if (k < 64) v = a->in[9][k * 512 + n]; }
          else if (n < 1024) { if (k >= 64 && k < 128) v = a->in[11][(k - 64) * 512 + n - 512]; }
          else { if (k >= 128) v = a->in[12][(k - 128) * 512 + n - 1024]; }
          w[i] = (bf16)f2bf(v); } }
    { bf16* w = (bf16*)(ws + WS_WLORA1);
      for (int i = gt; i < 2048 * 384; i += NT) { const int n = i / 384, k = i % 384; float v = 0.f;
          if (n < 512) { if (k < 64) v = a->in[9][64 * 512 + k * 512 + n]; }
          else if (n < 1024) { if (k >= 64 && k < 128) v = a->in[11][64 * 512 + (k - 64) * 512 + n - 512]; }
          else if (n < 1536) { if (k >= 128 && k < 256) v = a->in[12][128 * 512 + (k - 128) * 512 + n - 1024]; }
          else { if (k >= 256 && k < 288) v = a->in[14][(k - 256) * 512 + n - 1536]; }
          w[i] = (bf16)f2bf(v); } }
    for (int idx = gt; idx < 131072; idx += NT) {
        const int n = idx & 1023, cg8 = (idx >> 10) & 63, l = idx >> 16, g = cg8 >> 4, c0 = (cg8 & 15) * 8;
        const float* plw = a->in[26] + ((size_t)(l * 4 + g) * 128 + c0) * 128; const float* pls = a->in[27] + l * 512 + g * 128; const float* plo = a->in[28] + ((size_t)l * 512 + g * 128) * 1024 + n;
        float acc[8];
#pragma unroll
        for (int i = 0; i < 8; ++i) acc[i] = 0.f;
        for (int d = 0; d < 128; ++d) { const float bw = plo[(size_t)d * 1024] * pls[d];
#pragma unroll
            for (int i = 0; i < 8; ++i) acc[i] += plw[i * 128 + d] * bw; }
        bf16* wbr = (bf16*)(ws + (l ? WS_WBR1 : WS_WBR0));
        *(u32x4*)(wbr + (size_t)(2048 + n) * 512 + g * 128 + c0) = pack8(acc);
    }
    float* adap = (float*)(ws + WS_ADAP);
    for (int wt = gw; wt < 1536; wt += NGW) {
        const int l = wt / 768, r = wt % 768, cb = r >> 3, kc = r & 7, col = cb * 64 + lane;
#pragma unroll
        for (int i = 0; i < 16; ++i) { const int idx = lane + 64 * i, b = idx >> 7, kk = idx & 127; const float x = a->in[1][b * 1024 + kc * 128 + kk]; scr[idx] = x * sigm(x); }
        LDS_WAIT(); asm volatile("" ::: "memory");
        float acc[8];
#pragma unroll
        for (int b = 0; b < 8; ++b) acc[b] = 0.f;
        const float* wp = a->in[2] + ((size_t)l * 1024 + kc * 128) * 6144 + col;
#pragma unroll 4
        for (int kk = 0; kk < 128; ++kk) { const float w = wp[(size_t)kk * 6144];
#pragma unroll
            for (int b = 0; b < 8; ++b) acc[b] += scr[b * 128 + kk] * w; }
#pragma unroll
        for (int b = 0; b < 8; ++b) adap[((size_t)(l * 8 + kc) * 8 + b) * 6144 + col] = acc[b];
        LDS_WAIT(); asm volatile("" ::: "memory");
    }
}
__device__ __forceinline__ void p0b_phase(ArgsP a_) {
    const ArgsP a = launder(a_);
    const int tid = opq_tid(), lane = tid & 63, wave = tid >> 6, G = opq_gdim();
    const int gw = opq_bid() * 8 + wave, NGW = G * 8, gt = opq_bid() * 512 + tid, NT = G * 512;
    const float* adap = (const float*)(a->ws + WS_ADAP); float* ada = (float*)(a->ws + WS_ADA);
    for (int i = gt; i < 2 * 49152; i += NT) { const int l = i / 49152, r = i % 49152, col = r % 6144; float s = a->in[3][l * 6144 + col];
#pragma unroll
        for (int kc = 0; kc < 8; ++kc) s += adap[(size_t)(l * 8 + kc) * 49152 + r];
        ada[i] = s; }
    bf16* H = (bf16*)(a->ws + WS_H);
    for (int rb = gw; rb < 2048; rb += NGW) {
        const int b = rb >> 8; f32x4 sh[4], sc[4];
#pragma unroll
        for (int j = 0; j < 4; ++j) { const int col = 4 * lane + 256 * j; f32x4 s0 = *(const f32x4*)(a->in[3] + col), s1 = *(const f32x4*)(a->in[3] + 1024 + col);
#pragma unroll
            for (int kc = 0; kc < 8; ++kc) { s0 += *(const f32x4*)(adap + (size_t)kc * 49152 + b * 6144 + col); s1 += *(const f32x4*)(adap + (size_t)kc * 49152 + b * 6144 + 1024 + col); }
            sh[j] = s0; sc[j] = s1 + 1.f; }
        for (int rr = 0; rr < 32; ++rr) { const size_t m = (size_t)rb * 32 + rr;
#pragma unroll
            for (int j = 0; j < 4; ++j) { const int col = 4 * lane + 256 * j; const f32x4 x = *(const f32x4*)(a->in[0] + m * 1024 + col); const f32x4 h = x * sc[j] + sh[j];
                u32x2 w; w.x = pk2(h[0], h[1]); w.y = pk2(h[2], h[3]); *(u32x2*)(H + m * 1024 + col) = w; } }
    }
}
__device__ __forceinline__ void ln_phase(float* X, bf16* H, const float* gam, const float* bet, const float* adash  , const float* adasc, bool writeH) {
    const int tid = opq_tid(), lane = tid & 63, wave = tid >> 6, gw = opq_bid() * 8 + wave, NGW = opq_gdim() * 8;
    for (int rb = gw; rb < 2048; rb += NGW) {
        const int b = rb >> 8; f32x4 g4[4], b4[4], sh[4], sc[4];
#pragma unroll
        for (int j = 0; j < 4; ++j) { const int col = 4 * lane + 256 * j; g4[j] = *(const f32x4*)(gam + col); b4[j] = *(const f32x4*)(bet + col);
            if (writeH) { sh[j] = *(const f32x4*)(adash + b * 6144 + col); sc[j] = *(const f32x4*)(adasc + b * 6144 + col) + 1.f; } else { sh[j] = g4[j]; sc[j] = g4[j]; } }
        for (int rr = 0; rr < 32; ++rr) { const size_t m = (size_t)rb * 32 + rr; f32x4 v[4]; float s = 0.f;
#pragma unroll
            for (int j = 0; j < 4; ++j) { v[j] = *(const f32x4*)(X + m * 1024 + 4 * lane + 256 * j); s += (v[j][0] + v[j][1]) + (v[j][2] + v[j][3]); }
            const float mean = wave_sum(s) * (1.f / 1024.f); float q = 0.f;
#pragma unroll
            for (int j = 0; j < 4; ++j) { v[j] = v[j] - mean; q += (v[j][0] * v[j][0] + v[j][1] * v[j][1]) + (v[j][2] * v[j][2] + v[j][3] * v[j][3]); }
            const float rstd = 1.0f / sqrtf(wave_sum(q) * (1.f / 1024.f) + LN_EPS);
#pragma unroll
            for (int j = 0; j < 4; ++j) { const int col = 4 * lane + 256 * j; const f32x4 y = v[j] * rstd * g4[j] + b4[j]; *(f32x4*)(X + m * 1024 + col) = y;
                if (writeH) { const f32x4 h = y * sc[j] + sh[j]; u32x2 w; w.x = pk2(h[0], h[1]); w.y = pk2(h[2], h[3]); *(u32x2*)(H + m * 1024 + col) = w; } } }
    }
}
__device__ __forceinline__ void prep_phase(ArgsP a_, int l, LAS unsigned char* lds) {
    const ArgsP a = launder(a_);
    const int tid = opq_tid(), lane = tid & 63, wave = tid >> 6, gw = opq_bid() * 8 + wave, NGW = opq_gdim() * 8;
    unsigned char* ar = a->ws + WS_AR;
    const bf16* ZR = (const bf16*)(ar + AR_ZR); const bf16* CG = (const bf16*)(ar + AR_CG); const bf16* PL = (const bf16*)(ar + AR_PL); const bf16* LV = (const bf16*)(ar + AR_LV);
    bf16* LA = (bf16*)(ar + AR_LA); bf16* YCV = (bf16*)(ar + AR_YCV); bf16* POOL = (bf16*)(ar + AR_POOL);
    LAS float* cw = (LAS float*)lds;
    for (int i = tid; i < 31 * 512; i += 512) cw[i] = a->in[21][l * 31 * 512 + i];
    __syncthreads();
    const int c8 = 8 * lane, ldA = l ? 384 : 256;
    float cvb[8], lng[8], lnb[8], mu[8];
    load8f(a->in[22] + l * 512 + c8, cvb); load8f(a->in[23] + l * 512 + c8, lng); load8f(a->in[24] + l * 512 + c8, lnb);
    if (lane < 32) load8f(a->in[6] + l * 1792 + 1536 + c8, mu);
    else if (l && lane < 36) load8f(a->in[7] + 8 * (lane - 32), mu);
    else {
#pragma unroll
        for (int i = 0; i < 8; ++i) mu[i] = 0.f; }
    for (int rb = gw; rb < 2048; rb += NGW)
        for (int rr = 0; rr < 32; ++rr) {
            const size_t m = (size_t)rb * 32 + rr; const int s = (int)(m & 8191);
            if (lane < 32 || (l && lane < 36)) {
                const bf16* src = lane < 32 ? ZR + m * 1792 + 1536 + c8 : LV + m * 32 + 8 * (lane - 32); const int ldp = lane < 32 ? 1792 : 32;
                float zt[8], zp[8]; unpack8(*(const u32x4*)src, zt);
                if (s > 0) unpack8(*(const u32x4*)(src - ldp), zp); else {
#pragma unroll
                    for (int i = 0; i < 8; ++i) zp[i] = 0.f; }
#pragma unroll
                for (int i = 0; i < 8; ++i) { float z = zt[i] + (zp[i] - zt[i]) * mu[i];
                    if (lane < 8) z = 1.f - 2.f / (1.f + __expf(2.f * z)); else if (lane >= 16 && lane < 32) z = sigm(z);
                    zt[i] = z; }
                *(u32x4*)(LA + m * ldA + (lane < 32 ? c8 : 256 + 8 * (lane - 32))) = pack8(zt);
            } else if (l && lane < 48) { *(u32x4*)(LA + m * ldA + c8) = (u32x4){0u, 0u, 0u, 0u}; }
            { float acc[8]; u32x4 xr[31];
#pragma unroll
              for (int j = 0; j < 31; ++j) { const size_t row = (s - 30 + j >= 0) ? (m - 30 + j) : (m - s); xr[j] = *(const u32x4*)(CG + row * 512 + c8); }
#pragma unroll
              for (int i = 0; i < 8; ++i) acc[i] = cvb[i];
#pragma unroll
              for (int j = 0; j < 31; ++j) if (s - 30 + j >= 0) { float x[8]; unpack8(xr[j], x);
                  const f32x4 w0 = *(const LAS f32x4*)(cw + j * 512 + c8), w1 = *(const LAS f32x4*)(cw + j * 512 + c8 + 4);
#pragma unroll
                  for (int i = 0; i < 4; ++i) { acc[i] += x[i] * w0[i]; acc[4 + i] += x[4 + i] * w1[i]; } }
              float s1 = 0.f;
#pragma unroll
              for (int i = 0; i < 8; ++i) s1 += acc[i];
              const float mean = wave_sum(s1) * (1.f / 512.f); float q = 0.f;
#pragma unroll
              for (int i = 0; i < 8; ++i) { acc[i] -= mean; q += acc[i] * acc[i]; }
              const float rstd = 1.0f / sqrtf(wave_sum(q) * (1.f / 512.f) + LN_EPS);
#pragma unroll
              for (int i = 0; i < 8; ++i) { const float y = acc[i] * rstd * lng[i] + lnb[i]; acc[i] = y * sigm(y); }
              *(u32x4*)(YCV + m * 512 + c8) = pack8(acc); }
            { const int win = 2 << (lane >> 4), cnt = (s + 1) < win ? (s + 1) : win; u32x4 pr[16];
#pragma unroll
              for (int i = 0; i < 16; ++i) { const size_t row = (i <= s) ? (m - i) : m; pr[i] = *(const u32x4*)(PL + row * 512 + c8); }
              float x0[8], sum[8]; unpack8(pr[0], x0);
#pragma unroll
              for (int i = 0; i < 8; ++i) sum[i] = x0[i];
#pragma unroll
              for (int i = 1; i < 16; ++i) { float x[8]; unpack8(pr[i], x); const float f = i < cnt ? 1.f : 0.f;
#pragma unroll
                  for (int q = 0; q < 8; ++q) sum[q] += x[q] * f; }
              const float inv = 1.f / (float)cnt;
#pragma unroll
              for (int i = 0; i < 8; ++i) sum[i] = sum[i] * inv - x0[i];
              *(u32x4*)(POOL + m * 512 + c8) = pack8(sum); }
        }
    __syncthreads();
}
struct HSet { u32x2 rt[2], kt[2], rp[2], kp[2], ee[2], aa[2]; unsigned short vt[2], vp[2], vm[2], vf[2]; };
constexpr int SC_VV = 0, SC_YP = 4096, SC_OPS = 20480;
__device__ __forceinline__ void sc_load(HSet& S, int c, int l, int b, int h, int rg, int hl, const bf16* ZR, const bf16* LO, int ldlo, const bf16* VF) {
    if (c >= 256) return;
    const int cg = hl & 15, vc = h * 64 + 16 * rg + cg;
#pragma unroll
    for (int p = 0; p < 2; ++p) {
        const int t = (hl >> 4) + 16 * p, s = c * 32 + t; const size_t m = (size_t)b * 8192 + s;
        const bf16* zr = ZR + m * 1792; const bf16* lo = LO + m * ldlo;
        S.rt[p] = *(const u32x2*)(zr + h * 64 + 4 * cg); S.kt[p] = *(const u32x2*)(zr + 512 + h * 64 + 4 * cg); S.vt[p] = zr[1024 + vc];
        if (s > 0) { S.rp[p] = *(const u32x2*)(zr - 1792 + h * 64 + 4 * cg); S.kp[p] = *(const u32x2*)(zr - 1792 + 512 + h * 64 + 4 * cg); S.vp[p] = zr[-1792 + 1024 + vc]; }
        else { S.rp[p] = (u32x2){0u, 0u}; S.kp[p] = (u32x2){0u, 0u}; S.vp[p] = 0; }
        S.ee[p] = *(const u32x2*)(lo + h * 64 + 4 * cg); S.aa[p] = *(const u32x2*)(lo + 512 + h * 64 + 4 * cg);
        if (l) { S.vm[p] = lo[1536 + vc]; S.vf[p] = VF[m * 512 + vc]; } else { S.vm[p] = 0; S.vf[p] = 0; }
    }
}
__device__ __forceinline__ void sc_prep(const HSet& S, int c, int buf, int l, int b, int h, int rg, int hl, LAS unsigned char* lds, bf16* VF,
                                        const f32x4 mur, const f32x4 muk, const f32x4 kkc, const f32x4 kac, const float muv) {
    if (c >= 256) return;
    const int cg = hl & 15, vc = h * 64 + 16 * rg + cg;
#pragma unroll
    for (int p = 0; p < 2; ++p) {
        const int t = (hl >> 4) + 16 * p; const size_t m = (size_t)b * 8192 + c * 32 + t;
        f32x4 rt = {bflo(S.rt[p].x), bfhi(S.rt[p].x), bflo(S.rt[p].y), bfhi(S.rt[p].y)}, rp = {bflo(S.rp[p].x), bfhi(S.rp[p].x), bflo(S.rp[p].y), bfhi(S.rp[p].y)};
        f32x4 kt = {bflo(S.kt[p].x), bfhi(S.kt[p].x), bflo(S.kt[p].y), bfhi(S.kt[p].y)}, kp = {bflo(S.kp[p].x), bfhi(S.kp[p].x), bflo(S.kp[p].y), bfhi(S.kp[p].y)};
        const f32x4 e = {bflo(S.ee[p].x), bfhi(S.ee[p].x), bflo(S.ee[p].y), bfhi(S.ee[p].y)}, av = {bflo(S.aa[p].x), bfhi(S.aa[p].x), bflo(S.aa[p].y), bfhi(S.aa[p].y)};
        const f32x4 r = rt + (rp - rt) * mur, k = kt + (kp - kt) * muk;
        f32x4 w; w[0] = __expf(-e[0]); w[1] = __expf(-e[1]); w[2] = __expf(-e[2]); w[3] = __expf(-e[3]);
        f32x4 kk = k * kkc; const float ss = red16((kk[0] * kk[0] + kk[1] * kk[1]) + (kk[2] * kk[2] + kk[3] * kk[3]));
        kk = kk * __builtin_amdgcn_rsqf(fmaxf(ss, 1e-24f));
        const f32x4 kh = k * ((av - 1.f) * kac + 1.f);
        LAS float* o = (LAS float*)(lds + SC_OPS) + (buf * 32 + t) * 320 + 4 * cg;
        *(LAS f32x4*)(o) = w; *(LAS f32x4*)(o + 64) = -kk; *(LAS f32x4*)(o + 128) = kk * av; *(LAS f32x4*)(o + 192) = kh; *(LAS f32x4*)(o + 256) = r;
        const float vt = bf1(S.vt[p]), vp = bf1(S.vp[p]); float v = vt + (vp - vt) * muv;
        if (l) v = v + (bf1(S.vf[p]) - v) * bf1(S.vm[p]); else VF[m * 512 + vc] = (bf16)pk2(v, v);
        ((LAS float*)(lds + SC_VV))[(buf * 32 + t) * 16 + cg] = v;
    }
}
__device__ __forceinline__ void sc_yred(int c, int buf, int b, int h, int rg, int hl, LAS unsigned char* lds, bf16* YRW) {
    const int i = hl & 15;
#pragma unroll
    for (int p = 0; p < 2; ++p) { const int t = (hl >> 4) + 16 * p; const size_t m = (size_t)b * 8192 + c * 32 + t;
        const f32x4 q = *(const LAS f32x4*)((LAS float*)(lds + SC_YP) + ((buf * 32 + t) * 16 + i) * 4);
        const float ys = (q[0] + q[1]) + (q[2] + q[3]); YRW[m * 512 + h * 64 + 16 * rg + i] = (bf16)pk2(ys, ys); }
}
typedef float f32x2 __attribute__((ext_vector_type(2)));
struct ScOp { f32x4 w, a, b, k, r; float v; };
__device__ __forceinline__ ScOp sc_ld(const LAS float* ops, const LAS float* vv, int t) {
    ScOp o; o.w = *(const LAS f32x4*)(ops + t * 320); o.a = *(const LAS f32x4*)(ops + t * 320 + 64); o.b = *(const LAS f32x4*)(ops + t * 320 + 128);
    o.k = *(const LAS f32x4*)(ops + t * 320 + 192); o.r = *(const LAS f32x4*)(ops + t * 320 + 256); o.v = vv[t * 16]; return o;
}
__device__ __forceinline__ void sc_step(f32x2& s0, f32x2& s1, const ScOp& o, LAS float* ypt) {
    f32x2 p = s0 * o.a.xy; p = s1 * o.a.zw + p;
    const f32x2 vv = {o.v, o.v};
    const f32x2 t0 = s0 * o.w.xy + o.k.xy * vv, t1 = s1 * o.w.zw + o.k.zw * vv;
    const float sa = red16(p.x + p.y);
    const f32x2 sav = {sa, sa};
    s0 = o.b.xy * sav + t0;
    s1 = o.b.zw * sav + t1;
    f32x2 q = s0 * o.r.xy; q = s1 * o.r.zw + q;
    *ypt = red4(q.x + q.y);
}
__device__ __forceinline__ void sc_scan(f32x2& s0, f32x2& s1, int buf, int row, int seg, int lane, LAS unsigned char* lds) {
    const LAS float* ops = (const LAS float*)(lds + SC_OPS) + buf * 32 * 320 + 4 * seg;
    const LAS float* vv = (const LAS float*)(lds + SC_VV) + buf * 32 * 16 + row;
    LAS float* yp = (LAS float*)(lds + SC_YP) + (buf * 32 * 16 + row) * 4 + (seg >> 2);
    ScOp o0 = sc_ld(ops, vv, 0), o1 = sc_ld(ops, vv, 1);
#pragma unroll
    for (int t = 0; t < 32; t += 2) {
        const ScOp o2 = sc_ld(ops, vv, t + 2); sc_step(s0, s1, o0, yp + t * 64);
        const ScOp o3 = sc_ld(ops, vv, t + 3); sc_step(s0, s1, o1, yp + (t + 1) * 64);
        o0 = o2; o1 = o3;
    }
}
__device__ __forceinline__ void scan_phase(ArgsP a_, int l, LAS unsigned char* lds) {
    const ArgsP a = launder(a_);
    const int tid = opq_tid(), lane = tid & 63, wave = __builtin_amdgcn_readfirstlane(tid >> 6);
    unsigned char* ar = a->ws + WS_AR;
    const bf16* ZR = (const bf16*)(ar + AR_ZR); const bf16* LO = (const bf16*)(ar + AR_LO); const int ldlo = l ? 2048 : 1536;
    bf16* VF = (bf16*)(a->ws + WS_VFIRST); bf16* YRW = (bf16*)(ar + AR_YRW);
    for (int u = opq_bid(); u < 256; u += opq_gdim()) {
        const int b = u >> 5, h = (u >> 2) & 7, rg = u & 3;
        if (wave < 4) {
            f32x2 s0 = {0.f, 0.f}, s1 = {0.f, 0.f}; const int row = 4 * wave + (lane >> 4), seg = lane & 15;
            __syncthreads();
            for (int c = 0; c < 256; c += 2) { sc_scan(s0, s1, 0, row, seg, lane, lds); __syncthreads(); sc_scan(s0, s1, 1, row, seg, lane, lds); __syncthreads(); }
        } else {
            const int hl = tid - 256, cg = hl & 15, ch = h * 64 + 4 * cg, vc = h * 64 + 16 * rg + cg;
            const f32x4 mur = *(const f32x4*)(a->in[6] + l * 1792 + ch), muk = *(const f32x4*)(a->in[6] + l * 1792 + 512 + ch);
            const f32x4 kkc = *(const f32x4*)(a->in[15] + l * 512 + ch), kac = *(const f32x4*)(a->in[16] + l * 512 + ch);
            const float muv = a->in[6][l * 1792 + 1024 + vc];
            HSet SA, SB;
            sc_load(SA, 0, l, b, h, rg, hl, ZR, LO, ldlo, VF); sc_prep(SA, 0, 0, l, b, h, rg, hl, lds, VF, mur, muk, kkc, kac, muv);
            sc_load(SA, 1, l, b, h, rg, hl, ZR, LO, ldlo, VF); sc_load(SB, 2, l, b, h, rg, hl, ZR, LO, ldlo, VF);
            __syncthreads();
            for (int c = 0; c < 256; c += 2) {
                if (c > 0) sc_yred(c - 1, 1, b, h, rg, hl, lds, YRW);
                sc_prep(SA, c + 1, 1, l, b, h, rg, hl, lds, VF, mur, muk, kkc, kac, muv);
                if (DUPM & 32) { f32x4 m2 = mur; asm volatile("" : "+v"(m2) :: "memory"); sc_prep(SA, c + 1, 1, l, b, h, rg, hl, lds, VF, m2, muk, kkc, kac, muv); }
                sc_load(SA, c + 3, l, b, h, rg, hl, ZR, LO, ldlo, VF);
                __syncthreads();
                sc_yred(c, 0, b, h, rg, hl, lds, YRW);
                sc_prep(SB, c + 2, 0, l, b, h, rg, hl, lds, VF, mur, muk, kkc, kac, muv);
                if (DUPM & 32) { f32x4 m2 = mur; asm volatile("" : "+v"(m2) :: "memory"); sc_prep(SB, c + 2, 0, l, b, h, rg, hl, lds, VF, m2, muk, kkc, kac, muv); }
                sc_load(SB, c + 4, l, b, h, rg, hl, ZR, LO, ldlo, VF);
                __syncthreads();
            }
            sc_yred(255, 1, b, h, rg, hl, lds, YRW);
        }
        __syncthreads();
    }
}
__device__ __forceinline__ void post_phase(ArgsP a_, int l) {
    const ArgsP a = launder(a_);
    const int tid = opq_tid(), lane = tid & 63, wave = tid >> 6, gw = opq_bid() * 8 + wave, NGW = opq_gdim() * 8, c8 = 8 * lane;
    unsigned char* ar = a->ws + WS_AR;
    const bf16* ZR = (const bf16*)(ar + AR_ZR); const bf16* LO = (const bf16*)(ar + AR_LO); const int ldlo = l ? 2048 : 1536;
    const bf16* VF = (const bf16*)(a->ws + WS_VFIRST); bf16* YRW = (bf16*)(ar + AR_YRW);
    float mur[8], muk[8], muv[8], ka[8], rk[8], gng[8], gnb[8];
    load8f(a->in[6] + l * 1792 + c8, mur); load8f(a->in[6] + l * 1792 + 512 + c8, muk); load8f(a->in[6] + l * 1792 + 1024 + c8, muv);
    load8f(a->in[16] + l * 512 + c8, ka); load8f(a->in[17] + l * 512 + c8, rk); load8f(a->in[18] + l * 512 + c8, gng); load8f(a->in[19] + l * 512 + c8, gnb);
    for (int rb = gw; rb < 2048; rb += NGW)
        for (int rr = 0; rr < 32; ++rr) {
            const size_t m = (size_t)rb * 32 + rr; const int s = (int)(m & 8191);
            const bf16* zr = ZR + m * 1792 + c8; const bf16* lo = LO + m * ldlo + c8;
            float y[8], rt[8], kt[8], vt[8], rp[8], kp[8], vp[8], av[8], g[8];
            unpack8(*(const u32x4*)(YRW + m * 512 + c8), y);
            unpack8(*(const u32x4*)zr, rt); unpack8(*(const u32x4*)(zr + 512), kt); unpack8(*(const u32x4*)(zr + 1024), vt);
            if (s > 0) { unpack8(*(const u32x4*)(zr - 1792), rp); unpack8(*(const u32x4*)(zr - 1792 + 512), kp); unpack8(*(const u32x4*)(zr - 1792 + 1024), vp); }
            else {
#pragma unroll
                for (int i = 0; i < 8; ++i) { rp[i] = 0.f; kp[i] = 0.f; vp[i] = 0.f; } }
            unpack8(*(const u32x4*)(lo + 512), av); unpack8(*(const u32x4*)(lo + 1024), g);
            float bon = 0.f, sy = 0.f;
#pragma unroll
            for (int i = 0; i < 8; ++i) { const float r = rt[i] + (rp[i] - rt[i]) * mur[i], k = kt[i] + (kp[i] - kt[i]) * muk[i]; vt[i] = vt[i] + (vp[i] - vt[i]) * muv[i];
                bon += r * (k * (1.f + (av[i] - 1.f) * ka[i])) * rk[i]; sy += y[i]; }
            if (l) { float vm[8], vf[8]; unpack8(*(const u32x4*)(lo + 1536), vm); unpack8(*(const u32x4*)(VF + m * 512 + c8), vf);
#pragma unroll
                for (int i = 0; i < 8; ++i) vt[i] = vt[i] + (vf[i] - vt[i]) * vm[i]; }
            bon = red8(bon); const float mean = red8(sy) * (1.f / 64.f); float q = 0.f;
#pragma unroll
            for (int i = 0; i < 8; ++i) { y[i] -= mean; q += y[i] * y[i]; }
            const float rstd = 1.0f / sqrtf(red8(q) * (1.f / 64.f) + GN_EPS);
#pragma unroll
            for (int i = 0; i < 8; ++i) y[i] = (y[i] * rstd * gng[i] + gnb[i] + bon * vt[i]) * g[i];
            *(u32x4*)(YRW + m * 512 + c8) = pack8(y);
        }
}
__device__ __forceinline__ void combine_phase(ArgsP a_) {
    const ArgsP a = launder(a_);
    const int gt = opq_bid() * 512 + opq_tid(), NT = opq_gdim() * 512;
    const bf16* P = (const bf16*)(a->ws + WS_AR + AR_P); bf16* Hm = (bf16*)(a->ws + WS_H);
    for (int i = gt; i < M * 128; i += NT) { const size_t m = (size_t)(i >> 7); const int c8 = (i & 127) * 8; float p0[8], p1[8], p2[8];
        unpack8(*(const u32x4*)(P + m * 3072 + c8), p0); unpack8(*(const u32x4*)(P + m * 3072 + 1024 + c8), p1); unpack8(*(const u32x4*)(P + m * 3072 + 2048 + c8), p2);
#pragma unroll
        for (int q = 0; q < 8; ++q) p0[q] = (p0[q] + p1[q]) + p2[q];
        *(u32x4*)(Hm + m * 1024 + c8) = pack8(p0); }
}

#ifndef DUPM
#define DUPM 0
#endif
#ifndef PHM
#define PHM 0x7fff
#endif
#define GSYNC() do { XcdBarrier b_; b_.bar = (unsigned*)(launder(ak)->ws) + 1024; b_.x = xb_xcc_id(); b_.st = (volatile LAS unsigned*)(lds + LDS_BYTES - 64); xcd_barrier(b_); } while (0)
__global__ void __launch_bounds__(512, 2) fwd_kernel(Args kargs) {
    extern __shared__ __attribute__((aligned(16))) unsigned char lds_raw[];
    LAS unsigned char* lds = (LAS unsigned char*)lds_raw;
    cg::grid_group grid = cg::this_grid();
    { volatile LAS unsigned* st0 = (volatile LAS unsigned*)(lds + LDS_BYTES - 64); if (threadIdx.x == 0) { st0[0] = 0u; st0[1] = 0u; } __syncthreads(); }
    (void)xcd_barrier_post((unsigned*)(launder((ArgsP)__builtin_amdgcn_kernarg_segment_ptr())->ws) + 1024, (volatile LAS unsigned*)(lds + LDS_BYTES - 64));
    const ArgsP ak = (ArgsP)__builtin_amdgcn_kernarg_segment_ptr();

    if (PHM & 1) p0_phase(ak, lds); grid.sync();
    if (PHM & 2) p0b_phase(ak); GSYNC();
#pragma unroll 1
    for (int l = 0; l < 2; ++l) {
        if (PHM & 4) { const ArgsP a = launder(ak); const int G = opq_gdim(), bx = opq_bid(); unsigned char* ws = a->ws; unsigned char* ar = ws + WS_AR; bf16* H = (bf16*)(ws + WS_H); const float* adal = (const float*)(ws + WS_ADA) + l * 49152; (void)ar; (void)H; (void)adal;
          pg8::Gemm g{H, nullptr, nullptr, 0, (const bf16*)(ws + (l ? WS_WINA1 : WS_WINA0)), M, l ? 3584 : 3328, 1024};
          pg8::StaticOrder S; S.init(M, g.N, G, bx);
          EpiG1 E{(bf16*)(ar + AR_ZR), (bf16*)(ar + AR_CG), (bf16*)(ar + AR_PL), (bf16*)(ar + AR_LV)};
          pg8::gemm_phase<EpiG1, pg8::StaticOrder, true, true>(lds, g, S, E); }
        GSYNC();
        if (PHM & 8) prep_phase(ak, l, lds); GSYNC();
        if (DUPM & 1) { prep_phase(ak, l, lds); GSYNC(); }
        if (PHM & 16) { const ArgsP a = launder(ak); const int G = opq_gdim(), bx = opq_bid(); unsigned char* ws = a->ws; unsigned char* ar = ws + WS_AR; bf16* H = (bf16*)(ws + WS_H); const float* adal = (const float*)(ws + WS_ADA) + l * 49152; (void)ar; (void)H; (void)adal;
          pg8::Gemm g{(const bf16*)(ar + AR_LA), nullptr, nullptr, 0, (const bf16*)(ws + (l ? WS_WLORA1 : WS_WLORA0)), M, l ? 2048 : 1536, l ? 384 : 256};
          pg8::StaticOrder S; S.init(M, g.N, G, bx);
          EpiLora E{(bf16*)(ar + AR_LO), l ? 2048 : 1536, a->in[8] + l * 512, a->in[10] + l * 512, a->in[13]};
          pg8::gemm_phase<EpiLora, pg8::StaticOrder, true, true>(lds, g, S, E); }
        GSYNC();
        if (PHM & 32) scan_phase(ak, l, lds); GSYNC();
        if (DUPM & 16) { scan_phase(ak, l, lds); GSYNC(); }
        if (PHM & 64) post_phase(ak, l); GSYNC();
        if (DUPM & 2) { scan_phase(ak, l, lds); GSYNC(); post_phase(ak, l); GSYNC(); }
        if (DUPM & 4) { for (int q = 0; q < 16; ++q) GSYNC(); }
        if (PHM & 128) { const ArgsP a = launder(ak); const int G = opq_gdim(), bx = opq_bid(); unsigned char* ws = a->ws; unsigned char* ar = ws + WS_AR; bf16* H = (bf16*)(ws + WS_H); const float* adal = (const float*)(ws + WS_ADA) + l * 49152; (void)ar; (void)H; (void)adal;
          pg8::Gemm g{(const bf16*)(ar + AR_YRW), (const bf16*)(ar + AR_YCV), (const bf16*)(ar + AR_POOL), 4, (const bf16*)(ws + (l ? WS_WBR1 : WS_WBR0)), M, 3072, 512};
          pg8::StaticOrder S; S.init(M, g.N, G, bx);
          EpiBf<0> E{(bf16*)(ar + AR_P), 3072};
          pg8::gemm_phase<EpiBf<0>, pg8::StaticOrder, true, true>(lds, g, S, E); }
        GSYNC();
        if (PHM & 256) { const ArgsP a = launder(ak); const int G = opq_gdim(), bx = opq_bid(); unsigned char* ws = a->ws; unsigned char* ar = ws + WS_AR; bf16* H = (bf16*)(ws + WS_H); const float* adal = (const float*)(ws + WS_ADA) + l * 49152; (void)ar; (void)H; (void)adal;
          pg8::Gemm g{H, nullptr, nullptr, 0, (const bf16*)(ws + (l ? WS_WG1 : WS_WG0)), M, 3072, 1024};
          pg8::StaticOrder S; S.init(M, g.N, G, bx);
          EpiBf<2> E{(bf16*)(ar + AR_P), 3072};
          pg8::gemm_phase<EpiBf<2>, pg8::StaticOrder, true, true>(lds, g, S, E); }
        GSYNC();
        if (PHM & 512) combine_phase(ak); GSYNC();
        if (PHM & 1024) { const ArgsP a = launder(ak); const int G = opq_gdim(), bx = opq_bid(); unsigned char* ws = a->ws; unsigned char* ar = ws + WS_AR; bf16* H = (bf16*)(ws + WS_H); const float* adal = (const float*)(ws + WS_ADA) + l * 49152; (void)ar; (void)H; (void)adal;
          pg8::Gemm g{H, nullptr, nullptr, 0, (const bf16*)(ws + (l ? WS_WOUT1 : WS_WOUT0)), M, 1024, 1024};
          pg8::StaticOrder S; S.init(M, g.N, G, bx);
          EpiRes E{l ? (const float*)a->out : a->in[0], a->out, adal + 2 * 1024};
          pg8::gemm_phase<EpiRes, pg8::StaticOrder, true, true>(lds, g, S, E); }
        GSYNC();
        if (PHM & 2048) { const ArgsP a = launder(ak); const float* adal = (const float*)(a->ws + WS_ADA) + l * 49152;
          ln_phase(a->out, (bf16*)(a->ws + WS_H), a->in[30] + l * 1024, a->in[31] + l * 1024, adal + 3 * 1024, adal + 4 * 1024, true); }
        GSYNC();
        if (PHM & 4096) { const ArgsP a = launder(ak); const int G = opq_gdim(), bx = opq_bid(); unsigned char* ws = a->ws; unsigned char* ar = ws + WS_AR; bf16* H = (bf16*)(ws + WS_H); const float* adal = (const float*)(ws + WS_ADA) + l * 49152; (void)ar; (void)H; (void)adal;
          pg8::Gemm g{H, nullptr, nullptr, 0, (const bf16*)(ws + (l ? WS_W1_1 : WS_W1_0)), M, 4096, 1024};
          pg8::StaticOrder S; S.init(M, g.N, G, bx);
          EpiBf<1> E{(bf16*)(ar + AR_HID), 4096};
          pg8::gemm_phase<EpiBf<1>, pg8::StaticOrder, true, true>(lds, g, S, E); }
        GSYNC();
        if (PHM & 8192) { const ArgsP a = launder(ak); const int G = opq_gdim(), bx = opq_bid(); unsigned char* ws = a->ws; unsigned char* ar = ws + WS_AR; bf16* H = (bf16*)(ws + WS_H); const float* adal = (const float*)(ws + WS_ADA) + l * 49152; (void)ar; (void)H; (void)adal;
          pg8::Gemm g{(const bf16*)(ar + AR_HID), nullptr, nullptr, 0, (const bf16*)(ws + (l ? WS_W2_1 : WS_W2_0)), M, 1024, 4096};
          pg8::StaticOrder S; S.init(M, g.N, G, bx);
          EpiRes E{a->out, a->out, adal + 5 * 1024};
          pg8::gemm_phase<EpiRes, pg8::StaticOrder, true, true>(lds, g, S, E); }
        GSYNC();
        if (PHM & 16384) { const ArgsP a = launder(ak); const float* ada1 = (const float*)(a->ws + WS_ADA) + 49152;
          ln_phase(a->out, (bf16*)(a->ws + WS_H), a->in[34] + l * 1024, a->in[35] + l * 1024, ada1, ada1 + 1024, l == 0); }
        if (l == 0) GSYNC();
    }
}

extern "C" void kernel_launch(void* const* d_in, const int* in_sizes, int n_in, void* d_out, int out_size, void* d_ws, size_t ws_size, hipStream_t stream) {
    static int grid = 0;
    if (grid == 0) {
        if (n_in != 36 || out_size != M * D || ws_size < WS_END) { fprintf(stderr, "kernel_launch: unexpected shapes (n_in %d, out %d, ws %zu)\n", n_in, out_size, ws_size); grid = -1; return; }
        int dev = 0, cus = 0, per_cu = 0;
        hipGetDevice(&dev); hipDeviceGetAttribute(&cus, hipDeviceAttributeMultiprocessorCount, dev);
        hipFuncSetAttribute((const void*)fwd_kernel, hipFuncAttributeMaxDynamicSharedMemorySize, LDS_BYTES);
        hipOccupancyMaxActiveBlocksPerMultiprocessor(&per_cu, (const void*)fwd_kernel, 512, LDS_BYTES);
        (void)hipGetLastError();
        if (per_cu < 1) per_cu = 1;
        grid = cus;
        if (grid > 256) grid = 256;
    }
    if (grid < 0) return;
    if (hipMemsetAsync(d_ws, 0, 65536, stream) != hipSuccess) { fprintf(stderr, "kernel_launch: memset failed\n"); return; }
    Args ha{};
    for (int i = 0; i < 36; ++i) ha.in[i] = (const float*)d_in[i];
    ha.out = (float*)d_out; ha.ws = (unsigned char*)d_ws;
    void* params[] = {&ha};
    hipError_t e = hipLaunchCooperativeKernel((const void*)fwd_kernel, dim3(grid), dim3(512), params, LDS_BYTES, stream);
    if (e != hipSuccess) fprintf(stderr, "cooperative launch failed: %s (grid %d)\n", hipGetErrorString(e), grid);
}
```

```cpp
#include <hip/hip_runtime.h>
#include <hip/hip_cooperative_groups.h>
#include <cstdio>
#include <cstdint>
namespace cg = cooperative_groups;
__device__ __forceinline__ int opq_tid() { int t = threadIdx.x; asm volatile("" : "+v"(t)); return t; }
__device__ __forceinline__ int opq_bid() { int t = blockIdx.x; asm volatile("" : "+s"(t)); return t; }
__device__ __forceinline__ int opq_gdim() { int t = gridDim.x; asm volatile("" : "+s"(t)); return t; }
#ifndef DUPM
#define DUPM 0
#endif
#ifndef PHM
#define PHM 0x7fff
#endif
namespace pg8 {
#define PG8_LAS __attribute__((address_space(3)))
typedef unsigned short bf16_t;
typedef short bf16x8 __attribute__((ext_vector_type(8)));
typedef float f32x4 __attribute__((ext_vector_type(4)));
typedef unsigned u32x4 __attribute__((ext_vector_type(4)));
constexpr int BM = 256, BK = 64, HALF = 128, HTB = HALF * BK * 2  , STAGE_BYTES = 8 * HTB, NXCD = 8, WGM = 8;

__host__ __device__ __forceinline__ int lds_byte(int r, int c) { const int st = (r >> 4) * 2 + (c >> 5), rr = r & 15, cc = c & 31, ob = rr * 64 + cc * 2; return st * 1024 + (ob ^ (((ob >> 9) & 1) << 5)); }
__host__ __device__ __forceinline__ void stage_rc(int b, int& R, int& C) { const int st = b / 1024, sb = b % 1024, swz = sb ^ (((sb >> 9) & 1) << 5); R = (st >> 1) * 16 + swz / 64; C = (st & 1) * 32 + (swz % 64) / 2; }
__host__ __device__ __forceinline__ int perm32(int rho) { const int n = rho >> 4, i = rho & 15; return 8 * (i >> 2) + 4 * n + (i & 3); }

struct Unit { int pm, pn; };
struct Gemm { const bf16_t* A; const bf16_t* A1; const bf16_t* A2; int segt; const bf16_t* Bt; int M, N, K;
    __device__ __forceinline__ const bf16_t* a_of(int pn) const { return segt == 0 ? A : (pn < segt ? A : (pn < 2 * segt ? A1 : A2)); } };

struct StaticOrder {
    int nM, nN, nwg, G, c;
    __host__ __device__ void init(int M, int N, int G_, int c_) { nM = M / BM; nN = N / BM; nwg = nM * nN; G = G_; c = c_; }
    __host__ __device__ bool next(int i, Unit& u) const {
        const long L = (long)i * G + c; if (L >= nwg) return false;
        int wgid = (int)L; { const int q = nwg / NXCD, r = nwg % NXCD, xcd = wgid % NXCD, off = wgid / NXCD; wgid = (xcd < r ? xcd * (q + 1) : r * (q + 1) + (xcd - r) * q) + off; }
        const int nig = WGM * nN, gid = wgid / nig, fm = gid * WGM, gsz = (nM - fm) < WGM ? (nM - fm) : WGM;
        u.pm = fm + ((wgid % nig) % gsz); u.pn = (wgid % nig) / gsz; return true;
    }
    __device__ __forceinline__ void a_ready(const Unit&) const {}
    __device__ __forceinline__ void done(const Unit&) const {}
};
__device__ __forceinline__ unsigned cvt_pk_bf16(float lo, float hi) { unsigned r; asm volatile("v_cvt_pk_bf16_f32 %0, %1, %2" : "=v"(r) : "v"(lo), "v"(hi)); return r; }
template <class Epi, class Sched, bool ALIGN_EPI = false, bool SP2 = false>
__device__ __forceinline__ void gemm_phase(PG8_LAS unsigned char* lds, const Gemm g, const Sched& S, const Epi& E) {
    const int tid = opq_tid(), wid = __builtin_amdgcn_readfirstlane(tid >> 6), lane = tid & 63, wr = wid >> 2, wc = wid & 3, fr = lane & 15, fq = lane >> 4;
    const int K = g.K, nt = K / BK;
    unsigned voffA[2], voffB[2];
#pragma unroll
    for (int i = 0; i < 2; ++i) { int R, C; stage_rc(tid * 16 + i * 8192, R, C); const int Rb = Epi::PERM ? ((R & ~31) + perm32(R & 31)) : R;
        voffA[i] = (unsigned)(R * K + C) * 2u; voffB[i] = (unsigned)(Rb * K + C) * 2u; }
    const size_t kstep = (size_t)(BK * 2);
    const size_t hstep = (size_t)HALF * K * 2;
    const size_t tstep = 2 * hstep;
    const unsigned ldsw = (unsigned)wid * 1024u;
    const int aoff = lds_byte(wr * 64 + fr, fq * 8), boff = lds_byte(wc * 32 + fr, fq * 8);
#define PG8_SA(b, h) (((b) * 2 + (h)) * HTB)
#define PG8_SB(b, h) ((4 + (b) * 2 + (h)) * HTB)
#define PG8_STAGE(bufoff, gbase, voff) do { _Pragma("unroll") for (int _i = 0; _i < 2; ++_i) \
        __builtin_amdgcn_global_load_lds((const unsigned*)((const char*)(gbase) + (voff)[_i]), (PG8_LAS unsigned*)(lds + (bufoff) + ldsw + _i * 8192), 16, 0, 0); } while (0)
#define PG8_LDA(dst, b, h) do { _Pragma("unroll") for (int m = 0; m < 4; ++m) _Pragma("unroll") for (int k = 0; k < 2; ++k) dst[m][k] = *(const PG8_LAS bf16x8*)(lds + PG8_SA(b, h) + aoff + m * 2048 + k * 1024); } while (0)
#define PG8_LDB(dst, b, h) do { _Pragma("unroll") for (int n = 0; n < 2; ++n) _Pragma("unroll") for (int k = 0; k < 2; ++k) dst[n][k] = *(const PG8_LAS bf16x8*)(lds + PG8_SB(b, h) + boff + n * 2048 + k * 1024); } while (0)
#define PG8_MMA(ai, bj, At, Bt) do { __builtin_amdgcn_s_setprio(1); _Pragma("unroll") for (int m = 0; m < 4; ++m) _Pragma("unroll") for (int n = 0; n < 2; ++n) _Pragma("unroll") for (int k = 0; k < 2; ++k) \
        acc[ai][bj][m][n] = __builtin_amdgcn_mfma_f32_16x16x32_bf16(Bt[n][k], At[m][k], acc[ai][bj][m][n], 0, 0, 0); __builtin_amdgcn_s_setprio(0); } while (0)
#define PG8_WAIT_V(n) asm volatile("s_waitcnt vmcnt(" #n ")" ::: "memory")
#define PG8_WAIT_L(n) asm volatile("s_waitcnt lgkmcnt(" #n ")" ::: "memory")
#define PG8_BAR __builtin_amdgcn_s_barrier()
#define PG8_SCHED __builtin_amdgcn_sched_barrier(0)
    Unit cur, nxt; int ui = 0;
    if (!S.next(0, cur)) return;
    f32x4 acc[2][2][4][2];
#pragma unroll
    for (int a = 0; a < 2; ++a)
#pragma unroll
        for (int b = 0; b < 2; ++b)
#pragma unroll
            for (int m = 0; m < 4; ++m)
#pragma unroll
                for (int n = 0; n < 2; ++n) acc[a][b][m][n] = (f32x4){0.f, 0.f, 0.f, 0.f};
    bf16x8 At[4][2], B0[2][2], B1[2][2];
    const char* cA = (const char*)g.a_of(cur.pn) + (size_t)cur.pm * tstep; const char* cB = (const char*)g.Bt + (size_t)cur.pn * tstep;
    S.a_ready(cur);
    if constexpr (SP2) {
        PG8_STAGE(PG8_SB(0, 0), cB, voffB); PG8_STAGE(PG8_SB(0, 1), cB + hstep, voffB); PG8_STAGE(PG8_SA(0, 0), cA, voffA); PG8_STAGE(PG8_SA(0, 1), cA + hstep, voffA);
        if (wr == 1) PG8_BAR;
        PG8_WAIT_V(2); PG8_BAR;
        PG8_STAGE(PG8_SB(1, 0), cB + kstep, voffB); PG8_STAGE(PG8_SA(1, 0), cA + kstep, voffA); PG8_STAGE(PG8_SB(1, 1), cB + hstep + kstep, voffB);
        PG8_WAIT_V(6); PG8_BAR;
    } else {
        PG8_STAGE(PG8_SB(0, 0), cB, voffB); PG8_STAGE(PG8_SA(0, 0), cA, voffA); PG8_STAGE(PG8_SB(0, 1), cB + hstep, voffB); PG8_STAGE(PG8_SA(0, 1), cA + hstep, voffA);
        if (wr == 1) PG8_BAR;
        PG8_WAIT_V(4); PG8_BAR;
        PG8_STAGE(PG8_SB(1, 0), cB + kstep, voffB); PG8_STAGE(PG8_SA(1, 0), cA + kstep, voffA); PG8_STAGE(PG8_SB(1, 1), cB + hstep + kstep, voffB);
        PG8_WAIT_V(6); PG8_BAR;
    }
    for (;;) {
        const bool has_next = S.next(ui + 1, nxt);
        const char* nA = has_next ? (const char*)g.a_of(nxt.pn) + (size_t)nxt.pm * tstep : cA; const char* nB = has_next ? (const char*)g.Bt + (size_t)nxt.pn * tstep : cB;
        for (int t = 0; t < nt; t += 2) {
            const bool last = (t == nt - 2);
            const char* a1 = cA + (size_t)(t + 1) * kstep;
            const char* a2 = last ? nA : cA + (size_t)(t + 2) * kstep; const char* b2 = last ? nB : cB + (size_t)(t + 2) * kstep;
            const char* a3 = a2 + kstep; const char* b3 = b2 + kstep;
            if (last && has_next) S.a_ready(nxt);
            if constexpr (SP2) {
            PG8_LDB(B0, 0, 0); PG8_LDB(B1, 0, 1); PG8_SCHED; PG8_LDA(At, 0, 0); PG8_STAGE(PG8_SA(1, 1), a1 + hstep, voffA);
            PG8_WAIT_V(8); PG8_WAIT_L(0); PG8_BAR; PG8_MMA(0, 0, At, B0); PG8_MMA(0, 1, At, B1); PG8_BAR; PG8_SCHED;
            PG8_LDA(At, 0, 1); PG8_STAGE(PG8_SB(0, 0), b2, voffB); PG8_STAGE(PG8_SB(0, 1), b2 + hstep, voffB); PG8_STAGE(PG8_SA(0, 0), a2, voffA);
            PG8_WAIT_V(8); PG8_WAIT_L(0); PG8_BAR; PG8_MMA(1, 0, At, B0); PG8_MMA(1, 1, At, B1); PG8_BAR; PG8_SCHED;
            PG8_LDB(B0, 1, 0); PG8_LDB(B1, 1, 1); PG8_SCHED; PG8_LDA(At, 1, 0); PG8_STAGE(PG8_SA(0, 1), a2 + hstep, voffA);
            PG8_WAIT_V(8); PG8_WAIT_L(0); PG8_BAR; PG8_MMA(0, 0, At, B0); PG8_MMA(0, 1, At, B1); PG8_BAR; PG8_SCHED;
            PG8_LDA(At, 1, 1); PG8_STAGE(PG8_SB(1, 0), b3, voffB); PG8_STAGE(PG8_SB(1, 1), b3 + hstep, voffB); PG8_STAGE(PG8_SA(1, 0), a3, voffA);
            PG8_WAIT_V(8); PG8_WAIT_L(0); PG8_BAR; PG8_MMA(1, 0, At, B0); PG8_MMA(1, 1, At, B1); PG8_BAR; PG8_SCHED;
            } else {
            PG8_LDB(B0, 0, 0); PG8_SCHED; PG8_LDA(At, 0, 0); PG8_STAGE(PG8_SA(1, 1), a1 + hstep, voffA);
            PG8_WAIT_L(8); PG8_BAR; PG8_WAIT_L(0); PG8_MMA(0, 0, At, B0); PG8_BAR; PG8_SCHED;
            PG8_LDB(B1, 0, 1); PG8_STAGE(PG8_SB(0, 0), b2, voffB);
            PG8_BAR; PG8_WAIT_L(0); PG8_MMA(0, 1, At, B1); PG8_BAR;
            PG8_LDA(At, 0, 1); PG8_STAGE(PG8_SA(0, 0), a2, voffA);
            PG8_BAR; PG8_WAIT_L(0); PG8_MMA(1, 0, At, B0); PG8_BAR; PG8_SCHED;
            PG8_STAGE(PG8_SB(0, 1), b2 + hstep, voffB);
            PG8_WAIT_V(6); PG8_BAR; PG8_MMA(1, 1, At, B1); PG8_BAR;
            PG8_LDB(B0, 1, 0); PG8_SCHED; PG8_LDA(At, 1, 0); PG8_STAGE(PG8_SA(0, 1), a2 + hstep, voffA);
            PG8_WAIT_L(8); PG8_BAR; PG8_WAIT_L(0); PG8_MMA(0, 0, At, B0); PG8_BAR; PG8_SCHED;
            PG8_LDB(B1, 1, 1); PG8_STAGE(PG8_SB(1, 0), b3, voffB);
            PG8_BAR; PG8_WAIT_L(0); PG8_MMA(0, 1, At, B1); PG8_BAR;
            PG8_LDA(At, 1, 1); PG8_STAGE(PG8_SA(1, 0), a3, voffA);
            PG8_BAR; PG8_WAIT_L(0); PG8_MMA(1, 0, At, B0); PG8_BAR; PG8_SCHED;
            PG8_STAGE(PG8_SB(1, 1), b3 + hstep, voffB);
            PG8_WAIT_V(6); PG8_BAR; PG8_MMA(1, 1, At, B1); PG8_BAR;
            }
        }
        if constexpr (ALIGN_EPI) { if (wr == 0) PG8_BAR; }
        if constexpr (!Epi::AFTER_DRAIN) { E(acc, cur, wr, wc, fr, fq); S.done(cur); }
        if (!has_next) break;
#pragma unroll
        for (int a = 0; a < 2; ++a)
#pragma unroll
            for (int b = 0; b < 2; ++b)
#pragma unroll
                for (int m = 0; m < 4; ++m)
#pragma unroll
                    for (int n = 0; n < 2; ++n) acc[a][b][m][n] = (f32x4){0.f, 0.f, 0.f, 0.f};
        cur = nxt; cA = nA; cB = nB; ++ui;
        if constexpr (ALIGN_EPI) { if (wr == 1) PG8_BAR; }
    }
    PG8_WAIT_V(0);
    if constexpr (!ALIGN_EPI) { if (wr == 0) PG8_BAR; }
    PG8_BAR;
    if constexpr (Epi::AFTER_DRAIN) { E.fused(acc, cur, wr, wc, fr, fq, lds, wid, lane); S.done(cur); }
#undef PG8_SA
#undef PG8_SB
#undef PG8_STAGE
#undef PG8_LDA
#undef PG8_LDB
#undef PG8_MMA
#undef PG8_WAIT_V
#undef PG8_WAIT_L
#undef PG8_BAR
#undef PG8_SCHED
}
}

#define LAS __attribute__((address_space(3)))
typedef unsigned short bf16;
typedef pg8::f32x4 f32x4;
typedef pg8::u32x4 u32x4;
typedef unsigned u32x2 __attribute__((ext_vector_type(2)));
using pg8::Unit;

constexpr int M = 65536, D = 1024, SEQ = 8192;
constexpr float ALPHA = 1.4142135623730951f;
constexpr float LN_EPS = 1e-5f, GN_EPS = 64e-5f;
constexpr int LDS_BYTES = 147456;

constexpr size_t MiB = (size_t)1 << 20;
constexpr size_t WS_ADAP = 1 * MiB, WS_ADA = 4 * MiB, WS_WLORA0 = 5 * MiB, WS_WLORA1 = 6 * MiB, WS_WINA0 = 8 * MiB, WS_WINA1 = 15 * MiB,
    WS_WG0 = 22 * MiB, WS_WG1 = 28 * MiB, WS_WBR0 = 34 * MiB, WS_WBR1 = 37 * MiB, WS_WOUT0 = 40 * MiB, WS_WOUT1 = 42 * MiB,
    WS_W1_0 = 44 * MiB, WS_W1_1 = 52 * MiB, WS_W2_0 = 60 * MiB, WS_W2_1 = 68 * MiB, WS_VFIRST = 76 * MiB, WS_H = 140 * MiB, WS_AR = 268 * MiB;
constexpr size_t AR_ZR = 0, AR_CG = 224 * MiB, AR_PL = 288 * MiB, AR_LV = 352 * MiB, AR_LO = 224 * MiB, AR_YCV = 480 * MiB, AR_POOL = 544 * MiB,
    AR_YRW = 608 * MiB, AR_LA = 672 * MiB, AR_P = 0, AR_HID = 0;
constexpr size_t WS_END = WS_AR + 720 * MiB;

struct Args { const float* in[36]; float* out; unsigned char* ws; };
typedef const Args __attribute__((address_space(4)))* ArgsP;
__device__ __forceinline__ ArgsP launder(ArgsP p) { asm volatile("" : "+s"(p)); return p; }

#define XB_TMO      128
#define XB_XCNT(j)  (256  + 64 * (j))
#define XB_XSUB(j)  (1280 + 64 * (j))
#define XB_XGEN(j)  (2304 + 64 * (j))
#define XB_TOP      3328
#define XB_TOPGEN   3392
#define XCD_BAR_WORDS 3456
#define XB_SPIN_CAP (1u << 18)

__device__ __forceinline__ unsigned xb_ld(unsigned* p)              { return __hip_atomic_load(p, __ATOMIC_RELAXED, __HIP_MEMORY_SCOPE_AGENT); }
__device__ __forceinline__ unsigned xb_add(unsigned* p, unsigned v) { return __hip_atomic_fetch_add(p, v, __ATOMIC_RELAXED, __HIP_MEMORY_SCOPE_AGENT); }
__device__ __forceinline__ unsigned xb_xcc_id() { return (unsigned)__builtin_amdgcn_s_getreg((3 << 11) | 20) & 0xFu; }
#define XB_SPIN(cond, bar) do { unsigned _sp = 0; while (cond) { __builtin_amdgcn_s_sleep(1); \
    if ((++_sp & 255u) == 0u) { if (xb_ld(&(bar)[XB_TMO])) break; if (_sp > XB_SPIN_CAP) { atomicAdd(&(bar)[XB_TMO], 1u); break; } } } } while (0)

struct XcdBarrier {
    unsigned* bar; unsigned x;
    volatile LAS unsigned* st;
};

__device__ __forceinline__ XcdBarrier xcd_barrier_post(unsigned* bar, volatile LAS unsigned* st) {
    XcdBarrier b; b.bar = bar; b.x = xb_xcc_id(); b.st = st;
    if (threadIdx.x == 0) (void)xb_add(&bar[XB_XCNT(b.x)], 1u);
    return b;
}
__device__ __forceinline__ void xcd_barrier_complete(unsigned* bar, unsigned x, unsigned& nloc, unsigned& nx) {
    const unsigned G = gridDim.x * gridDim.y * gridDim.z;
    unsigned sum, cnt, mine, sp = 0u;
    for (;;) {
        sum = 0u; cnt = 0u; mine = 0u;
#pragma unroll
        for (unsigned j = 0; j < 16; ++j) { const unsigned c = xb_ld(&bar[XB_XCNT(j)]); sum += c; cnt += (c > 0u) ? 1u : 0u; mine = (j == x) ? c : mine; }
        if (sum == G) break;
        __builtin_amdgcn_s_sleep(1);
        if ((++sp & 255u) == 0u) { if (xb_ld(&bar[XB_TMO])) break; if (sp > XB_SPIN_CAP) { atomicAdd(&bar[XB_TMO], 1u); break; } }
    }
    nloc = mine > 0u ? mine : 1u; nx = cnt > 0u ? cnt : 1u;
}

__device__ __forceinline__ void xcd_barrier(const XcdBarrier& b) {
    asm volatile("s_waitcnt vmcnt(0)" ::: "memory");
    __syncthreads();
    if (threadIdx.x == 0) {
        unsigned* bar = b.bar;
        __builtin_amdgcn_s_waitcnt(0);
        unsigned nloc = b.st[0], nx = b.st[1];
        if (nloc == 0u) { xcd_barrier_complete(bar, b.x, nloc, nx); b.st[0] = nloc; b.st[1] = nx; }
        const unsigned old = xb_add(&bar[XB_XSUB(b.x)], 1u);
        const unsigned gen = old / nloc;
        if (old + 1u == (gen + 1u) * nloc) {
            __builtin_amdgcn_fence(__ATOMIC_RELEASE, "agent");
            asm volatile("s_waitcnt vmcnt(0)" ::: "memory");
            const unsigned og = xb_add(&bar[XB_TOP], 1u);
            const unsigned tg = og / nx;
            if (og + 1u == (tg + 1u) * nx) xb_add(&bar[XB_TOPGEN], 1u);
            else XB_SPIN(xb_ld(&bar[XB_TOPGEN]) == tg, bar);
            __builtin_amdgcn_fence(__ATOMIC_ACQUIRE, "agent");
            xb_add(&bar[XB_XGEN(b.x)], 1u);
            asm volatile("s_waitcnt vmcnt(0)" ::: "memory");
        } else {
            XB_SPIN(xb_ld(&bar[XB_XGEN(b.x)]) == gen, bar);
            __builtin_amdgcn_fence(__ATOMIC_ACQUIRE, "agent");
            asm volatile("s_waitcnt vmcnt(0)" ::: "memory");
        }
    }
    __syncthreads();
}
#define LDS_WAIT() asm volatile("s_waitcnt lgkmcnt(0)" ::: "memory")
__device__ __forceinline__ unsigned f2bf(float f) { unsigned u = __builtin_bit_cast(unsigned, f); return (u + 0x7fffu + ((u >> 16) & 1u)) >> 16; }
__device__ __forceinline__ unsigned pk2(float lo, float hi) { return pg8::cvt_pk_bf16(lo, hi); }
__device__ __forceinline__ float bflo(unsigned u) { return __uint_as_float(u << 16); }
__device__ __forceinline__ float bfhi(unsigned u) { return __uint_as_float(u & 0xffff0000u); }
__device__ __forceinline__ float bf1(unsigned short u) { return __uint_as_float(((unsigned)u) << 16); }
__device__ __forceinline__ float sigm(float x) { return 1.f / (1.f + __expf(-x)); }
__device__ __forceinline__ void unpack8(const u32x4 v, float (&o)[8]) { o[0] = bflo(v.x); o[1] = bfhi(v.x); o[2] = bflo(v.y); o[3] = bfhi(v.y); o[4] = bflo(v.z); o[5] = bfhi(v.z); o[6] = bflo(v.w); o[7] = bfhi(v.w); }
__device__ __forceinline__ u32x4 pack8(const float (&o)[8]) { u32x4 r; r.x = pk2(o[0], o[1]); r.y = pk2(o[2], o[3]); r.z = pk2(o[4], o[5]); r.w = pk2(o[6], o[7]); return r; }
__device__ __forceinline__ void load8f(const float* p, float (&o)[8]) { const f32x4 a = *(const f32x4*)p, b = *(const f32x4*)(p + 4); o[0] = a.x; o[1] = a.y; o[2] = a.z; o[3] = a.w; o[4] = b.x; o[5] = b.y; o[6] = b.z; o[7] = b.w; }
__device__ __forceinline__ float wave_sum(float v) {
#pragma unroll
    for (int o = 1; o < 64; o <<= 1) v += __shfl_xor(v, o);
    return v;
}
template <int CTRL> __device__ __forceinline__ float dppf(float x) { return __builtin_bit_cast(float, __builtin_amdgcn_update_dpp(0, __builtin_bit_cast(int, x), CTRL, 0xF, 0xF, true)); }
__device__ __forceinline__ float red4(float x) { x += dppf<0xB1>(x); x += dppf<0x4E>(x); return x; }
__device__ __forceinline__ float red8(float x) { x = red4(x); x += dppf<0x141>(x); return x; }
__device__ __forceinline__ float red16(float x) { x = red8(x); x += dppf<0x140>(x); return x; }

__device__ __forceinline__ void store8(bf16* p, const f32x4 v0, const f32x4 v1) {
    u32x4 w; w.x = pk2(v0[0], v0[1]); w.y = pk2(v0[2], v0[3]); w.z = pk2(v1[0], v1[1]); w.w = pk2(v1[2], v1[3]); *(u32x4*)p = w;
}
struct EpiG1 {
    static constexpr bool PERM = true, AFTER_DRAIN = false;
    bf16 *ZR, *CG, *PL, *LV;
    __device__ __forceinline__ void operator()(const f32x4 (&acc)[2][2][4][2], const Unit& u, int wr, int wc, int fr, int fq) const {
        const int row0 = u.pm * 256 + wr * 64 + fr, pn = u.pn, cin = wc * 32 + 8 * fq;
        if (pn < 7 || (pn >= 11 && pn < 13)) {
            bf16* base = pn < 7 ? ZR : PL; const int ldc = pn < 7 ? 1792 : 512, col0 = (pn < 7 ? pn : pn - 11) * 256 + cin;
#pragma unroll
            for (int ai = 0; ai < 2; ++ai)
#pragma unroll
                for (int m = 0; m < 4; ++m) { bf16* rp = base + (size_t)(row0 + ai * 128 + m * 16) * ldc + col0;
#pragma unroll
                    for (int bj = 0; bj < 2; ++bj) store8(rp + bj * 128, acc[ai][bj][m][0], acc[ai][bj][m][1]); }
        } else if (pn < 11) {
            const int col0 = (pn - 7) * 128 + cin;
#pragma unroll
            for (int ai = 0; ai < 2; ++ai)
#pragma unroll
                for (int m = 0; m < 4; ++m) { f32x4 h0, h1;
#pragma unroll
                    for (int i = 0; i < 4; ++i) { h0[i] = acc[ai][0][m][0][i] * sigm(acc[ai][1][m][0][i]); h1[i] = acc[ai][0][m][1][i] * sigm(acc[ai][1][m][1][i]); }
                    store8(CG + (size_t)(row0 + ai * 128 + m * 16) * 512 + col0, h0, h1); }
        } else {
            if (wc == 0) {
#pragma unroll
                for (int ai = 0; ai < 2; ++ai)
#pragma unroll
                    for (int m = 0; m < 4; ++m) store8(LV + (size_t)(row0 + ai * 128 + m * 16) * 32 + 8 * fq, acc[ai][0][m][0], acc[ai][0][m][1]);
            }
        }
    }
};
struct EpiLora {
    static constexpr bool PERM = true, AFTER_DRAIN = false;
    bf16* O; int ldc; const float *w0, *a0, *v0;
    __device__ __forceinline__ void operator()(const f32x4 (&acc)[2][2][4][2], const Unit& u, int wr, int wc, int fr, int fq) const {
        const int row0 = u.pm * 256 + wr * 64 + fr, type = u.pn >> 1, cin = wc * 32 + 8 * fq;
#pragma unroll
        for (int bj = 0; bj < 2; ++bj) {
            const int cb = u.pn * 256 + bj * 128 + cin, pc = cb & 511;
            f32x4 p0 = (f32x4){0.f, 0.f, 0.f, 0.f}, p1 = p0;
            if (type == 0) { p0 = *(const f32x4*)(w0 + pc); p1 = *(const f32x4*)(w0 + pc + 4); }
            else if (type == 1) { p0 = *(const f32x4*)(a0 + pc); p1 = *(const f32x4*)(a0 + pc + 4); }
            else if (type == 3) { p0 = *(const f32x4*)(v0 + pc); p1 = *(const f32x4*)(v0 + pc + 4); }
#pragma unroll
            for (int ai = 0; ai < 2; ++ai)
#pragma unroll
                for (int m = 0; m < 4; ++m) { f32x4 v0_ = acc[ai][bj][m][0] + p0, v1_ = acc[ai][bj][m][1] + p1;
                    if (type != 2) {
                        const float sc = type == 0 ? 0.60653065971f : 1.f;
#pragma unroll
                        for (int i = 0; i < 4; ++i) { v0_[i] = sc * sigm(v0_[i]); v1_[i] = sc * sigm(v1_[i]); } }
                    store8(O + (size_t)(row0 + ai * 128 + m * 16) * ldc + cb, v0_, v1_); }
        }
    }
};
template <int MODE  > struct EpiBf {
    static constexpr bool PERM = true, AFTER_DRAIN = false;
    bf16* O; int ldc;
    __device__ __forceinline__ void operator()(const f32x4 (&acc)[2][2][4][2], const Unit& u, int wr, int wc, int fr, int fq) const {
        const int row0 = u.pm * 256 + wr * 64 + fr, col0 = u.pn * 256 + wc * 32 + 8 * fq;
#pragma unroll
        for (int ai = 0; ai < 2; ++ai)
#pragma unroll
            for (int m = 0; m < 4; ++m) { bf16* rp = O + (size_t)(row0 + ai * 128 + m * 16) * ldc + col0;
#pragma unroll
                for (int bj = 0; bj < 2; ++bj) { f32x4 v0 = acc[ai][bj][m][0], v1 = acc[ai][bj][m][1];
                    if (MODE == 1) {
#pragma unroll
                        for (int i = 0; i < 4; ++i) { const float a = fmaxf(v0[i], 0.f), b = fmaxf(v1[i], 0.f); v0[i] = a * a; v1[i] = b * b; } }
                    if (MODE == 2) { float p[8]; unpack8(*(const u32x4*)(rp + bj * 128), p);
#pragma unroll
                        for (int i = 0; i < 4; ++i) { v0[i] = sigm(v0[i]) * p[i]; v1[i] = sigm(v1[i]) * p[4 + i]; } }
                    store8(rp + bj * 128, v0, v1); } }
    }
};
struct EpiRes {
    static constexpr bool PERM = false, AFTER_DRAIN = false;
    const float* xin; float* out; const float* gt;
    __device__ __forceinline__ void operator()(const f32x4 (&acc)[2][2][4][2], const Unit& u, int wr, int wc, int fr, int fq) const {
        const float* gtb = gt + (size_t)(u.pm >> 5) * 6144; const int col0 = u.pn * 256 + wc * 32 + 4 * fq;
        f32x4 g4[2][2];
#pragma unroll
        for (int bj = 0; bj < 2; ++bj)
#pragma unroll
            for (int n = 0; n < 2; ++n) g4[bj][n] = *(const f32x4*)(gtb + col0 + bj * 128 + n * 16);
#pragma unroll
        for (int ai = 0; ai < 2; ++ai)
#pragma unroll
            for (int m = 0; m < 4; ++m) { const size_t off = (size_t)(u.pm * 256 + ai * 128 + wr * 64 + m * 16 + fr) * 1024 + col0;
#pragma unroll
                for (int bj = 0; bj < 2; ++bj)
#pragma unroll
                    for (int n = 0; n < 2; ++n) { const f32x4 x4 = *(const f32x4*)(xin + off + bj * 128 + n * 16);
                        *(f32x4*)(out + off + bj * 128 + n * 16) = x4 * ALPHA + g4[bj][n] * acc[ai][bj][m][n]; } }
    }
};

__device__ __forceinline__ void tr_item(const float* W, int N, int k0, int n0, bf16* dst, int K, LAS float* scr, int lane) {
#pragma unroll 8
    for (int i = 0; i < 32; ++i) { const int kk = 2 * i + (lane >> 5); scr[kk * 33 + (lane & 31)] = W[(size_t)(k0 + kk) * N + n0 + (lane & 31)]; }
    LDS_WAIT(); asm volatile("" ::: "memory");
    const int c = lane & 7;
#pragma unroll
    for (int j = 0; j < 4; ++j) { const int n = (lane >> 3) + 8 * j; const LAS float* s = scr + (8 * c) * 33 + n;
        u32x4 o; o.x = pk2(s[0 * 33], s[1 * 33]); o.y = pk2(s[2 * 33], s[3 * 33]); o.z = pk2(s[4 * 33], s[5 * 33]); o.w = pk2(s[6 * 33], s[7 * 33]);
        *(u32x4*)(dst + (size_t)n * K + 8 * c) = o; }
    LDS_WAIT(); asm volatile("" ::: "memory");
}
__device__ __forceinline__ bf16* win_dst(unsigned char* ws, int l, int n0) {
    bf16* wina = (bf16*)(ws + (l ? WS_WINA1 : WS_WINA0)); bf16* wg = (bf16*)(ws + (l ? WS_WG1 : WS_WG0));
    if (n0 < 1792) return wina + (size_t)n0 * 1024;
    if (n0 < 2816) { const int c = n0 - 1792, half = c >> 9, cc = c & 511, j = cc >> 7, i = cc & 127; return wina + (size_t)(1792 + j * 256 + half * 128 + i) * 1024; }
    if (n0 < 3328) return wina + (size_t)n0 * 1024;
    return wg + (size_t)(n0 - 3328) * 1024;
}
__device__ __forceinline__ void p0_phase(ArgsP a_, LAS unsigned char* lds) {
    const ArgsP a = launder(a_);
    const int tid = opq_tid(), lane = tid & 63, wave = tid >> 6, G = opq_gdim();
    const int gw = opq_bid() * 8 + wave, NGW = G * 8, gt = opq_bid() * 512 + tid, NT = G * 512;
    unsigned char* ws = a->ws;
    LAS float* scr = (LAS float*)(lds + wave * 8448);
    for (int it = gw; it < 16656; it += NGW) {
        int r = it;
        if (r >= 16640) { const int kb = r - 16640; tr_item(a->in[5], 32, 64 * kb, 0, (bf16*)(ws + WS_WINA1) + (size_t)3328 * 1024 + 64 * kb, 1024, scr, lane); continue; }
        const int l = r >= 8320 ? 1 : 0; r -= l * 8320;
        if (r < 3200) { const int kb = r / 200, nb = r % 200; tr_item(a->in[4] + (size_t)l * 1024 * 6400, 6400, 64 * kb, 32 * nb, win_dst(ws, l, 32 * nb) + 64 * kb, 1024, scr, lane); continue; } r -= 3200;
        bf16* wbr = (bf16*)(ws + (l ? WS_WBR1 : WS_WBR0));
        if (r < 256) { const int kb = r >> 5, nb = r & 31; tr_item(a->in[20] + (size_t)l * 512 * 1024, 1024, 64 * kb, 32 * nb, wbr + (size_t)(32 * nb) * 512 + 64 * kb, 512, scr, lane); continue; } r -= 256;
        if (r < 256) { const int kb = r >> 5, nb = r & 31; tr_item(a->in[25] + (size_t)l * 512 * 1024, 1024, 64 * kb, 32 * nb, wbr + (size_t)(1024 + 32 * nb) * 512 + 64 * kb, 512, scr, lane); continue; } r -= 256;
        if (r < 512) { const int kb = r >> 5, nb = r & 31; tr_item(a->in[29] + (size_t)l * 1024 * 1024, 1024, 64 * kb, 32 * nb, (bf16*)(ws + (l ? WS_WOUT1 : WS_WOUT0)) + (size_t)(32 * nb) * 1024 + 64 * kb, 1024, scr, lane); continue; } r -= 512;
        if (r < 2048) { const int kb = r >> 7, nb = r & 127; tr_item(a->in[32] + (size_t)l * 1024 * 4096, 4096, 64 * kb, 32 * nb, (bf16*)(ws + (l ? WS_W1_1 : WS_W1_0)) + (size_t)(32 * nb) * 1024 + 64 * kb, 1024, scr, lane); continue; } r -= 2048;
        { const int kb = r >> 5, nb = r & 31; tr_item(a->in[33] + (size_t)l * 4096 * 1024, 1024, 64 * kb, 32 * nb, (bf16*)(ws + (l ? WS_W2_1 : WS_W2_0)) + (size_t)(32 * nb) * 4096 + 64 * kb, 4096, scr, lane); }
    }
    { u32x4* z = (u32x4*)((bf16*)(ws + WS_WINA1) + (size_t)3360 * 1024); for (int i = gt; i < 28672; i += NT) z[i] = (u32x4){0u, 0u, 0u, 0u}; }
    { bf16* w = (bf16*)(ws + WS_WLORA0);
      for (int i = gt; i < 1536 * 256; i += NT) { const int n = i >> 8, k = i & 255; float v = 0.f;
          if (n < 512) { if (k < 64) v = a->in[9][k * 512 + n]; }
          else if (n < 1024) { if (k >= 64 && k < 128) v = a->in[11][(k - 64) * 512 + n - 512]; }
          else { if (k >= 128) v = a->in[12][(k - 128) * 512 + n - 1024]; }
          w[i] = (bf16)f2bf(v); } }
    { bf16* w = (bf16*)(ws + WS_WLORA1);
      for (int i = gt; i < 2048 * 384; i += NT) { const int n = i / 384, k = i % 384; float v = 0.f;
          if (n < 512) { if (k < 64) v = a->in[9][64 * 512 + k * 512 + n]; }
          else if (n < 1024) { if (k >= 64 && k < 128) v = a->in[11][64 * 512 + (k - 64) * 512 + n - 512]; }
          else if (n < 1536) { if (k >= 128 && k < 256) v = a->in[12][128 * 512 + (k - 128) * 512 + n - 1024]; }
          else { if (k >= 256 && k < 288) v = a->in[14][(k - 256) * 512 + n - 1536]; }
          w[i] = (bf16)f2bf(v); } }
    for (int idx = gt; idx < 131072; idx += NT) {
        const int n = idx & 1023, cg8 = (idx >> 10) & 63, l = idx >> 16, g = cg8 >> 4, c0 = (cg8 & 15) * 8;
        const float* plw = a->in[26] + ((size_t)(l * 4 + g) * 128 + c0) * 128; const float* pls = a->in[27] + l * 512 + g * 128; const float* plo = a->in[28] + ((size_t)l * 512 + g * 128) * 1024 + n;
        float acc[8];
#pragma unroll
        for (int i = 0; i < 8; ++i) acc[i] = 0.f;
        for (int d = 0; d < 128; ++d) { const float bw = plo[(size_t)d * 1024] * pls[d];
#pragma unroll
            for (int i = 0; i < 8; ++i) acc[i] += plw[i * 128 + d] * bw; }
        bf16* wbr = (bf16*)(ws + (l ? WS_WBR1 : WS_WBR0));
        *(u32x4*)(wbr + (size_t)(2048 + n) * 512 + g * 128 + c0) = pack8(acc);
    }
    float* adap = (float*)(ws + WS_ADAP);
    for (int wt = gw; wt < 1536; wt += NGW) {
        const int l = wt / 768, r = wt % 768, cb = r >> 3, kc = r & 7, col = cb * 64 + lane;
#pragma unroll
        for (int i = 0; i < 16; ++i) { const int idx = lane + 64 * i, b = idx >> 7, kk = idx & 127; const float x = a->in[1][b * 1024 + kc * 128 + kk]; scr[idx] = x * sigm(x); }
        LDS_WAIT(); asm volatile("" ::: "memory");
        float acc[8];
#pragma unroll
        for (int b = 0; b < 8; ++b) acc[b] = 0.f;
        const float* wp = a->in[2] + ((size_t)l * 1024 + kc * 128) * 6144 + col;
#pragma unroll 4
        for (int kk = 0; kk < 128; ++kk) { const float w = wp[(size_t)kk * 6144];
#pragma unroll
            for (int b = 0; b < 8; ++b) acc[b] += scr[b * 128 + kk] * w; }
#pragma unroll
        for (int b = 0; b < 8; ++b) adap[((size_t)(l * 8 + kc) * 8 + b) * 6144 + col] = acc[b];
        LDS_WAIT(); asm volatile("" ::: "memory");
    }
}
__device__ __forceinline__ void p0b_phase(ArgsP a_) {
    const ArgsP a = launder(a_);
    const int tid = opq_tid(), lane = tid & 63, wave = tid >> 6, G = opq_gdim();
    const int gw = opq_bid() * 8 + wave, NGW = G * 8, gt = opq_bid() * 512 + tid, NT = G * 512;
    const float* adap = (const float*)(a->ws + WS_ADAP); float* ada = (float*)(a->ws + WS_ADA);
    for (int i = gt; i < 2 * 49152; i += NT) { const int l = i / 49152, r = i % 49152, col = r % 6144; float s = a->in[3][l * 6144 + col];
#pragma unroll
        for (int kc = 0; kc < 8; ++kc) s += adap[(size_t)(l * 8 + kc) * 49152 + r];
        ada[i] = s; }
    bf16* H = (bf16*)(a->ws + WS_H);
    for (int rb = gw; rb < 2048; rb += NGW) {
        const int b = rb >> 8; f32x4 sh[4], sc[4];
#pragma unroll
        for (int j = 0; j < 4; ++j) { const int col = 4 * lane + 256 * j; f32x4 s0 = *(const f32x4*)(a->in[3] + col), s1 = *(const f32x4*)(a->in[3] + 1024 + col);
#pragma unroll
            for (int kc = 0; kc < 8; ++kc) { s0 += *(const f32x4*)(adap + (size_t)kc * 49152 + b * 6144 + col); s1 += *(const f32x4*)(adap + (size_t)kc * 49152 + b * 6144 + 1024 + col); }
            sh[j] = s0; sc[j] = s1 + 1.f; }
        for (int rr = 0; rr < 32; ++rr) { const size_t m = (size_t)rb * 32 + rr;
#pragma unroll
            for (int j = 0; j < 4; ++j) { const int col = 4 * lane + 256 * j; const f32x4 x = *(const f32x4*)(a->in[0] + m * 1024 + col); const f32x4 h = x * sc[j] + sh[j];
                u32x2 w; w.x = pk2(h[0], h[1]); w.y = pk2(h[2], h[3]); *(u32x2*)(H + m * 1024 + col) = w; } }
    }
}
__device__ __forceinline__ void ln_phase(float* X, bf16* H, const float* gam, const float* bet, const float* adash  , const float* adasc, bool writeH) {
    const int tid = opq_tid(), lane = tid & 63, wave = tid >> 6, gw = opq_bid() * 8 + wave, NGW = opq_gdim() * 8;
    for (int rb = gw; rb < 2048; rb += NGW) {
        const int b = rb >> 8; f32x4 g4[4], b4[4], sh[4], sc[4];
#pragma unroll
        for (int j = 0; j < 4; ++j) { const int col = 4 * lane + 256 * j; g4[j] = *(const f32x4*)(gam + col); b4[j] = *(const f32x4*)(bet + col);
            if (writeH) { sh[j] = *(const f32x4*)(adash + b * 6144 + col); sc[j] = *(const f32x4*)(adasc + b * 6144 + col) + 1.f; } else { sh[j] = g4[j]; sc[j] = g4[j]; } }
        for (int rr = 0; rr < 32; ++rr) { const size_t m = (size_t)rb * 32 + rr; f32x4 v[4]; float s = 0.f;
#pragma unroll
            for (int j = 0; j < 4; ++j) { v[j] = *(const f32x4*)(X + m * 1024 + 4 * lane + 256 * j); s += (v[j][0] + v[j][1]) + (v[j][2] + v[j][3]); }
            const float mean = wave_sum(s) * (1.f / 1024.f); float q = 0.f;
#pragma unroll
            for (int j = 0; j < 4; ++j) { v[j] = v[j] - mean; q += (v[j][0] * v[j][0] + v[j][1] * v[j][1]) + (v[j][2] * v[j][2] + v[j][3] * v[j][3]); }
            const float rstd = 1.0f / sqrtf(wave_sum(q) * (1.f / 1024.f) + LN_EPS);
#pragma unroll
            for (int j = 0; j < 4; ++j) { const int col = 4 * lane + 256 * j; const f32x4 y = v[j] * rstd * g4[j] + b4[j]; *(f32x4*)(X + m * 1024 + col) = y;
                if (writeH) { const f32x4 h = y * sc[j] + sh[j]; u32x2 w; w.x = pk2(h[0], h[1]); w.y = pk2(h[2], h[3]); *(u32x2*)(H + m * 1024 + col) = w; } } }
    }
}
__device__ __forceinline__ void prep_phase(ArgsP a_, int l, LAS unsigned char* lds) {
    const ArgsP a = launder(a_);
    const int tid = opq_tid(), lane = tid & 63, wave = tid >> 6, gw = opq_bid() * 8 + wave, NGW = opq_gdim() * 8;
    unsigned char* ar = a->ws + WS_AR;
    const bf16* ZR = (const bf16*)(ar + AR_ZR); const bf16* CG = (const bf16*)(ar + AR_CG); const bf16* PL = (const bf16*)(ar + AR_PL); const bf16* LV = (const bf16*)(ar + AR_LV);
    bf16* LA = (bf16*)(ar + AR_LA); bf16* YCV = (bf16*)(ar + AR_YCV); bf16* POOL = (bf16*)(ar + AR_POOL);
    LAS float* cw = (LAS float*)lds;
    for (int i = tid; i < 31 * 512; i += 512) cw[i] = a->in[21][l * 31 * 512 + i];
    __syncthreads();
    const int c8 = 8 * lane, ldA = l ? 384 : 256;
    float cvb[8], lng[8], lnb[8], mu[8];
    load8f(a->in[22] + l * 512 + c8, cvb); load8f(a->in[23] + l * 512 + c8, lng); load8f(a->in[24] + l * 512 + c8, lnb);
    if (lane < 32) load8f(a->in[6] + l * 1792 + 1536 + c8, mu);
    else if (l && lane < 36) load8f(a->in[7] + 8 * (lane - 32), mu);
    else {
#pragma unroll
        for (int i = 0; i < 8; ++i) mu[i] = 0.f; }
    for (int rb = gw; rb < 2048; rb += NGW)
        for (int gq = 0; gq < 8; ++gq) {
            const size_t m0 = (size_t)rb * 32 + gq * 4; const int s0 = (int)(m0 & 8191);
            if (lane < 32 || (l && lane < 36)) {
                const bf16* src = lane < 32 ? ZR + m0 * 1792 + 1536 + c8 : LV + m0 * 32 + 8 * (lane - 32); const int ldp = lane < 32 ? 1792 : 32;
                u32x4 zz[5];
#pragma unroll
                for (int i = 0; i < 5; ++i) zz[i] = (i == 0 && s0 == 0) ? (u32x4){0u, 0u, 0u, 0u} : *(const u32x4*)(src + (ptrdiff_t)(i - 1) * ldp);
#pragma unroll
                for (int i = 0; i < 4; ++i) { float zt[8], zp[8]; unpack8(zz[i + 1], zt); unpack8(zz[i], zp);
#pragma unroll
                    for (int q = 0; q < 8; ++q) { float z = zt[q] + (zp[q] - zt[q]) * mu[q];
                        if (lane < 8) z = 1.f - 2.f / (1.f + __expf(2.f * z)); else if (lane >= 16 && lane < 32) z = sigm(z);
                        zt[q] = z; }
                    *(u32x4*)(LA + (m0 + i) * ldA + (lane < 32 ? c8 : 256 + 8 * (lane - 32))) = pack8(zt); }
            } else if (l && lane < 48) {
#pragma unroll
                for (int i = 0; i < 4; ++i) *(u32x4*)(LA + (m0 + i) * ldA + c8) = (u32x4){0u, 0u, 0u, 0u}; }
            { float acc[4][8]; f32x4 wq[4][2];
#pragma unroll
              for (int i = 0; i < 4; ++i)
#pragma unroll
                  for (int q = 0; q < 8; ++q) acc[i][q] = cvb[q];
#pragma unroll
              for (int hh = 0; hh < 2; ++hh) {
                  u32x4 xr[17];
#pragma unroll
                  for (int r = 0; r < 17; ++r) { const int rr = hh * 17 + r; const size_t row = (s0 - 30 + rr >= 0) ? (m0 - 30 + rr) : m0; xr[r] = *(const u32x4*)(CG + row * 512 + c8); }
#pragma unroll
                  for (int r = 0; r < 17; ++r) { const int rr = hh * 17 + r;
                      if (rr <= 30) { wq[rr & 3][0] = *(const LAS f32x4*)(cw + rr * 512 + c8); wq[rr & 3][1] = *(const LAS f32x4*)(cw + rr * 512 + c8 + 4); }
                      if (s0 - 30 + rr >= 0) { float x[8]; unpack8(xr[r], x);
#pragma unroll
                          for (int i = 0; i < 4; ++i) { const int j = rr - i; if (j >= 0 && j <= 30) {
#pragma unroll
                              for (int q = 0; q < 4; ++q) { acc[i][q] += x[q] * wq[j & 3][0][q]; acc[i][4 + q] += x[4 + q] * wq[j & 3][1][q]; } } } } }
              }
#pragma unroll
              for (int i = 0; i < 4; ++i) { float s1 = 0.f;
#pragma unroll
                  for (int q = 0; q < 8; ++q) s1 += acc[i][q];
                  const float mean = wave_sum(s1) * (1.f / 512.f); float qq = 0.f;
#pragma unroll
                  for (int q = 0; q < 8; ++q) { acc[i][q] -= mean; qq += acc[i][q] * acc[i][q]; }
                  const float rstd = 1.0f / sqrtf(wave_sum(qq) * (1.f / 512.f) + LN_EPS);
#pragma unroll
                  for (int q = 0; q < 8; ++q) { const float y = acc[i][q] * rstd * lng[q] + lnb[q]; acc[i][q] = y * sigm(y); }
                  *(u32x4*)(YCV + (m0 + i) * 512 + c8) = pack8(acc[i]); } }
            { const int win = 2 << (lane >> 4); u32x4 pr[19]; float sum[4][8], x0[4][8];
#pragma unroll
              for (int r = 0; r < 19; ++r) { const size_t row = (s0 - 15 + r >= 0) ? (m0 - 15 + r) : m0; pr[r] = *(const u32x4*)(PL + row * 512 + c8); }
#pragma unroll
              for (int i = 0; i < 4; ++i)
#pragma unroll
                  for (int q = 0; q < 8; ++q) sum[i][q] = 0.f;
#pragma unroll
              for (int r = 0; r < 19; ++r) { float x[8]; unpack8(pr[r], x);
#pragma unroll
                  for (int i = 0; i < 4; ++i) { const int d = i + 15 - r;
                      if (d >= 0 && d <= 15) { const int cnt = (s0 + i + 1) < win ? (s0 + i + 1) : win; const float f = d < cnt ? 1.f : 0.f;
#pragma unroll
                          for (int q = 0; q < 8; ++q) sum[i][q] += x[q] * f;
                          if (d == 0) {
#pragma unroll
                              for (int q = 0; q < 8; ++q) x0[i][q] = x[q]; } } } }
#pragma unroll
              for (int i = 0; i < 4; ++i) { const int cnt = (s0 + i + 1) < win ? (s0 + i + 1) : win; const float inv = 1.f / (float)cnt;
#pragma unroll
                  for (int q = 0; q < 8; ++q) sum[i][q] = sum[i][q] * inv - x0[i][q];
                  *(u32x4*)(POOL + (m0 + i) * 512 + c8) = pack8(sum[i]); } }
        }
    __syncthreads();
}
struct HSet { u32x2 rt[2], kt[2], rp[2], kp[2], ee[2], aa[2]; unsigned short vt[2], vp[2], vm[2], vf[2]; };
constexpr int SC_VV = 0, SC_YP = 4096, SC_OPS = 20480;
__device__ __forceinline__ void sc_load(HSet& S, int c, int l, int b, int h, int rg, int hl, const bf16* ZR, const bf16* LO, int ldlo, const bf16* VF) {
    if (c >= 256) return;
    const int cg = hl & 15, vc = h * 64 + 16 * rg + cg;
#pragma unroll
    for (int p = 0; p < 2; ++p) {
        const int t = (hl >> 4) + 16 * p, s = c * 32 + t; const size_t m = (size_t)b * 8192 + s;
        const bf16* zr = ZR + m * 1792; const bf16* lo = LO + m * ldlo;
        S.rt[p] = *(const u32x2*)(zr + h * 64 + 4 * cg); S.kt[p] = *(const u32x2*)(zr + 512 + h * 64 + 4 * cg); S.vt[p] = zr[1024 + vc];
        if (s > 0) { S.rp[p] = *(const u32x2*)(zr - 1792 + h * 64 + 4 * cg); S.kp[p] = *(const u32x2*)(zr - 1792 + 512 + h * 64 + 4 * cg); S.vp[p] = zr[-1792 + 1024 + vc]; }
        else { S.rp[p] = (u32x2){0u, 0u}; S.kp[p] = (u32x2){0u, 0u}; S.vp[p] = 0; }
        S.ee[p] = *(const u32x2*)(lo + h * 64 + 4 * cg); S.aa[p] = *(const u32x2*)(lo + 512 + h * 64 + 4 * cg);
        if (l) { S.vm[p] = lo[1536 + vc]; S.vf[p] = VF[m * 512 + vc]; } else { S.vm[p] = 0; S.vf[p] = 0; }
    }
}
__device__ __forceinline__ void sc_prep(const HSet& S, int c, int buf, int l, int b, int h, int rg, int hl, LAS unsigned char* lds, bf16* VF,
                                        const f32x4 mur, const f32x4 muk, const f32x4 kkc, const f32x4 kac, const float muv) {
    if (c >= 256) return;
    const int cg = hl & 15, vc = h * 64 + 16 * rg + cg;
#pragma unroll
    for (int p = 0; p < 2; ++p) {
        const int t = (hl >> 4) + 16 * p; const size_t m = (size_t)b * 8192 + c * 32 + t;
        f32x4 rt = {bflo(S.rt[p].x), bfhi(S.rt[p].x), bflo(S.rt[p].y), bfhi(S.rt[p].y)}, rp = {bflo(S.rp[p].x), bfhi(S.rp[p].x), bflo(S.rp[p].y), bfhi(S.rp[p].y)};
        f32x4 kt = {bflo(S.kt[p].x), bfhi(S.kt[p].x), bflo(S.kt[p].y), bfhi(S.kt[p].y)}, kp = {bflo(S.kp[p].x), bfhi(S.kp[p].x), bflo(S.kp[p].y), bfhi(S.kp[p].y)};
        const f32x4 e = {bflo(S.ee[p].x), bfhi(S.ee[p].x), bflo(S.ee[p].y), bfhi(S.ee[p].y)}, av = {bflo(S.aa[p].x), bfhi(S.aa[p].x), bflo(S.aa[p].y), bfhi(S.aa[p].y)};
        const f32x4 r = rt + (rp - rt) * mur, k = kt + (kp - kt) * muk;
        f32x4 w; w[0] = __expf(-e[0]); w[1] = __expf(-e[1]); w[2] = __expf(-e[2]); w[3] = __expf(-e[3]);
        f32x4 kk = k * kkc; const float ss = red16((kk[0] * kk[0] + kk[1] * kk[1]) + (kk[2] * kk[2] + kk[3] * kk[3]));
        kk = kk * __builtin_amdgcn_rsqf(fmaxf(ss, 1e-24f));
        const f32x4 kh = k * ((av - 1.f) * kac + 1.f);
        LAS float* o = (LAS float*)(lds + SC_OPS) + (buf * 32 + t) * 320 + 4 * cg;
        *(LAS f32x4*)(o) = w; *(LAS f32x4*)(o + 64) = -kk; *(LAS f32x4*)(o + 128) = kk * av; *(LAS f32x4*)(o + 192) = kh; *(LAS f32x4*)(o + 256) = r;
        const float vt = bf1(S.vt[p]), vp = bf1(S.vp[p]); float v = vt + (vp - vt) * muv;
        if (l) v = v + (bf1(S.vf[p]) - v) * bf1(S.vm[p]); else VF[m * 512 + vc] = (bf16)pk2(v, v);
        ((LAS float*)(lds + SC_VV))[(buf * 32 + t) * 16 + cg] = v;
    }
}
__device__ __forceinline__ void sc_yred(int c, int buf, int b, int h, int rg, int hl, LAS unsigned char* lds, bf16* YRW) {
    const int i = hl & 15;
#pragma unroll
    for (int p = 0; p < 2; ++p) { const int t = (hl >> 4) + 16 * p; const size_t m = (size_t)b * 8192 + c * 32 + t;
        const f32x4 q = *(const LAS f32x4*)((LAS float*)(lds + SC_YP) + ((buf * 32 + t) * 16 + i) * 4);
        const float ys = (q[0] + q[1]) + (q[2] + q[3]); YRW[m * 512 + h * 64 + 16 * rg + i] = (bf16)pk2(ys, ys); }
}
typedef float f32x2 __attribute__((ext_vector_type(2)));
struct ScOp { f32x4 w, a, b, k, r; float v; };
__device__ __forceinline__ ScOp sc_ld(const LAS float* ops, const LAS float* vv, int t) {
    ScOp o; o.w = *(const LAS f32x4*)(ops + t * 320); o.a = *(const LAS f32x4*)(ops + t * 320 + 64); o.b = *(const LAS f32x4*)(ops + t * 320 + 128);
    o.k = *(const LAS f32x4*)(ops + t * 320 + 192); o.r = *(const LAS f32x4*)(ops + t * 320 + 256); o.v = vv[t * 16]; return o;
}
__device__ __forceinline__ void sc_step(f32x2& s0, f32x2& s1, const ScOp& o, LAS float* ypt) {
    f32x2 p = s0 * o.a.xy; p = s1 * o.a.zw + p;
    const f32x2 vv = {o.v, o.v};
    const f32x2 t0 = s0 * o.w.xy + o.k.xy * vv, t1 = s1 * o.w.zw + o.k.zw * vv;
    const float sa = red16(p.x + p.y);
    const f32x2 sav = {sa, sa};
    s0 = o.b.xy * sav + t0;
    s1 = o.b.zw * sav + t1;
    f32x2 q = s0 * o.r.xy; q = s1 * o.r.zw + q;
    *ypt = red4(q.x + q.y);
}
__device__ __forceinline__ void sc_scan(f32x2& s0, f32x2& s1, int buf, int row, int seg, int lane, LAS unsigned char* lds) {
    const LAS float* ops = (const LAS float*)(lds + SC_OPS) + buf * 32 * 320 + 4 * seg;
    const LAS float* vv = (const LAS float*)(lds + SC_VV) + buf * 32 * 16 + row;
    LAS float* yp = (LAS float*)(lds + SC_YP) + (buf * 32 * 16 + row) * 4 + (seg >> 2);
    ScOp o0 = sc_ld(ops, vv, 0), o1 = sc_ld(ops, vv, 1);
#pragma unroll
    for (int t = 0; t < 32; t += 2) {
        const ScOp o2 = sc_ld(ops, vv, t + 2); sc_step(s0, s1, o0, yp + t * 64);
        const ScOp o3 = sc_ld(ops, vv, t + 3); sc_step(s0, s1, o1, yp + (t + 1) * 64);
        o0 = o2; o1 = o3;
    }
}
__device__ __forceinline__ void scan_phase(ArgsP a_, int l, LAS unsigned char* lds) {
    const ArgsP a = launder(a_);
    const int tid = opq_tid(), lane = tid & 63, wave = __builtin_amdgcn_readfirstlane(tid >> 6);
    unsigned char* ar = a->ws + WS_AR;
    const bf16* ZR = (const bf16*)(ar + AR_ZR); const bf16* LO = (const bf16*)(ar + AR_LO); const int ldlo = l ? 2048 : 1536;
    bf16* VF = (bf16*)(a->ws + WS_VFIRST); bf16* YRW = (bf16*)(ar + AR_YRW);
    for (int u = opq_bid(); u < 256; u += opq_gdim()) {
        const int b = u >> 5, h = (u >> 2) & 7, rg = u & 3;
        if (wave < 4) {
            f32x2 s0 = {0.f, 0.f}, s1 = {0.f, 0.f}; const int row = 4 * wave + (lane >> 4), seg = lane & 15;
            __syncthreads();
            for (int c = 0; c < 256; c += 2) {
                if (DUPM & 64) { f32x2 a0 = s0, a1 = s1; sc_scan(a0, a1, 0, row, seg, lane, lds); asm volatile("" :: "v"(a0), "v"(a1) : "memory"); }
                sc_scan(s0, s1, 0, row, seg, lane, lds); __syncthreads();
                if (DUPM & 64) { f32x2 a0 = s0, a1 = s1; sc_scan(a0, a1, 1, row, seg, lane, lds); asm volatile("" :: "v"(a0), "v"(a1) : "memory"); }
                sc_scan(s0, s1, 1, row, seg, lane, lds); __syncthreads(); }
        } else {
            const int hl = tid - 256, cg = hl & 15, ch = h * 64 + 4 * cg, vc = h * 64 + 16 * rg + cg;
            const f32x4 mur = *(const f32x4*)(a->in[6] + l * 1792 + ch), muk = *(const f32x4*)(a->in[6] + l * 1792 + 512 + ch);
            const f32x4 kkc = *(const f32x4*)(a->in[15] + l * 512 + ch), kac = *(const f32x4*)(a->in[16] + l * 512 + ch);
            const float muv = a->in[6][l * 1792 + 1024 + vc];
            HSet SA, SB;
            sc_load(SA, 0, l, b, h, rg, hl, ZR, LO, ldlo, VF); sc_prep(SA, 0, 0, l, b, h, rg, hl, lds, VF, mur, muk, kkc, kac, muv);
            sc_load(SA, 1, l, b, h, rg, hl, ZR, LO, ldlo, VF); sc_load(SB, 2, l, b, h, rg, hl, ZR, LO, ldlo, VF);
            __syncthreads();
            for (int c = 0; c < 256; c += 2) {
                if (c > 0) sc_yred(c - 1, 1, b, h, rg, hl, lds, YRW);
                sc_prep(SA, c + 1, 1, l, b, h, rg, hl, lds, VF, mur, muk, kkc, kac, muv);
                if (DUPM & 32) { f32x4 m2 = mur; asm volatile("" : "+v"(m2) :: "memory"); sc_prep(SA, c + 1, 1, l, b, h, rg, hl, lds, VF, m2, muk, kkc, kac, muv); }
                sc_load(SA, c + 3, l, b, h, rg, hl, ZR, LO, ldlo, VF);
                __syncthreads();
                sc_yred(c, 0, b, h, rg, hl, lds, YRW);
                sc_prep(SB, c + 2, 0, l, b, h, rg, hl, lds, VF, mur, muk, kkc, kac, muv);
                if (DUPM & 32) { f32x4 m2 = mur; asm volatile("" : "+v"(m2) :: "memory"); sc_prep(SB, c + 2, 0, l, b, h, rg, hl, lds, VF, m2, muk, kkc, kac, muv); }
                sc_load(SB, c + 4, l, b, h, rg, hl, ZR, LO, ldlo, VF);
                __syncthreads();
            }
            sc_yred(255, 1, b, h, rg, hl, lds, YRW);
        }
        __syncthreads();
    }
}
__device__ __forceinline__ void post_phase(ArgsP a_, int l) {
    const ArgsP a = launder(a_);
    const int tid = opq_tid(), lane = tid & 63, wave = tid >> 6, gw = opq_bid() * 8 + wave, NGW = opq_gdim() * 8, c8 = 8 * lane;
    unsigned char* ar = a->ws + WS_AR;
    const bf16* ZR = (const bf16*)(ar + AR_ZR); const bf16* LO = (const bf16*)(ar + AR_LO); const int ldlo = l ? 2048 : 1536;
    const bf16* VF = (const bf16*)(a->ws + WS_VFIRST); bf16* YRW = (bf16*)(ar + AR_YRW);
    float mur[8], muk[8], muv[8], ka[8], rk[8], gng[8], gnb[8];
    load8f(a->in[6] + l * 1792 + c8, mur); load8f(a->in[6] + l * 1792 + 512 + c8, muk); load8f(a->in[6] + l * 1792 + 1024 + c8, muv);
    load8f(a->in[16] + l * 512 + c8, ka); load8f(a->in[17] + l * 512 + c8, rk); load8f(a->in[18] + l * 512 + c8, gng); load8f(a->in[19] + l * 512 + c8, gnb);
    for (int rb = gw; rb < 2048; rb += NGW)
        for (int rr = 0; rr < 32; ++rr) {
            const size_t m = (size_t)rb * 32 + rr; const int s = (int)(m & 8191);
            const bf16* zr = ZR + m * 1792 + c8; const bf16* lo = LO + m * ldlo + c8;
            float y[8], rt[8], kt[8], vt[8], rp[8], kp[8], vp[8], av[8], g[8];
            unpack8(*(const u32x4*)(YRW + m * 512 + c8), y);
            unpack8(*(const u32x4*)zr, rt); unpack8(*(const u32x4*)(zr + 512), kt); unpack8(*(const u32x4*)(zr + 1024), vt);
            if (s > 0) { unpack8(*(const u32x4*)(zr - 1792), rp); unpack8(*(const u32x4*)(zr - 1792 + 512), kp); unpack8(*(const u32x4*)(zr - 1792 + 1024), vp); }
            else {
#pragma unroll
                for (int i = 0; i < 8; ++i) { rp[i] = 0.f; kp[i] = 0.f; vp[i] = 0.f; } }
            unpack8(*(const u32x4*)(lo + 512), av); unpack8(*(const u32x4*)(lo + 1024), g);
            float bon = 0.f, sy = 0.f;
#pragma unroll
            for (int i = 0; i < 8; ++i) { const float r = rt[i] + (rp[i] - rt[i]) * mur[i], k = kt[i] + (kp[i] - kt[i]) * muk[i]; vt[i] = vt[i] + (vp[i] - vt[i]) * muv[i];
                bon += r * (k * (1.f + (av[i] - 1.f) * ka[i])) * rk[i]; sy += y[i]; }
            if (l) { float vm[8], vf[8]; unpack8(*(const u32x4*)(lo + 1536), vm); unpack8(*(const u32x4*)(VF + m * 512 + c8), vf);
#pragma unroll
                for (int i = 0; i < 8; ++i) vt[i] = vt[i] + (vf[i] - vt[i]) * vm[i]; }
            bon = red8(bon); const float mean = red8(sy) * (1.f / 64.f); float q = 0.f;
#pragma unroll
            for (int i = 0; i < 8; ++i) { y[i] -= mean; q += y[i] * y[i]; }
            const float rstd = 1.0f / sqrtf(red8(q) * (1.f / 64.f) + GN_EPS);
#pragma unroll
            for (int i = 0; i < 8; ++i) y[i] = (y[i] * rstd * gng[i] + gnb[i] + bon * vt[i]) * g[i];
            *(u32x4*)(YRW + m * 512 + c8) = pack8(y);
        }
}
__device__ __forceinline__ void combine_phase(ArgsP a_) {
    const ArgsP a = launder(a_);
    const int gt = opq_bid() * 512 + opq_tid(), NT = opq_gdim() * 512;
    const bf16* P = (const bf16*)(a->ws + WS_AR + AR_P); bf16* Hm = (bf16*)(a->ws + WS_H);
    for (int i = gt; i < M * 128; i += NT) { const size_t m = (size_t)(i >> 7); const int c8 = (i & 127) * 8; float p0[8], p1[8], p2[8];
        unpack8(*(const u32x4*)(P + m * 3072 + c8), p0); unpack8(*(const u32x4*)(P + m * 3072 + 1024 + c8), p1); unpack8(*(const u32x4*)(P + m * 3072 + 2048 + c8), p2);
#pragma unroll
        for (int q = 0; q < 8; ++q) p0[q] = (p0[q] + p1[q]) + p2[q];
        *(u32x4*)(Hm + m * 1024 + c8) = pack8(p0); }
}

#ifndef DUPM
#define DUPM 0
#endif
#ifndef PHM
#define PHM 0x7fff
#endif
#define GSYNC() do { XcdBarrier b_; b_.bar = (unsigned*)(launder(ak)->ws) + 1024; b_.x = xb_xcc_id(); b_.st = (volatile LAS unsigned*)(lds + LDS_BYTES - 64); xcd_barrier(b_); } while (0)
__global__ void __launch_bounds__(512, 2) fwd_kernel(Args kargs) {
    extern __shared__ __attribute__((aligned(16))) unsigned char lds_raw[];
    LAS unsigned char* lds = (LAS unsigned char*)lds_raw;
    cg::grid_group grid = cg::this_grid();
    { volatile LAS unsigned* st0 = (volatile LAS unsigned*)(lds + LDS_BYTES - 64); if (threadIdx.x == 0) { st0[0] = 0u; st0[1] = 0u; } __syncthreads(); }
    (void)xcd_barrier_post((unsigned*)(launder((ArgsP)__builtin_amdgcn_kernarg_segment_ptr())->ws) + 1024, (volatile LAS unsigned*)(lds + LDS_BYTES - 64));
    const ArgsP ak = (ArgsP)__builtin_amdgcn_kernarg_segment_ptr();

    if (PHM & 1) p0_phase(ak, lds); grid.sync();
    if (PHM & 2) p0b_phase(ak); GSYNC();
#pragma unroll 1
    for (int l = 0; l < 2; ++l) {
        if (PHM & 4) { const ArgsP a = launder(ak); const int G = opq_gdim(), bx = opq_bid(); unsigned char* ws = a->ws; unsigned char* ar = ws + WS_AR; bf16* H = (bf16*)(ws + WS_H); const float* adal = (const float*)(ws + WS_ADA) + l * 49152; (void)ar; (void)H; (void)adal;
          pg8::Gemm g{H, nullptr, nullptr, 0, (const bf16*)(ws + (l ? WS_WINA1 : WS_WINA0)), M, l ? 3584 : 3328, 1024};
          pg8::StaticOrder S; S.init(M, g.N, G, bx);
          EpiG1 E{(bf16*)(ar + AR_ZR), (bf16*)(ar + AR_CG), (bf16*)(ar + AR_PL), (bf16*)(ar + AR_LV)};
          pg8::gemm_phase<EpiG1, pg8::StaticOrder, true, true>(lds, g, S, E); }
        GSYNC();
        if (PHM & 8) prep_phase(ak, l, lds); GSYNC();
        if (DUPM & 1) { prep_phase(ak, l, lds); GSYNC(); }
        if (PHM & 16) { const ArgsP a = launder(ak); const int G = opq_gdim(), bx = opq_bid(); unsigned char* ws = a->ws; unsigned char* ar = ws + WS_AR; bf16* H = (bf16*)(ws + WS_H); const float* adal = (const float*)(ws + WS_ADA) + l * 49152; (void)ar; (void)H; (void)adal;
          pg8::Gemm g{(const bf16*)(ar + AR_LA), nullptr, nullptr, 0, (const bf16*)(ws + (l ? WS_WLORA1 : WS_WLORA0)), M, l ? 2048 : 1536, l ? 384 : 256};
          pg8::StaticOrder S; S.init(M, g.N, G, bx);
          EpiLora E{(bf16*)(ar + AR_LO), l ? 2048 : 1536, a->in[8] + l * 512, a->in[10] + l * 512, a->in[13]};
          pg8::gemm_phase<EpiLora, pg8::StaticOrder, true, true>(lds, g, S, E); }
        GSYNC();
        if (PHM & 32) scan_phase(ak, l, lds); GSYNC();
        if (DUPM & 16) { scan_phase(ak, l, lds); GSYNC(); }
        if (PHM & 64) post_phase(ak, l); GSYNC();
        if (DUPM & 2) { scan_phase(ak, l, lds); GSYNC(); post_phase(ak, l); GSYNC(); }
        if (DUPM & 4) { for (int q = 0; q < 16; ++q) GSYNC(); }
        if (PHM & 128) { const ArgsP a = launder(ak); const int G = opq_gdim(), bx = opq_bid(); unsigned char* ws = a->ws; unsigned char* ar = ws + WS_AR; bf16* H = (bf16*)(ws + WS_H); const float* adal = (const float*)(ws + WS_ADA) + l * 49152; (void)ar; (void)H; (void)adal;
          pg8::Gemm g{(const bf16*)(ar + AR_YRW), (const bf16*)(ar + AR_YCV), (const bf16*)(ar + AR_POOL), 4, (const bf16*)(ws + (l ? WS_WBR1 : WS_WBR0)), M, 3072, 512};
          pg8::StaticOrder S; S.init(M, g.N, G, bx);
          EpiBf<0> E{(bf16*)(ar + AR_P), 3072};
          pg8::gemm_phase<EpiBf<0>, pg8::StaticOrder, true, true>(lds, g, S, E); }
        GSYNC();
        if (PHM & 256) { const ArgsP a = launder(ak); const int G = opq_gdim(), bx = opq_bid(); unsigned char* ws = a->ws; unsigned char* ar = ws + WS_AR; bf16* H = (bf16*)(ws + WS_H); const float* adal = (const float*)(ws + WS_ADA) + l * 49152; (void)ar; (void)H; (void)adal;
          pg8::Gemm g{H, nullptr, nullptr, 0, (const bf16*)(ws + (l ? WS_WG1 : WS_WG0)), M, 3072, 1024};
          pg8::StaticOrder S; S.init(M, g.N, G, bx);
          EpiBf<2> E{(bf16*)(ar + AR_P), 3072};
          pg8::gemm_phase<EpiBf<2>, pg8::StaticOrder, true, true>(lds, g, S, E); }
        GSYNC();
        if (PHM & 512) combine_phase(ak); GSYNC();
        if (PHM & 1024) { const ArgsP a = launder(ak); const int G = opq_gdim(), bx = opq_bid(); unsigned char* ws = a->ws; unsigned char* ar = ws + WS_AR; bf16* H = (bf16*)(ws + WS_H); const float* adal = (const float*)(ws + WS_ADA) + l * 49152; (void)ar; (void)H; (void)adal;
          pg8::Gemm g{H, nullptr, nullptr, 0, (const bf16*)(ws + (l ? WS_WOUT1 : WS_WOUT0)), M, 1024, 1024};
          pg8::StaticOrder S; S.init(M, g.N, G, bx);
          EpiRes E{l ? (const float*)a->out : a->in[0], a->out, adal + 2 * 1024};
          pg8::gemm_phase<EpiRes, pg8::StaticOrder, true, true>(lds, g, S, E); }
        GSYNC();
        if (PHM & 2048) { const ArgsP a = launder(ak); const float* adal = (const float*)(a->ws + WS_ADA) + l * 49152;
          ln_phase(a->out, (bf16*)(a->ws + WS_H), a->in[30] + l * 1024, a->in[31] + l * 1024, adal + 3 * 1024, adal + 4 * 1024, true); }
        GSYNC();
        if (PHM & 4096) { const ArgsP a = launder(ak); const int G = opq_gdim(), bx = opq_bid(); unsigned char* ws = a->ws; unsigned char* ar = ws + WS_AR; bf16* H = (bf16*)(ws + WS_H); const float* adal = (const float*)(ws + WS_ADA) + l * 49152; (void)ar; (void)H; (void)adal;
          pg8::Gemm g{H, nullptr, nullptr, 0, (const bf16*)(ws + (l ? WS_W1_1 : WS_W1_0)), M, 4096, 1024};
          pg8::StaticOrder S; S.init(M, g.N, G, bx);
          EpiBf<1> E{(bf16*)(ar + AR_HID), 4096};
          pg8::gemm_phase<EpiBf<1>, pg8::StaticOrder, true, true>(lds, g, S, E); }
        GSYNC();
        if (PHM & 8192) { const ArgsP a = launder(ak); const int G = opq_gdim(), bx = opq_bid(); unsigned char* ws = a->ws; unsigned char* ar = ws + WS_AR; bf16* H = (bf16*)(ws + WS_H); const float* adal = (const float*)(ws + WS_ADA) + l * 49152; (void)ar; (void)H; (void)adal;
          pg8::Gemm g{(const bf16*)(ar + AR_HID), nullptr, nullptr, 0, (const bf16*)(ws + (l ? WS_W2_1 : WS_W2_0)), M, 1024, 4096};
          pg8::StaticOrder S; S.init(M, g.N, G, bx);
          EpiRes E{a->out, a->out, adal + 5 * 1024};
          pg8::gemm_phase<EpiRes, pg8::StaticOrder, true, true>(lds, g, S, E); }
        GSYNC();
        if (PHM & 16384) { const ArgsP a = launder(ak); const float* ada1 = (const float*)(a->ws + WS_ADA) + 49152;
          ln_phase(a->out, (bf16*)(a->ws + WS_H), a->in[34] + l * 1024, a->in[35] + l * 1024, ada1, ada1 + 1024, l == 0); }
        if (l == 0) GSYNC();
    }
}

extern "C" void kernel_launch(void* const* d_in, const int* in_sizes, int n_in, void* d_out, int out_size, void* d_ws, size_t ws_size, hipStream_t stream) {
    static int grid = 0;
    if (grid == 0) {
        if (n_in != 36 || out_size != M * D || ws_size < WS_END) { fprintf(stderr, "kernel_launch: unexpected shapes (n_in %d, out %d, ws %zu)\n", n_in, out_size, ws_size); grid = -1; return; }
        int dev = 0, cus = 0, per_cu = 0;
        hipGetDevice(&dev); hipDeviceGetAttribute(&cus, hipDeviceAttributeMultiprocessorCount, dev);
        hipFuncSetAttribute((const void*)fwd_kernel, hipFuncAttributeMaxDynamicSharedMemorySize, LDS_BYTES);
        hipOccupancyMaxActiveBlocksPerMultiprocessor(&per_cu, (const void*)fwd_kernel, 512, LDS_BYTES);
        (void)hipGetLastError();
        if (per_cu < 1) per_cu = 1;
        grid = cus;
        if (grid > 256) grid = 256;
    }
    if (grid < 0) return;
    if (hipMemsetAsync(d_ws, 0, 65536, stream) != hipSuccess) { fprintf(stderr, "kernel_launch: memset failed\n"); return; }
    Args ha{};
    for (int i = 0; i < 36; ++i) ha.in[i] = (const float*)d_in[i];
    ha.out = (float*)d_out; ha.ws = (unsigned char*)d_ws;
    void* params[] = {&ha};
    hipError_t e = hipLaunchCooperativeKernel((const void*)fwd_kernel, dim3(grid), dim3(512), params, LDS_BYTES, stream);
    if (e != hipSuccess) fprintf(stderr, "cooperative launch failed: %s (grid %d)\n", hipGetErrorString(e), grid);
}
```

```cpp
#include <hip/hip_runtime.h>
#include <hip/hip_cooperative_groups.h>
#include <cstdio>
#include <cstdint>
namespace cg = cooperative_groups;
__device__ __forceinline__ int opq_tid() { int t = threadIdx.x; asm volatile("" : "+v"(t)); return t; }
__device__ __forceinline__ int opq_bid() { int t = blockIdx.x; asm volatile("" : "+s"(t)); return t; }
__device__ __forceinline__ int opq_gdim() { int t = gridDim.x; asm volatile("" : "+s"(t)); return t; }
#ifndef DUPM
#define DUPM 0
#endif
#ifndef PHM
#define PHM 0x7fff
#endif
#ifndef TPROBE
#define TPROBE 0
#endif
#ifndef TMASK
#define TMASK 0
#endif
namespace pg8 {
#define PG8_LAS __attribute__((address_space(3)))
typedef unsigned short bf16_t;
typedef short bf16x8 __attribute__((ext_vector_type(8)));
typedef float f32x4 __attribute__((ext_vector_type(4)));
typedef unsigned u32x4 __attribute__((ext_vector_type(4)));
constexpr int BM = 256, BK = 64, HALF = 128, HTB = HALF * BK * 2  , STAGE_BYTES = 8 * HTB, NXCD = 8, WGM = 8;

__host__ __device__ __forceinline__ int lds_byte(int r, int c) { const int st = (r >> 4) * 2 + (c >> 5), rr = r & 15, cc = c & 31, ob = rr * 64 + cc * 2; return st * 1024 + (ob ^ (((ob >> 9) & 1) << 5)); }
__host__ __device__ __forceinline__ void stage_rc(int b, int& R, int& C) { const int st = b / 1024, sb = b % 1024, swz = sb ^ (((sb >> 9) & 1) << 5); R = (st >> 1) * 16 + swz / 64; C = (st & 1) * 32 + (swz % 64) / 2; }
__host__ __device__ __forceinline__ int perm32(int rho) { const int n = rho >> 4, i = rho & 15; return 8 * (i >> 2) + 4 * n + (i & 3); }

struct Unit { int pm, pn; };
struct Gemm { const bf16_t* A; const bf16_t* A1; const bf16_t* A2; int segt; const bf16_t* Bt; int M, N, K; int lda;
    __device__ __forceinline__ const bf16_t* a_of(int pn) const { return segt == 0 ? A : (pn < segt ? A : (pn < 2 * segt ? A1 : A2)); } };

struct StaticOrder {
    int nM, nN, nwg, G, c;
    __host__ __device__ void init(int M, int N, int G_, int c_) { nM = M / BM; nN = N / BM; nwg = nM * nN; G = G_; c = c_; }
    __host__ __device__ bool next(int i, Unit& u) const {
        const long L = (long)i * G + c; if (L >= nwg) return false;
        int wgid = (int)L; { const int q = nwg / NXCD, r = nwg % NXCD, xcd = wgid % NXCD, off = wgid / NXCD; wgid = (xcd < r ? xcd * (q + 1) : r * (q + 1) + (xcd - r) * q) + off; }
        const int nig = WGM * nN, gid = wgid / nig, fm = gid * WGM, gsz = (nM - fm) < WGM ? (nM - fm) : WGM;
        u.pm = fm + ((wgid % nig) % gsz); u.pn = (wgid % nig) / gsz; return true;
    }
    __device__ __forceinline__ void a_ready(const Unit&) const {}
    __device__ __forceinline__ void done(const Unit&) const {}
};
__device__ __forceinline__ unsigned cvt_pk_bf16(float lo, float hi) { unsigned r; asm volatile("v_cvt_pk_bf16_f32 %0, %1, %2" : "=v"(r) : "v"(lo), "v"(hi)); return r; }
template <class Epi, class Sched, bool ALIGN_EPI = false, bool SP2 = false>
__device__ __forceinline__ void gemm_phase(PG8_LAS unsigned char* lds, const Gemm g, const Sched& S, const Epi& E) {
    const int tid = opq_tid(), wid = __builtin_amdgcn_readfirstlane(tid >> 6), lane = tid & 63, wr = wid >> 2, wc = wid & 3, fr = lane & 15, fq = lane >> 4;
    const int K = g.K, nt = K / BK, LDA = g.lda ? g.lda : g.K;
    unsigned voffA[2], voffB[2];
#pragma unroll
    for (int i = 0; i < 2; ++i) { int R, C; stage_rc(tid * 16 + i * 8192, R, C); const int Rb = Epi::PERM ? ((R & ~31) + perm32(R & 31)) : R;
        voffA[i] = (unsigned)(R * LDA + C) * 2u; voffB[i] = (unsigned)(Rb * K + C) * 2u; }
    const size_t kstep = (size_t)(BK * 2);
    const size_t hstep = (size_t)HALF * K * 2;
    const size_t tstep = 2 * hstep;
    const size_t hstepA = (size_t)HALF * LDA * 2, tstepA = 2 * hstepA;
    const unsigned ldsw = (unsigned)wid * 1024u;
    const int aoff = lds_byte(wr * 64 + fr, fq * 8), boff = lds_byte(wc * 32 + fr, fq * 8);
#define PG8_SA(b, h) (((b) * 2 + (h)) * HTB)
#define PG8_SB(b, h) ((4 + (b) * 2 + (h)) * HTB)
#define PG8_STAGE(bufoff, gbase, voff) do { _Pragma("unroll") for (int _i = 0; _i < 2; ++_i) \
        __builtin_amdgcn_global_load_lds((const unsigned*)((const char*)(gbase) + (voff)[_i]), (PG8_LAS unsigned*)(lds + (bufoff) + ldsw + _i * 8192), 16, 0, 0); } while (0)
#define PG8_LDA(dst, b, h) do { _Pragma("unroll") for (int m = 0; m < 4; ++m) _Pragma("unroll") for (int k = 0; k < 2; ++k) dst[m][k] = *(const PG8_LAS bf16x8*)(lds + PG8_SA(b, h) + aoff + m * 2048 + k * 1024); } while (0)
#define PG8_LDB(dst, b, h) do { _Pragma("unroll") for (int n = 0; n < 2; ++n) _Pragma("unroll") for (int k = 0; k < 2; ++k) dst[n][k] = *(const PG8_LAS bf16x8*)(lds + PG8_SB(b, h) + boff + n * 2048 + k * 1024); } while (0)
#define PG8_MMA(ai, bj, At, Bt) do { __builtin_amdgcn_s_setprio(1); _Pragma("unroll") for (int m = 0; m < 4; ++m) _Pragma("unroll") for (int n = 0; n < 2; ++n) _Pragma("unroll") for (int k = 0; k < 2; ++k) \
        acc[ai][bj][m][n] = __builtin_amdgcn_mfma_f32_16x16x32_bf16(Bt[n][k], At[m][k], acc[ai][bj][m][n], 0, 0, 0); __builtin_amdgcn_s_setprio(0); } while (0)
#define PG8_WAIT_V(n) asm volatile("s_waitcnt vmcnt(" #n ")" ::: "memory")
#define PG8_WAIT_L(n) asm volatile("s_waitcnt lgkmcnt(" #n ")" ::: "memory")
#define PG8_BAR __builtin_amdgcn_s_barrier()
#define PG8_SCHED __builtin_amdgcn_sched_barrier(0)
    Unit cur, nxt; int ui = 0;
    if (!S.next(0, cur)) return;
    f32x4 acc[2][2][4][2];
#pragma unroll
    for (int a = 0; a < 2; ++a)
#pragma unroll
        for (int b = 0; b < 2; ++b)
#pragma unroll
            for (int m = 0; m < 4; ++m)
#pragma unroll
                for (int n = 0; n < 2; ++n) acc[a][b][m][n] = (f32x4){0.f, 0.f, 0.f, 0.f};
    bf16x8 At[4][2], B0[2][2], B1[2][2];
    const char* cA = (const char*)g.a_of(cur.pn) + (size_t)cur.pm * tstepA; const char* cB = (const char*)g.Bt + (size_t)cur.pn * tstep;
    S.a_ready(cur);
    if constexpr (SP2) {
        PG8_STAGE(PG8_SB(0, 0), cB, voffB); PG8_STAGE(PG8_SB(0, 1), cB + hstep, voffB); PG8_STAGE(PG8_SA(0, 0), cA, voffA); PG8_STAGE(PG8_SA(0, 1), cA + hstepA, voffA);
        if (wr == 1) PG8_BAR;
        PG8_WAIT_V(2); PG8_BAR;
        PG8_STAGE(PG8_SB(1, 0), cB + kstep, voffB); PG8_STAGE(PG8_SA(1, 0), cA + kstep, voffA); PG8_STAGE(PG8_SB(1, 1), cB + hstep + kstep, voffB);
        PG8_WAIT_V(6); PG8_BAR;
    } else {
        PG8_STAGE(PG8_SB(0, 0), cB, voffB); PG8_STAGE(PG8_SA(0, 0), cA, voffA); PG8_STAGE(PG8_SB(0, 1), cB + hstep, voffB); PG8_STAGE(PG8_SA(0, 1), cA + hstepA, voffA);
        if (wr == 1) PG8_BAR;
        PG8_WAIT_V(4); PG8_BAR;
        PG8_STAGE(PG8_SB(1, 0), cB + kstep, voffB); PG8_STAGE(PG8_SA(1, 0), cA + kstep, voffA); PG8_STAGE(PG8_SB(1, 1), cB + hstep + kstep, voffB);
        PG8_WAIT_V(6); PG8_BAR;
    }
    for (;;) {
        const bool has_next = S.next(ui + 1, nxt);
        const char* nA = has_next ? (const char*)g.a_of(nxt.pn) + (size_t)nxt.pm * tstepA : cA; const char* nB = has_next ? (const char*)g.Bt + (size_t)nxt.pn * tstep : cB;
        for (int t = 0; t < nt; t += 2) {
            const bool last = (t == nt - 2);
            const char* a1 = cA + (size_t)(t + 1) * kstep;
            const char* a2 = last ? nA : cA + (size_t)(t + 2) * kstep; const char* b2 = last ? nB : cB + (size_t)(t + 2) * kstep;
            const char* a3 = a2 + kstep; const char* b3 = b2 + kstep;
            if (last && has_next) S.a_ready(nxt);
            if constexpr (SP2) {
            PG8_LDB(B0, 0, 0); PG8_LDB(B1, 0, 1); PG8_SCHED; PG8_LDA(At, 0, 0); PG8_STAGE(PG8_SA(1, 1), a1 + hstepA, voffA);
            PG8_WAIT_V(8); PG8_WAIT_L(0); PG8_BAR; PG8_MMA(0, 0, At, B0); PG8_MMA(0, 1, At, B1); PG8_BAR; PG8_SCHED;
            PG8_LDA(At, 0, 1); PG8_STAGE(PG8_SB(0, 0), b2, voffB); PG8_STAGE(PG8_SB(0, 1), b2 + hstep, voffB); PG8_STAGE(PG8_SA(0, 0), a2, voffA);
            PG8_WAIT_V(8); PG8_WAIT_L(0); PG8_BAR; PG8_MMA(1, 0, At, B0); PG8_MMA(1, 1, At, B1); PG8_BAR; PG8_SCHED;
            PG8_LDB(B0, 1, 0); PG8_LDB(B1, 1, 1); PG8_SCHED; PG8_LDA(At, 1, 0); PG8_STAGE(PG8_SA(0, 1), a2 + hstepA, voffA);
            PG8_WAIT_V(8); PG8_WAIT_L(0); PG8_BAR; PG8_MMA(0, 0, At, B0); PG8_MMA(0, 1, At, B1); PG8_BAR; PG8_SCHED;
            PG8_LDA(At, 1, 1); PG8_STAGE(PG8_SB(1, 0), b3, voffB); PG8_STAGE(PG8_SB(1, 1), b3 + hstep, voffB); PG8_STAGE(PG8_SA(1, 0), a3, voffA);
            PG8_WAIT_V(8); PG8_WAIT_L(0); PG8_BAR; PG8_MMA(1, 0, At, B0); PG8_MMA(1, 1, At, B1); PG8_BAR; PG8_SCHED;
            } else {
            PG8_LDB(B0, 0, 0); PG8_SCHED; PG8_LDA(At, 0, 0); PG8_STAGE(PG8_SA(1, 1), a1 + hstepA, voffA);
            PG8_WAIT_L(8); PG8_BAR; PG8_WAIT_L(0); PG8_MMA(0, 0, At, B0); PG8_BAR; PG8_SCHED;
            PG8_LDB(B1, 0, 1); PG8_STAGE(PG8_SB(0, 0), b2, voffB);
            PG8_BAR; PG8_WAIT_L(0); PG8_MMA(0, 1, At, B1); PG8_BAR;
            PG8_LDA(At, 0, 1); PG8_STAGE(PG8_SA(0, 0), a2, voffA);
            PG8_BAR; PG8_WAIT_L(0); PG8_MMA(1, 0, At, B0); PG8_BAR; PG8_SCHED;
            PG8_STAGE(PG8_SB(0, 1), b2 + hstep, voffB);
            PG8_WAIT_V(6); PG8_BAR; PG8_MMA(1, 1, At, B1); PG8_BAR;
            PG8_LDB(B0, 1, 0); PG8_SCHED; PG8_LDA(At, 1, 0); PG8_STAGE(PG8_SA(0, 1), a2 + hstepA, voffA);
            PG8_WAIT_L(8); PG8_BAR; PG8_WAIT_L(0); PG8_MMA(0, 0, At, B0); PG8_BAR; PG8_SCHED;
            PG8_LDB(B1, 1, 1); PG8_STAGE(PG8_SB(1, 0), b3, voffB);
            PG8_BAR; PG8_WAIT_L(0); PG8_MMA(0, 1, At, B1); PG8_BAR;
            PG8_LDA(At, 1, 1); PG8_STAGE(PG8_SA(1, 0), a3, voffA);
            PG8_BAR; PG8_WAIT_L(0); PG8_MMA(1, 0, At, B0); PG8_BAR; PG8_SCHED;
            PG8_STAGE(PG8_SB(1, 1), b3 + hstep, voffB);
            PG8_WAIT_V(6); PG8_BAR; PG8_MMA(1, 1, At, B1); PG8_BAR;
            }
        }
        if constexpr (ALIGN_EPI) { if (wr == 0) PG8_BAR; }
        if constexpr (!Epi::AFTER_DRAIN) { E(acc, cur, wr, wc, fr, fq); S.done(cur); }
        if (!has_next) break;
#pragma unroll
        for (int a = 0; a < 2; ++a)
#pragma unroll
            for (int b = 0; b < 2; ++b)
#pragma unroll
                for (int m = 0; m < 4; ++m)
#pragma unroll
                    for (int n = 0; n < 2; ++n) acc[a][b][m][n] = (f32x4){0.f, 0.f, 0.f, 0.f};
        cur = nxt; cA = nA; cB = nB; ++ui;
        if constexpr (ALIGN_EPI) { if (wr == 1) PG8_BAR; }
    }
    PG8_WAIT_V(0);
    if constexpr (!ALIGN_EPI) { if (wr == 0) PG8_BAR; }
    PG8_BAR;
    if constexpr (Epi::AFTER_DRAIN) { E.fused(acc, cur, wr, wc, fr, fq, lds, wid, lane); S.done(cur); }
#undef PG8_SA
#undef PG8_SB
#undef PG8_STAGE
#undef PG8_LDA
#undef PG8_LDB
#undef PG8_MMA
#undef PG8_WAIT_V
#undef PG8_WAIT_L
#undef PG8_BAR
#undef PG8_SCHED
}
}

#define LAS __attribute__((address_space(3)))
typedef unsigned short bf16;
typedef pg8::f32x4 f32x4;
typedef pg8::u32x4 u32x4;
typedef unsigned u32x2 __attribute__((ext_vector_type(2)));
using pg8::Unit;

constexpr int M = 65536, D = 1024, SEQ = 8192;
constexpr float ALPHA = 1.4142135623730951f;
constexpr float LN_EPS = 1e-5f, GN_EPS = 64e-5f;
constexpr int LDS_BYTES = 147456;

constexpr size_t MiB = (size_t)1 << 20;
constexpr size_t WS_ADAP = 1 * MiB, WS_ADA = 4 * MiB, WS_WLORA0 = 5 * MiB, WS_WLORA1 = 6 * MiB, WS_WINA0 = 8 * MiB, WS_WINA1 = 15 * MiB,
    WS_WG0 = 22 * MiB, WS_WG1 = 28 * MiB, WS_WBR0 = 34 * MiB, WS_WBR1 = 37 * MiB, WS_WOUT0 = 40 * MiB, WS_WOUT1 = 42 * MiB,
    WS_W1_0 = 44 * MiB, WS_W1_1 = 52 * MiB, WS_W2_0 = 60 * MiB, WS_W2_1 = 68 * MiB, WS_VFIRST = 76 * MiB, WS_H = 140 * MiB, WS_AR = 268 * MiB;
constexpr size_t AR_ZR = 0, AR_CG = 224 * MiB, AR_PL = 288 * MiB, AR_LV = 352 * MiB, AR_LO = 224 * MiB, AR_YCV = 480 * MiB, AR_POOL = 544 * MiB,
    AR_YRW = 608 * MiB, AR_LA = 672 * MiB, AR_P = 0, AR_HID = 0;
constexpr size_t WS_END = WS_AR + 720 * MiB;

struct Args { const float* in[36]; float* out; unsigned char* ws; };
typedef const Args __attribute__((address_space(4)))* ArgsP;
__device__ __forceinline__ ArgsP launder(ArgsP p) { asm volatile("" : "+s"(p)); return p; }

#define XB_TMO      128
#define XB_XCNT(j)  (256  + 64 * (j))
#define XB_XSUB(j)  (1280 + 64 * (j))
#define XB_XGEN(j)  (2304 + 64 * (j))
#define XB_TOP      3328
#define XB_TOPGEN   3392
#define XCD_BAR_WORDS 3456
#define XB_SPIN_CAP (1u << 18)

__device__ __forceinline__ unsigned xb_ld(unsigned* p)              { return __hip_atomic_load(p, __ATOMIC_RELAXED, __HIP_MEMORY_SCOPE_AGENT); }
__device__ __forceinline__ unsigned xb_add(unsigned* p, unsigned v) { return __hip_atomic_fetch_add(p, v, __ATOMIC_RELAXED, __HIP_MEMORY_SCOPE_AGENT); }
__device__ __forceinline__ unsigned xb_xcc_id() { return (unsigned)__builtin_amdgcn_s_getreg((3 << 11) | 20) & 0xFu; }
#define XB_SPIN(cond, bar) do { unsigned _sp = 0; while (cond) { __builtin_amdgcn_s_sleep(1); \
    if ((++_sp & 255u) == 0u) { if (xb_ld(&(bar)[XB_TMO])) break; if (_sp > XB_SPIN_CAP) { atomicAdd(&(bar)[XB_TMO], 1u); break; } } } } while (0)

struct XcdBarrier {
    unsigned* bar; unsigned x;
    volatile LAS unsigned* st;
};

__device__ __forceinline__ XcdBarrier xcd_barrier_post(unsigned* bar, volatile LAS unsigned* st) {
    XcdBarrier b; b.bar = bar; b.x = xb_xcc_id(); b.st = st;
    if (threadIdx.x == 0) (void)xb_add(&bar[XB_XCNT(b.x)], 1u);
    return b;
}
__device__ __forceinline__ void xcd_barrier_complete(unsigned* bar, unsigned x, unsigned& nloc, unsigned& nx) {
    const unsigned G = gridDim.x * gridDim.y * gridDim.z;
    unsigned sum, cnt, mine, sp = 0u;
    for (;;) {
        sum = 0u; cnt = 0u; mine = 0u;
#pragma unroll
        for (unsigned j = 0; j < 16; ++j) { const unsigned c = xb_ld(&bar[XB_XCNT(j)]); sum += c; cnt += (c > 0u) ? 1u : 0u; mine = (j == x) ? c : mine; }
        if (sum == G) break;
        __builtin_amdgcn_s_sleep(1);
        if ((++sp & 255u) == 0u) { if (xb_ld(&bar[XB_TMO])) break; if (sp > XB_SPIN_CAP) { atomicAdd(&bar[XB_TMO], 1u); break; } }
    }
    nloc = mine > 0u ? mine : 1u; nx = cnt > 0u ? cnt : 1u;
}

__device__ __forceinline__ void xcd_barrier(const XcdBarrier& b) {
    asm volatile("s_waitcnt vmcnt(0)" ::: "memory");
    __syncthreads();
    if (threadIdx.x == 0) {
        unsigned* bar = b.bar;
        __builtin_amdgcn_s_waitcnt(0);
        unsigned nloc = b.st[0], nx = b.st[1];
        if (nloc == 0u) { xcd_barrier_complete(bar, b.x, nloc, nx); b.st[0] = nloc; b.st[1] = nx; }
        const unsigned old = xb_add(&bar[XB_XSUB(b.x)], 1u);
        const unsigned gen = old / nloc;
        if (old + 1u == (gen + 1u) * nloc) {
            __builtin_amdgcn_fence(__ATOMIC_RELEASE, "agent");
            asm volatile("s_waitcnt vmcnt(0)" ::: "memory");
            const unsigned og = xb_add(&bar[XB_TOP], 1u);
            const unsigned tg = og / nx;
            if (og + 1u == (tg + 1u) * nx) xb_add(&bar[XB_TOPGEN], 1u);
            else XB_SPIN(xb_ld(&bar[XB_TOPGEN]) == tg, bar);
            __builtin_amdgcn_fence(__ATOMIC_ACQUIRE, "agent");
            xb_add(&bar[XB_XGEN(b.x)], 1u);
            asm volatile("s_waitcnt vmcnt(0)" ::: "memory");
        } else {
            XB_SPIN(xb_ld(&bar[XB_XGEN(b.x)]) == gen, bar);
            __builtin_amdgcn_fence(__ATOMIC_ACQUIRE, "agent");
            asm volatile("s_waitcnt vmcnt(0)" ::: "memory");
        }
    }
    __syncthreads();
}
#define LDS_WAIT() asm volatile("s_waitcnt lgkmcnt(0)" ::: "memory")
__device__ __forceinline__ unsigned f2bf(float f) { unsigned u = __builtin_bit_cast(unsigned, f); return (u + 0x7fffu + ((u >> 16) & 1u)) >> 16; }
__device__ __forceinline__ unsigned pk2(float lo, float hi) { return pg8::cvt_pk_bf16(lo, hi); }
__device__ __forceinline__ float bflo(unsigned u) { return __uint_as_float(u << 16); }
__device__ __forceinline__ float bfhi(unsigned u) { return __uint_as_float(u & 0xffff0000u); }
__device__ __forceinline__ float bf1(unsigned short u) { return __uint_as_float(((unsigned)u) << 16); }
__device__ __forceinline__ float sigm(float x) { return 1.f / (1.f + __expf(-x)); }
__device__ __forceinline__ void unpack8(const u32x4 v, float (&o)[8]) { o[0] = bflo(v.x); o[1] = bfhi(v.x); o[2] = bflo(v.y); o[3] = bfhi(v.y); o[4] = bflo(v.z); o[5] = bfhi(v.z); o[6] = bflo(v.w); o[7] = bfhi(v.w); }
__device__ __forceinline__ u32x4 pack8(const float (&o)[8]) { u32x4 r; r.x = pk2(o[0], o[1]); r.y = pk2(o[2], o[3]); r.z = pk2(o[4], o[5]); r.w = pk2(o[6], o[7]); return r; }
__device__ __forceinline__ void load8f(const float* p, float (&o)[8]) { const f32x4 a = *(const f32x4*)p, b = *(const f32x4*)(p + 4); o[0] = a.x; o[1] = a.y; o[2] = a.z; o[3] = a.w; o[4] = b.x; o[5] = b.y; o[6] = b.z; o[7] = b.w; }
__device__ __forceinline__ float wave_sum(float v) {
#pragma unroll
    for (int o = 1; o < 64; o <<= 1) v += __shfl_xor(v, o);
    return v;
}
template <int CTRL> __device__ __forceinline__ float dppf(float x) { return __builtin_bit_cast(float, __builtin_amdgcn_update_dpp(0, __builtin_bit_cast(int, x), CTRL, 0xF, 0xF, true)); }
__device__ __forceinline__ float red4(float x) { x += dppf<0xB1>(x); x += dppf<0x4E>(x); return x; }
__device__ __forceinline__ float red8(float x) { x = red4(x); x += dppf<0x141>(x); return x; }
__device__ __forceinline__ float red16(float x) { x = red8(x); x += dppf<0x140>(x); return x; }

__device__ __forceinline__ void store8(bf16* p, const f32x4 v0, const f32x4 v1) {
    u32x4 w; w.x = pk2(v0[0], v0[1]); w.y = pk2(v0[2], v0[3]); w.z = pk2(v1[0], v1[1]); w.w = pk2(v1[2], v1[3]); *(u32x4*)p = w;
}
struct EpiG1 {
    static constexpr bool PERM = true, AFTER_DRAIN = false;
    bf16 *ZR, *CG, *PL, *LV;
    __device__ __forceinline__ void operator()(const f32x4 (&acc)[2][2][4][2], const Unit& u, int wr, int wc, int fr, int fq) const {
        const int row0 = u.pm * 256 + wr * 64 + fr, pn = u.pn, cin = wc * 32 + 8 * fq;
        if (pn < 7 || (pn >= 11 && pn < 13)) {
            bf16* base = pn < 7 ? ZR : PL; const int ldc = pn < 7 ? 1792 : 512, col0 = (pn < 7 ? pn : pn - 11) * 256 + cin;
#pragma unroll
            for (int ai = 0; ai < 2; ++ai)
#pragma unroll
                for (int m = 0; m < 4; ++m) { bf16* rp = base + (size_t)(row0 + ai * 128 + m * 16) * ldc + col0;
#pragma unroll
                    for (int bj = 0; bj < 2; ++bj) store8(rp + bj * 128, acc[ai][bj][m][0], acc[ai][bj][m][1]); }
        } else if (pn < 11) {
            const int col0 = (pn - 7) * 128 + cin;
#pragma unroll
            for (int ai = 0; ai < 2; ++ai)
#pragma unroll
                for (int m = 0; m < 4; ++m) { f32x4 h0, h1;
#pragma unroll
                    for (int i = 0; i < 4; ++i) { h0[i] = acc[ai][0][m][0][i] * sigm(acc[ai][1][m][0][i]); h1[i] = acc[ai][0][m][1][i] * sigm(acc[ai][1][m][1][i]); }
                    store8(CG + (size_t)(row0 + ai * 128 + m * 16) * 512 + col0, h0, h1); }
        } else {
            if (wc == 0) {
#pragma unroll
                for (int ai = 0; ai < 2; ++ai)
#pragma unroll
                    for (int m = 0; m < 4; ++m) store8(LV + (size_t)(row0 + ai * 128 + m * 16) * 32 + 8 * fq, acc[ai][0][m][0], acc[ai][0][m][1]);
            }
        }
    }
};
struct EpiLora {
    static constexpr bool PERM = true, AFTER_DRAIN = false;
    bf16* O; int ldc; const float *w0, *a0, *v0;
    __device__ __forceinline__ void operator()(const f32x4 (&acc)[2][2][4][2], const Unit& u, int wr, int wc, int fr, int fq) const {
        const int row0 = u.pm * 256 + wr * 64 + fr, type = u.pn >> 1, cin = wc * 32 + 8 * fq;
#pragma unroll
        for (int bj = 0; bj < 2; ++bj) {
            const int cb = u.pn * 256 + bj * 128 + cin, pc = cb & 511;
            f32x4 p0 = (f32x4){0.f, 0.f, 0.f, 0.f}, p1 = p0;
            if (type == 0) { p0 = *(const f32x4*)(w0 + pc); p1 = *(const f32x4*)(w0 + pc + 4); }
            else if (type == 1) { p0 = *(const f32x4*)(a0 + pc); p1 = *(const f32x4*)(a0 + pc + 4); }
            else if (type == 3) { p0 = *(const f32x4*)(v0 + pc); p1 = *(const f32x4*)(v0 + pc + 4); }
#pragma unroll
            for (int ai = 0; ai < 2; ++ai)
#pragma unroll
                for (int m = 0; m < 4; ++m) { f32x4 v0_ = acc[ai][bj][m][0] + p0, v1_ = acc[ai][bj][m][1] + p1;
                    if (type != 2) {
                        const float sc = type == 0 ? 0.60653065971f : 1.f;
#pragma unroll
                        for (int i = 0; i < 4; ++i) { v0_[i] = sc * sigm(v0_[i]); v1_[i] = sc * sigm(v1_[i]); } }
                    store8(O + (size_t)(row0 + ai * 128 + m * 16) * ldc + cb, v0_, v1_); }
        }
    }
};
template <int MODE  > struct EpiBf {
    static constexpr bool PERM = true, AFTER_DRAIN = false;
    bf16* O; int ldc;
    __device__ __forceinline__ void operator()(const f32x4 (&acc)[2][2][4][2], const Unit& u, int wr, int wc, int fr, int fq) const {
        const int row0 = u.pm * 256 + wr * 64 + fr, col0 = u.pn * 256 + wc * 32 + 8 * fq;
#pragma unroll
        for (int ai = 0; ai < 2; ++ai)
#pragma unroll
            for (int m = 0; m < 4; ++m) { bf16* rp = O + (size_t)(row0 + ai * 128 + m * 16) * ldc + col0;
#pragma unroll
                for (int bj = 0; bj < 2; ++bj) { f32x4 v0 = acc[ai][bj][m][0], v1 = acc[ai][bj][m][1];
                    if (MODE == 1) {
#pragma unroll
                        for (int i = 0; i < 4; ++i) { const float a = fmaxf(v0[i], 0.f), b = fmaxf(v1[i], 0.f); v0[i] = a * a; v1[i] = b * b; } }
                    if (MODE == 2) { float p[8]; unpack8(*(const u32x4*)(rp + bj * 128), p);
#pragma unroll
                        for (int i = 0; i < 4; ++i) { v0[i] = sigm(v0[i]) * p[i]; v1[i] = sigm(v1[i]) * p[4 + i]; } }
                    store8(rp + bj * 128, v0, v1); } }
    }
};
struct BranchOrder {
    pg8::StaticOrder S;
    __device__ void init(int M_, int G_, int c_) { S.init(M_, 1024, G_, c_); }
    __device__ bool next(int i, Unit& u) const { const int base = i / 3, br = i - 3 * base; Unit t; if (!S.next(base, t)) return false; u.pm = t.pm; u.pn = br * 4 + t.pn; return true; }
    __device__ __forceinline__ void a_ready(const Unit&) const {}
    __device__ __forceinline__ void done(const Unit&) const {}
};
struct EpiGate {
    static constexpr bool PERM = true, AFTER_DRAIN = false;
    bf16* P;
    __device__ __forceinline__ void operator()(const f32x4 (&acc)[2][2][4][2], const Unit& u, int wr, int wc, int fr, int fq) const {
        const int row0 = u.pm * 256 + wr * 64 + fr, br = u.pn >> 2, cown = u.pn * 256 + wc * 32 + 8 * fq, cslot = (u.pn & 3) * 256 + wc * 32 + 8 * fq;
#pragma unroll
        for (int ai = 0; ai < 2; ++ai)
#pragma unroll
            for (int m = 0; m < 4; ++m) { bf16* rp = P + (size_t)(row0 + ai * 128 + m * 16) * 3072;
#pragma unroll
                for (int bj = 0; bj < 2; ++bj) { f32x4 v0 = acc[ai][bj][m][0], v1 = acc[ai][bj][m][1]; float p[8]; unpack8(*(const u32x4*)(rp + cown + bj * 128), p);
#pragma unroll
                    for (int i = 0; i < 4; ++i) { v0[i] = sigm(v0[i]) * p[i]; v1[i] = sigm(v1[i]) * p[4 + i]; }
                    if (br > 0) { float q[8]; unpack8(*(const u32x4*)(rp + cslot + bj * 128), q);
#pragma unroll
                        for (int i = 0; i < 4; ++i) { v0[i] += q[i]; v1[i] += q[4 + i]; } }
                    store8(rp + cslot + bj * 128, v0, v1); } }
    }
};
struct EpiRes {
    static constexpr bool PERM = false, AFTER_DRAIN = false;
    const float* xin; float* out; const float* gt;
    __device__ __forceinline__ void operator()(const f32x4 (&acc)[2][2][4][2], const Unit& u, int wr, int wc, int fr, int fq) const {
        const float* gtb = gt + (size_t)(u.pm >> 5) * 6144; const int col0 = u.pn * 256 + wc * 32 + 4 * fq;
        f32x4 g4[2][2];
#pragma unroll
        for (int bj = 0; bj < 2; ++bj)
#pragma unroll
            for (int n = 0; n < 2; ++n) g4[bj][n] = *(const f32x4*)(gtb + col0 + bj * 128 + n * 16);
#pragma unroll
        for (int ai = 0; ai < 2; ++ai)
#pragma unroll
            for (int m = 0; m < 4; ++m) { const size_t off = (size_t)(u.pm * 256 + ai * 128 + wr * 64 + m * 16 + fr) * 1024 + col0;
#pragma unroll
                for (int bj = 0; bj < 2; ++bj)
#pragma unroll
                    for (int n = 0; n < 2; ++n) { const f32x4 x4 = *(const f32x4*)(xin + off + bj * 128 + n * 16);
                        *(f32x4*)(out + off + bj * 128 + n * 16) = x4 * ALPHA + g4[bj][n] * acc[ai][bj][m][n]; } }
    }
};

__device__ __forceinline__ void tr_item(const float* W, int N, int k0, int n0, bf16* dst, int K, LAS float* scr, int lane) {
#pragma unroll 8
    for (int i = 0; i < 32; ++i) { const int kk = 2 * i + (lane >> 5); scr[kk * 33 + (lane & 31)] = W[(size_t)(k0 + kk) * N + n0 + (lane & 31)]; }
    LDS_WAIT(); asm volatile("" ::: "memory");
    const int c = lane & 7;
#pragma unroll
    for (int j = 0; j < 4; ++j) { const int n = (lane >> 3) + 8 * j; const LAS float* s = scr + (8 * c) * 33 + n;
        u32x4 o; o.x = pk2(s[0 * 33], s[1 * 33]); o.y = pk2(s[2 * 33], s[3 * 33]); o.z = pk2(s[4 * 33], s[5 * 33]); o.w = pk2(s[6 * 33], s[7 * 33]);
        *(u32x4*)(dst + (size_t)n * K + 8 * c) = o; }
    LDS_WAIT(); asm volatile("" ::: "memory");
}
__device__ __forceinline__ bf16* win_dst(unsigned char* ws, int l, int n0) {
    bf16* wina = (bf16*)(ws + (l ? WS_WINA1 : WS_WINA0)); bf16* wg = (bf16*)(ws + (l ? WS_WG1 : WS_WG0));
    if (n0 < 1792) return wina + (size_t)n0 * 1024;
    if (n0 < 2816) { const int c = n0 - 1792, half = c >> 9, cc = c & 511, j = cc >> 7, i = cc & 127; return wina + (size_t)(1792 + j * 256 + half * 128 + i) * 1024; }
    if (n0 < 3328) return wina + (size_t)n0 * 1024;
    return wg + (size_t)(n0 - 3328) * 1024;
}
__device__ __forceinline__ void p0_phase(ArgsP a_, LAS unsigned char* lds) {
    const ArgsP a = launder(a_);
    const int tid = opq_tid(), lane = tid & 63, wave = tid >> 6, G = opq_gdim();
    const int gw = opq_bid() * 8 + wave, NGW = G * 8, gt = opq_bid() * 512 + tid, NT = G * 512;
    unsigned char* ws = a->ws;
    LAS float* scr = (LAS float*)(lds + wave * 8448);
    for (int it = gw; it < 16656; it += NGW) {
        int r = it;
        if (r >= 16640) { const int kb = r - 16640; tr_item(a->in[5], 32, 64 * kb, 0, (bf16*)(ws + WS_WINA1) + (size_t)3328 * 1024 + 64 * kb, 1024, scr, lane); continue; }
        const int l = r >= 8320 ? 1 : 0; r -= l * 8320;
        if (r < 3200) { const int kb = r / 200, nb = r % 200; tr_item(a->in[4] + (size_t)l * 1024 * 6400, 6400, 64 * kb, 32 * nb, win_dst(ws, l, 32 * nb) + 64 * kb, 1024, scr, lane); continue; } r -= 3200;
        bf16* wbr = (bf16*)(ws + (l ? WS_WBR1 : WS_WBR0));
        if (r < 256) { const int kb = r >> 5, nb = r & 31; tr_item(a->in[20] + (size_t)l * 512 * 1024, 1024, 64 * kb, 32 * nb, wbr + (size_t)(32 * nb) * 512 + 64 * kb, 512, scr, lane); continue; } r -= 256;
        if (r < 256) { const int kb = r >> 5, nb = r & 31; tr_item(a->in[25] + (size_t)l * 512 * 1024, 1024, 64 * kb, 32 * nb, wbr + (size_t)(1024 + 32 * nb) * 512 + 64 * kb, 512, scr, lane); continue; } r -= 256;
        if (r < 512) { const int kb = r >> 5, nb = r & 31; tr_item(a->in[29] + (size_t)l * 1024 * 1024, 1024, 64 * kb, 32 * nb, (bf16*)(ws + (l ? WS_WOUT1 : WS_WOUT0)) + (size_t)(32 * nb) * 1024 + 64 * kb, 1024, scr, lane); continue; } r -= 512;
        if (r < 2048) { const int kb = r >> 7, nb = r & 127; tr_item(a->in[32] + (size_t)l * 1024 * 4096, 4096, 64 * kb, 32 * nb, (bf16*)(ws + (l ? WS_W1_1 : WS_W1_0)) + (size_t)(32 * nb) * 1024 + 64 * kb, 1024, scr, lane); continue; } r -= 2048;
        { const int kb = r >> 5, nb = r & 31; tr_item(a->in[33] + (size_t)l * 4096 * 1024, 1024, 64 * kb, 32 * nb, (bf16*)(ws + (l ? WS_W2_1 : WS_W2_0)) + (size_t)(32 * nb) * 4096 + 64 * kb, 4096, scr, lane); }
    }
    { u32x4* z = (u32x4*)((bf16*)(ws + WS_WINA1) + (size_t)3360 * 1024); for (int i = gt; i < 28672; i += NT) z[i] = (u32x4){0u, 0u, 0u, 0u}; }
    { bf16* w = (bf16*)(ws + WS_WLORA0);
      for (int i = gt; i < 1536 * 256; i += NT) { const int n = i >> 8, k = i & 255; float v = 0.f;
          if (n < 512) { if (k < 64) v = a->in[9][k * 512 + n]; }
          else if (n < 1024) { if (k >= 64 && k < 128) v = a->in[11][(k - 64) * 512 + n - 512]; }
          else { if (k >= 128) v = a->in[12][(k - 128) * 512 + n - 1024]; }
          w[i] = (bf16)f2bf(v); } }
    { bf16* w = (bf16*)(ws + WS_WLORA1);
      for (int i = gt; i < 2048 * 384; i += NT) { const int n = i / 384, k = i % 384; float v = 0.f;
          if (n < 512) { if (k < 64) v = a->in[9][64 * 512 + k * 512 + n]; }
          else if (n < 1024) { if (k >= 64 && k < 128) v = a->in[11][64 * 512 + (k - 64) * 512 + n - 512]; }
          else if (n < 1536) { if (k >= 128 && k < 256) v = a->in[12][128 * 512 + (k - 128) * 512 + n - 1024]; }
          else { if (k >= 256 && k < 288) v = a->in[14][(k - 256) * 512 + n - 1536]; }
          w[i] = (bf16)f2bf(v); } }
    for (int idx = gt; idx < 131072; idx += NT) {
        const int n = idx & 1023, cg8 = (idx >> 10) & 63, l = idx >> 16, g = cg8 >> 4, c0 = (cg8 & 15) * 8;
        const float* plw = a->in[26] + ((size_t)(l * 4 + g) * 128 + c0) * 128; const float* pls = a->in[27] + l * 512 + g * 128; const float* plo = a->in[28] + ((size_t)l * 512 + g * 128) * 1024 + n;
        float acc[8];
#pragma unroll
        for (int i = 0; i < 8; ++i) acc[i] = 0.f;
#pragma unroll 8
        for (int d = 0; d < 128; ++d) { const float bw = plo[(size_t)d * 1024] * pls[d];
#pragma unroll
            for (int i = 0; i < 8; ++i) acc[i] += plw[i * 128 + d] * bw; }
        bf16* wbr = (bf16*)(ws + (l ? WS_WBR1 : WS_WBR0));
        *(u32x4*)(wbr + (size_t)(2048 + n) * 512 + g * 128 + c0) = pack8(acc);
    }
    float* adap = (float*)(ws + WS_ADAP);
    for (int wt = gw; wt < 1536; wt += NGW) {
        const int l = wt / 768, r = wt % 768, cb = r >> 3, kc = r & 7, col = cb * 64 + lane;
#pragma unroll
        for (int i = 0; i < 16; ++i) { const int idx = lane + 64 * i, b = idx >> 7, kk = idx & 127; const float x = a->in[1][b * 1024 + kc * 128 + kk]; scr[idx] = x * sigm(x); }
        LDS_WAIT(); asm volatile("" ::: "memory");
        float acc[8];
#pragma unroll
        for (int b = 0; b < 8; ++b) acc[b] = 0.f;
        const float* wp = a->in[2] + ((size_t)l * 1024 + kc * 128) * 6144 + col;
#pragma unroll 4
        for (int kk = 0; kk < 128; ++kk) { const float w = wp[(size_t)kk * 6144];
#pragma unroll
            for (int b = 0; b < 8; ++b) acc[b] += scr[b * 128 + kk] * w; }
#pragma unroll
        for (int b = 0; b < 8; ++b) adap[((size_t)(l * 8 + kc) * 8 + b) * 6144 + col] = acc[b];
        LDS_WAIT(); asm volatile("" ::: "memory");
    }
}
__device__ __forceinline__ void p0b_phase(ArgsP a_) {
    const ArgsP a = launder(a_);
    const int tid = opq_tid(), lane = tid & 63, wave = tid >> 6, G = opq_gdim();
    const int gw = opq_bid() * 8 + wave, NGW = G * 8, gt = opq_bid() * 512 + tid, NT = G * 512;
    const float* adap = (const float*)(a->ws + WS_ADAP); float* ada = (float*)(a->ws + WS_ADA);
    for (int i = gt; i < 2 * 49152; i += NT) { const int l = i / 49152, r = i % 49152, col = r % 6144; float s = a->in[3][l * 6144 + col];
#pragma unroll
        for (int kc = 0; kc < 8; ++kc) s += adap[(size_t)(l * 8 + kc) * 49152 + r];
        ada[i] = s; }
    bf16* H = (bf16*)(a->ws + WS_H);
    for (int rb = gw; rb < 2048; rb += NGW) {
        const int b = rb >> 8; f32x4 sh[4], sc[4];
#pragma unroll
        for (int j = 0; j < 4; ++j) { const int col = 4 * lane + 256 * j; f32x4 s0 = *(const f32x4*)(a->in[3] + col), s1 = *(const f32x4*)(a->in[3] + 1024 + col);
#pragma unroll
            for (int kc = 0; kc < 8; ++kc) { s0 += *(const f32x4*)(adap + (size_t)kc * 49152 + b * 6144 + col); s1 += *(const f32x4*)(adap + (size_t)kc * 49152 + b * 6144 + 1024 + col); }
            sh[j] = s0; sc[j] = s1 + 1.f; }
        for (int rr = 0; rr < 32; ++rr) { const size_t m = (size_t)rb * 32 + rr;
#pragma unroll
            for (int j = 0; j < 4; ++j) { const int col = 4 * lane + 256 * j; const f32x4 x = *(const f32x4*)(a->in[0] + m * 1024 + col); const f32x4 h = x * sc[j] + sh[j];
                u32x2 w; w.x = pk2(h[0], h[1]); w.y = pk2(h[2], h[3]); *(u32x2*)(H + m * 1024 + col) = w; } }
    }
}
__device__ __forceinline__ void ln_phase(float* X, bf16* H, const float* gam, const float* bet, const float* adash  , const float* adasc, bool writeH) {
    const int tid = opq_tid(), lane = tid & 63, wave = tid >> 6, gw = opq_bid() * 8 + wave, NGW = opq_gdim() * 8;
    for (int rb = gw; rb < 2048; rb += NGW) {
        const int b = rb >> 8; f32x4 g4[4], b4[4], sh[4], sc[4];
#pragma unroll
        for (int j = 0; j < 4; ++j) { const int col = 4 * lane + 256 * j; g4[j] = *(const f32x4*)(gam + col); b4[j] = *(const f32x4*)(bet + col);
            if (writeH) { sh[j] = *(const f32x4*)(adash + b * 6144 + col); sc[j] = *(const f32x4*)(adasc + b * 6144 + col) + 1.f; } else { sh[j] = g4[j]; sc[j] = g4[j]; } }
        for (int rr = 0; rr < 32; ++rr) { const size_t m = (size_t)rb * 32 + rr; f32x4 v[4]; float s = 0.f;
#pragma unroll
            for (int j = 0; j < 4; ++j) { v[j] = *(const f32x4*)(X + m * 1024 + 4 * lane + 256 * j); s += (v[j][0] + v[j][1]) + (v[j][2] + v[j][3]); }
            const float mean = wave_sum(s) * (1.f / 1024.f); float q = 0.f;
#pragma unroll
            for (int j = 0; j < 4; ++j) { v[j] = v[j] - mean; q += (v[j][0] * v[j][0] + v[j][1] * v[j][1]) + (v[j][2] * v[j][2] + v[j][3] * v[j][3]); }
            const float rstd = 1.0f / sqrtf(wave_sum(q) * (1.f / 1024.f) + LN_EPS);
#pragma unroll
            for (int j = 0; j < 4; ++j) { const int col = 4 * lane + 256 * j; const f32x4 y = v[j] * rstd * g4[j] + b4[j]; *(f32x4*)(X + m * 1024 + col) = y;
                if (writeH) { const f32x4 h = y * sc[j] + sh[j]; u32x2 w; w.x = pk2(h[0], h[1]); w.y = pk2(h[2], h[3]); *(u32x2*)(H + m * 1024 + col) = w; } } }
    }
}
__device__ __forceinline__ void prep_phase(ArgsP a_, int l, LAS unsigned char* lds) {
    const ArgsP a = launder(a_);
    const int tid = opq_tid(), lane = tid & 63, wave = tid >> 6, gw = opq_bid() * 8 + wave, NGW = opq_gdim() * 8;
    unsigned char* ar = a->ws + WS_AR;
    const bf16* ZR = (const bf16*)(ar + AR_ZR); const bf16* CG = (const bf16*)(ar + AR_CG); const bf16* PL = (const bf16*)(ar + AR_PL); const bf16* LV = (const bf16*)(ar + AR_LV);
    bf16* LA = (bf16*)(ar + AR_LA); bf16* YCV = (bf16*)(ar + AR_YCV); bf16* POOL = (bf16*)(ar + AR_POOL);
    LAS float* cw = (LAS float*)lds;
    for (int i = tid; i < 31 * 512; i += 512) cw[i] = a->in[21][l * 31 * 512 + i];
    __syncthreads();
    const int c8 = 8 * lane, ldA = l ? 384 : 256;
    float cvb[8], lng[8], lnb[8], mu[8];
    load8f(a->in[22] + l * 512 + c8, cvb); load8f(a->in[23] + l * 512 + c8, lng); load8f(a->in[24] + l * 512 + c8, lnb);
    if (lane < 32) load8f(a->in[6] + l * 1792 + 1536 + c8, mu);
    else if (l && lane < 36) load8f(a->in[7] + 8 * (lane - 32), mu);
    else {
#pragma unroll
        for (int i = 0; i < 8; ++i) mu[i] = 0.f; }
    for (int rb = gw; rb < 2048; rb += NGW)
        for (int gq = 0; gq < 8; ++gq) {
            const size_t m0 = (size_t)rb * 32 + gq * 4; const int s0 = (int)(m0 & 8191);
            if (lane < 32 || (l && lane < 36)) {
                const bf16* src = lane < 32 ? ZR + m0 * 1792 + 1536 + c8 : LV + m0 * 32 + 8 * (lane - 32); const int ldp = lane < 32 ? 1792 : 32;
                u32x4 zz[5];
#pragma unroll
                for (int i = 0; i < 5; ++i) zz[i] = (i == 0 && s0 == 0) ? (u32x4){0u, 0u, 0u, 0u} : *(const u32x4*)(src + (ptrdiff_t)(i - 1) * ldp);
#pragma unroll
                for (int i = 0; i < 4; ++i) { float zt[8], zp[8]; unpack8(zz[i + 1], zt); unpack8(zz[i], zp);
#pragma unroll
                    for (int q = 0; q < 8; ++q) { float z = zt[q] + (zp[q] - zt[q]) * mu[q];
                        if (lane < 8) z = 1.f - 2.f / (1.f + __expf(2.f * z)); else if (lane >= 16 && lane < 32) z = sigm(z);
                        zt[q] = z; }
                    *(u32x4*)(LA + (m0 + i) * ldA + (lane < 32 ? c8 : 256 + 8 * (lane - 32))) = pack8(zt); }
            } else if (l && lane < 48) {
#pragma unroll
                for (int i = 0; i < 4; ++i) *(u32x4*)(LA + (m0 + i) * ldA + c8) = (u32x4){0u, 0u, 0u, 0u}; }
            { float acc[4][8]; f32x4 wq[4][2];
#pragma unroll
              for (int i = 0; i < 4; ++i)
#pragma unroll
                  for (int q = 0; q < 8; ++q) acc[i][q] = cvb[q];
#pragma unroll
              for (int hh = 0; hh < 2; ++hh) {
                  u32x4 xr[17];
#pragma unroll
                  for (int r = 0; r < 17; ++r) { const int rr = hh * 17 + r; const size_t row = (s0 - 30 + rr >= 0) ? (m0 - 30 + rr) : m0; xr[r] = *(const u32x4*)(CG + row * 512 + c8); }
#pragma unroll
                  for (int r = 0; r < 17; ++r) { const int rr = hh * 17 + r;
                      if (rr <= 30) { wq[rr & 3][0] = *(const LAS f32x4*)(cw + rr * 512 + c8); wq[rr & 3][1] = *(const LAS f32x4*)(cw + rr * 512 + c8 + 4); }
                      if (s0 - 30 + rr >= 0) { float x[8]; unpack8(xr[r], x);
#pragma unroll
                          for (int i = 0; i < 4; ++i) { const int j = rr - i; if (j >= 0 && j <= 30) {
#pragma unroll
                              for (int q = 0; q < 4; ++q) { acc[i][q] += x[q] * wq[j & 3][0][q]; acc[i][4 + q] += x[4 + q] * wq[j & 3][1][q]; } } } } }
              }
#pragma unroll
              for (int i = 0; i < 4; ++i) { float s1 = 0.f;
#pragma unroll
                  for (int q = 0; q < 8; ++q) s1 += acc[i][q];
                  const float mean = wave_sum(s1) * (1.f / 512.f); float qq = 0.f;
#pragma unroll
                  for (int q = 0; q < 8; ++q) { acc[i][q] -= mean; qq += acc[i][q] * acc[i][q]; }
                  const float rstd = 1.0f / sqrtf(wave_sum(qq) * (1.f / 512.f) + LN_EPS);
#pragma unroll
                  for (int q = 0; q < 8; ++q) { const float y = acc[i][q] * rstd * lng[q] + lnb[q]; acc[i][q] = y * sigm(y); }
                  *(u32x4*)(YCV + (m0 + i) * 512 + c8) = pack8(acc[i]); } }
            { const int win = 2 << (lane >> 4); u32x4 pr[19]; float sum[4][8], x0[4][8];
#pragma unroll
              for (int r = 0; r < 19; ++r) { const size_t row = (s0 - 15 + r >= 0) ? (m0 - 15 + r) : m0; pr[r] = *(const u32x4*)(PL + row * 512 + c8); }
#pragma unroll
              for (int i = 0; i < 4; ++i)
#pragma unroll
                  for (int q = 0; q < 8; ++q) sum[i][q] = 0.f;
#pragma unroll
              for (int r = 0; r < 19; ++r) { float x[8]; unpack8(pr[r], x);
#pragma unroll
                  for (int i = 0; i < 4; ++i) { const int d = i + 15 - r;
                      if (d >= 0 && d <= 15) { const int cnt = (s0 + i + 1) < win ? (s0 + i + 1) : win; const float f = d < cnt ? 1.f : 0.f;
#pragma unroll
                          for (int q = 0; q < 8; ++q) sum[i][q] += x[q] * f;
                          if (d == 0) {
#pragma unroll
                              for (int q = 0; q < 8; ++q) x0[i][q] = x[q]; } } } }
#pragma unroll
              for (int i = 0; i < 4; ++i) { const int cnt = (s0 + i + 1) < win ? (s0 + i + 1) : win; const float inv = 1.f / (float)cnt;
#pragma unroll
                  for (int q = 0; q < 8; ++q) sum[i][q] = sum[i][q] * inv - x0[i][q];
                  *(u32x4*)(POOL + (m0 + i) * 512 + c8) = pack8(sum[i]); } }
        }
    __syncthreads();
}
struct HSet { u32x2 rt[2], kt[2], rp[2], kp[2], ee[2], aa[2]; unsigned short vt[2], vp[2], vm[2], vf[2]; };
constexpr int SC_VV = 0, SC_YP = 4096, SC_OPS = 20480;
__device__ __forceinline__ void sc_load(HSet& S, int c, int l, int b, int h, int rg, int hl, const bf16* ZR, const bf16* LO, int ldlo, const bf16* VF) {
    if (c >= 256) return;
    const int cg = hl & 15, vc = h * 64 + 16 * rg + cg;
#pragma unroll
    for (int p = 0; p < 2; ++p) {
        const int t = (hl >> 4) + 16 * p, s = c * 32 + t; const size_t m = (size_t)b * 8192 + s;
        const bf16* zr = ZR + m * 1792; const bf16* lo = LO + m * ldlo;
        S.rt[p] = *(const u32x2*)(zr + h * 64 + 4 * cg); S.kt[p] = *(const u32x2*)(zr + 512 + h * 64 + 4 * cg); S.vt[p] = zr[1024 + vc];
        if (s > 0) { S.rp[p] = *(const u32x2*)(zr - 1792 + h * 64 + 4 * cg); S.kp[p] = *(const u32x2*)(zr - 1792 + 512 + h * 64 + 4 * cg); S.vp[p] = zr[-1792 + 1024 + vc]; }
        else { S.rp[p] = (u32x2){0u, 0u}; S.kp[p] = (u32x2){0u, 0u}; S.vp[p] = 0; }
        S.ee[p] = *(const u32x2*)(lo + h * 64 + 4 * cg); S.aa[p] = *(const u32x2*)(lo + 512 + h * 64 + 4 * cg);
        if (l) { S.vm[p] = lo[1536 + vc]; S.vf[p] = VF[m * 512 + vc]; } else { S.vm[p] = 0; S.vf[p] = 0; }
    }
}
__device__ __forceinline__ void sc_prep(const HSet& S, int c, int buf, int l, int b, int h, int rg, int hl, LAS unsigned char* lds, bf16* VF,
                                        const f32x4 mur, const f32x4 muk, const f32x4 kkc, const f32x4 kac, const float muv) {
    if (c >= 256) return;
    const int cg = hl & 15, vc = h * 64 + 16 * rg + cg;
#pragma unroll
    for (int p = 0; p < 2; ++p) {
        const int t = (hl >> 4) + 16 * p; const size_t m = (size_t)b * 8192 + c * 32 + t;
        f32x4 rt = {bflo(S.rt[p].x), bfhi(S.rt[p].x), bflo(S.rt[p].y), bfhi(S.rt[p].y)}, rp = {bflo(S.rp[p].x), bfhi(S.rp[p].x), bflo(S.rp[p].y), bfhi(S.rp[p].y)};
        f32x4 kt = {bflo(S.kt[p].x), bfhi(S.kt[p].x), bflo(S.kt[p].y), bfhi(S.kt[p].y)}, kp = {bflo(S.kp[p].x), bfhi(S.kp[p].x), bflo(S.kp[p].y), bfhi(S.kp[p].y)};
        const f32x4 e = {bflo(S.ee[p].x), bfhi(S.ee[p].x), bflo(S.ee[p].y), bfhi(S.ee[p].y)}, av = {bflo(S.aa[p].x), bfhi(S.aa[p].x), bflo(S.aa[p].y), bfhi(S.aa[p].y)};
        const f32x4 r = rt + (rp - rt) * mur, k = kt + (kp - kt) * muk;
        f32x4 w; w[0] = __expf(-e[0]); w[1] = __expf(-e[1]); w[2] = __expf(-e[2]); w[3] = __expf(-e[3]);
        f32x4 kk = k * kkc; const float ss = red16((kk[0] * kk[0] + kk[1] * kk[1]) + (kk[2] * kk[2] + kk[3] * kk[3]));
        kk = kk * __builtin_amdgcn_rsqf(fmaxf(ss, 1e-24f));
        const f32x4 kh = k * ((av - 1.f) * kac + 1.f);
        LAS float* o = (LAS float*)(lds + SC_OPS) + (buf * 32 + t) * 320 + 4 * cg;
        *(LAS f32x4*)(o) = w; *(LAS f32x4*)(o + 64) = -kk; *(LAS f32x4*)(o + 128) = kk * av; *(LAS f32x4*)(o + 192) = kh; *(LAS f32x4*)(o + 256) = r;
        const float vt = bf1(S.vt[p]), vp = bf1(S.vp[p]); float v = vt + (vp - vt) * muv;
        if (l) v = v + (bf1(S.vf[p]) - v) * bf1(S.vm[p]); else VF[m * 512 + vc] = (bf16)pk2(v, v);
        ((LAS float*)(lds + SC_VV))[(buf * 32 + t) * 16 + cg] = v;
    }
}
__device__ __forceinline__ void sc_yred(int c, int buf, int b, int h, int rg, int hl, LAS unsigned char* lds, bf16* YRW) {
    const int i = hl & 15;
#pragma unroll
    for (int p = 0; p < 2; ++p) { const int t = (hl >> 4) + 16 * p; const size_t m = (size_t)b * 8192 + c * 32 + t;
        const f32x4 q = *(const LAS f32x4*)((LAS float*)(lds + SC_YP) + ((buf * 32 + t) * 16 + i) * 4);
        const float ys = (q[0] + q[1]) + (q[2] + q[3]); YRW[m * 512 + h * 64 + 16 * rg + i] = (bf16)pk2(ys, ys); }
}
typedef float f32x2 __attribute__((ext_vector_type(2)));
struct ScOp { f32x4 w, a, b, k, r; float v; };
__device__ __forceinline__ ScOp sc_ld(const LAS float* ops, const LAS float* vv, int t) {
    ScOp o; o.w = *(const LAS f32x4*)(ops + t * 320); o.a = *(const LAS f32x4*)(ops + t * 320 + 64); o.b = *(const LAS f32x4*)(ops + t * 320 + 128);
    o.k = *(const LAS f32x4*)(ops + t * 320 + 192); o.r = *(const LAS f32x4*)(ops + t * 320 + 256); o.v = vv[t * 16]; return o;
}
__device__ __forceinline__ void sc_step(f32x2& s0, f32x2& s1, const ScOp& o, LAS float* ypt) {
    f32x2 p = s0 * o.a.xy; p = s1 * o.a.zw + p;
    const f32x2 vv = {o.v, o.v};
    const f32x2 t0 = s0 * o.w.xy + o.k.xy * vv, t1 = s1 * o.w.zw + o.k.zw * vv;
    const float sa = red16(p.x + p.y);
    const f32x2 sav = {sa, sa};
    s0 = o.b.xy * sav + t0;
    s1 = o.b.zw * sav + t1;
    f32x2 q = s0 * o.r.xy; q = s1 * o.r.zw + q;
    *ypt = red4(q.x + q.y);
}
__device__ __forceinline__ void sc_scan(f32x2& s0, f32x2& s1, int buf, int row, int seg, int lane, LAS unsigned char* lds) {
    const LAS float* ops = (const LAS float*)(lds + SC_OPS) + buf * 32 * 320 + 4 * seg;
    const LAS float* vv = (const LAS float*)(lds + SC_VV) + buf * 32 * 16 + row;
    LAS float* yp = (LAS float*)(lds + SC_YP) + (buf * 32 * 16 + row) * 4 + (seg >> 2);
    ScOp o0 = sc_ld(ops, vv, 0), o1 = sc_ld(ops, vv, 1);
#pragma unroll
    for (int t = 0; t < 32; t += 2) {
        const ScOp o2 = sc_ld(ops, vv, t + 2); sc_step(s0, s1, o0, yp + t * 64);
        const ScOp o3 = sc_ld(ops, vv, t + 3); sc_step(s0, s1, o1, yp + (t + 1) * 64);
        o0 = o2; o1 = o3;
    }
}
__device__ __forceinline__ void scan_phase(ArgsP a_, int l, LAS unsigned char* lds) {
    const ArgsP a = launder(a_);
    const int tid = opq_tid(), lane = tid & 63, wave = __builtin_amdgcn_readfirstlane(tid >> 6);
    unsigned char* ar = a->ws + WS_AR;
    const bf16* ZR = (const bf16*)(ar + AR_ZR); const bf16* LO = (const bf16*)(ar + AR_LO); const int ldlo = l ? 2048 : 1536;
    bf16* VF = (bf16*)(a->ws + WS_VFIRST); bf16* YRW = (bf16*)(ar + AR_YRW);
    for (int u = opq_bid(); u < 256; u += opq_gdim()) {
        const int b = u >> 5, h = (u >> 2) & 7, rg = u & 3;
        if (wave < 4) {
            f32x2 s0 = {0.f, 0.f}, s1 = {0.f, 0.f}; const int row = 4 * wave + (lane >> 4), seg = lane & 15;
            __syncthreads();
            for (int c = 0; c < 256; c += 2) {
                if (DUPM & 64) { f32x2 a0 = s0, a1 = s1; sc_scan(a0, a1, 0, row, seg, lane, lds); asm volatile("" :: "v"(a0), "v"(a1) : "memory"); }
                sc_scan(s0, s1, 0, row, seg, lane, lds); __syncthreads();
                if (DUPM & 64) { f32x2 a0 = s0, a1 = s1; sc_scan(a0, a1, 1, row, seg, lane, lds); asm volatile("" :: "v"(a0), "v"(a1) : "memory"); }
                sc_scan(s0, s1, 1, row, seg, lane, lds); __syncthreads(); }
        } else {
            const int hl = tid - 256, cg = hl & 15, ch = h * 64 + 4 * cg, vc = h * 64 + 16 * rg + cg;
            const f32x4 mur = *(const f32x4*)(a->in[6] + l * 1792 + ch), muk = *(const f32x4*)(a->in[6] + l * 1792 + 512 + ch);
            const f32x4 kkc = *(const f32x4*)(a->in[15] + l * 512 + ch), kac = *(const f32x4*)(a->in[16] + l * 512 + ch);
            const float muv = a->in[6][l * 1792 + 1024 + vc];
            HSet SA, SB;
            sc_load(SA, 0, l, b, h, rg, hl, ZR, LO, ldlo, VF); sc_prep(SA, 0, 0, l, b, h, rg, hl, lds, VF, mur, muk, kkc, kac, muv);
            sc_load(SA, 1, l, b, h, rg, hl, ZR, LO, ldlo, VF); sc_load(SB, 2, l, b, h, rg, hl, ZR, LO, ldlo, VF);
            __syncthreads();
            for (int c = 0; c < 256; c += 2) {
                if (c > 0) sc_yred(c - 1, 1, b, h, rg, hl, lds, YRW);
                sc_prep(SA, c + 1, 1, l, b, h, rg, hl, lds, VF, mur, muk, kkc, kac, muv);
                if (DUPM & 32) { f32x4 m2 = mur; asm volatile("" : "+v"(m2) :: "memory"); sc_prep(SA, c + 1, 1, l, b, h, rg, hl, lds, VF, m2, muk, kkc, kac, muv); }
                sc_load(SA, c + 3, l, b, h, rg, hl, ZR, LO, ldlo, VF);
                __syncthreads();
                sc_yred(c, 0, b, h, rg, hl, lds, YRW);
                sc_prep(SB, c + 2, 0, l, b, h, rg, hl, lds, VF, mur, muk, kkc, kac, muv);
                if (DUPM & 32) { f32x4 m2 = mur; asm volatile("" : "+v"(m2) :: "memory"); sc_prep(SB, c + 2, 0, l, b, h, rg, hl, lds, VF, m2, muk, kkc, kac, muv); }
                sc_load(SB, c + 4, l, b, h, rg, hl, ZR, LO, ldlo, VF);
                __syncthreads();
            }
            sc_yred(255, 1, b, h, rg, hl, lds, YRW);
        }
        __syncthreads();
    }
}
__device__ __forceinline__ void post_phase(ArgsP a_, int l) {
    const ArgsP a = launder(a_);
    const int tid = opq_tid(), lane = tid & 63, wave = tid >> 6, gw = opq_bid() * 8 + wave, NGW = opq_gdim() * 8, c8 = 8 * lane;
    unsigned char* ar = a->ws + WS_AR;
    const bf16* __restrict__ ZR = (const bf16*)(ar + AR_ZR); const bf16* __restrict__ LO = (const bf16*)(ar + AR_LO); const int ldlo = l ? 2048 : 1536;
    const bf16* __restrict__ VF = (const bf16*)(a->ws + WS_VFIRST); bf16* __restrict__ YRW = (bf16*)(ar + AR_YRW); const bf16* __restrict__ YRD = (const bf16*)(ar + AR_YRW);
    float mur[8], muk[8], muv[8], ka[8], rk[8], gng[8], gnb[8];
    load8f(a->in[6] + l * 1792 + c8, mur); load8f(a->in[6] + l * 1792 + 512 + c8, muk); load8f(a->in[6] + l * 1792 + 1024 + c8, muv);
    load8f(a->in[16] + l * 512 + c8, ka); load8f(a->in[17] + l * 512 + c8, rk); load8f(a->in[18] + l * 512 + c8, gng); load8f(a->in[19] + l * 512 + c8, gnb);
    for (int rb = gw; rb < 2048; rb += NGW)
#pragma unroll 2
        for (int rr = 0; rr < 32; ++rr) {
            const size_t m = (size_t)rb * 32 + rr; const int s = (int)(m & 8191);
            const bf16* zr = ZR + m * 1792 + c8; const bf16* lo = LO + m * ldlo + c8;
            float y[8], rt[8], kt[8], vt[8], rp[8], kp[8], vp[8], av[8], g[8];
            unpack8(*(const u32x4*)(YRD + m * 512 + c8), y);
            unpack8(*(const u32x4*)zr, rt); unpack8(*(const u32x4*)(zr + 512), kt); unpack8(*(const u32x4*)(zr + 1024), vt);
            if (s > 0) { unpack8(*(const u32x4*)(zr - 1792), rp); unpack8(*(const u32x4*)(zr - 1792 + 512), kp); unpack8(*(const u32x4*)(zr - 1792 + 1024), vp); }
            else {
#pragma unroll
                for (int i = 0; i < 8; ++i) { rp[i] = 0.f; kp[i] = 0.f; vp[i] = 0.f; } }
            unpack8(*(const u32x4*)(lo + 512), av); unpack8(*(const u32x4*)(lo + 1024), g);
            float bon = 0.f, sy = 0.f;
#pragma unroll
            for (int i = 0; i < 8; ++i) { const float r = rt[i] + (rp[i] - rt[i]) * mur[i], k = kt[i] + (kp[i] - kt[i]) * muk[i]; vt[i] = vt[i] + (vp[i] - vt[i]) * muv[i];
                bon += r * (k * (1.f + (av[i] - 1.f) * ka[i])) * rk[i]; sy += y[i]; }
            if (l) { float vm[8], vf[8]; unpack8(*(const u32x4*)(lo + 1536), vm); unpack8(*(const u32x4*)(VF + m * 512 + c8), vf);
#pragma unroll
                for (int i = 0; i < 8; ++i) vt[i] = vt[i] + (vf[i] - vt[i]) * vm[i]; }
            bon = red8(bon); const float mean = red8(sy) * (1.f / 64.f); float q = 0.f;
#pragma unroll
            for (int i = 0; i < 8; ++i) { y[i] -= mean; q += y[i] * y[i]; }
            const float rstd = 1.0f / sqrtf(red8(q) * (1.f / 64.f) + GN_EPS);
#pragma unroll
            for (int i = 0; i < 8; ++i) y[i] = (y[i] * rstd * gng[i] + gnb[i] + bon * vt[i]) * g[i];
            *(u32x4*)(YRW + m * 512 + c8) = pack8(y);
        }
}
__device__ __forceinline__ void combine_phase(ArgsP a_) {
    const ArgsP a = launder(a_);
    const int gt = opq_bid() * 512 + opq_tid(), NT = opq_gdim() * 512;
    const bf16* P = (const bf16*)(a->ws + WS_AR + AR_P); bf16* Hm = (bf16*)(a->ws + WS_H);
    for (int i = gt; i < M * 128; i += NT) { const size_t m = (size_t)(i >> 7); const int c8 = (i & 127) * 8; float p0[8], p1[8], p2[8];
        unpack8(*(const u32x4*)(P + m * 3072 + c8), p0); unpack8(*(const u32x4*)(P + m * 3072 + 1024 + c8), p1); unpack8(*(const u32x4*)(P + m * 3072 + 2048 + c8), p2);
#pragma unroll
        for (int q = 0; q < 8; ++q) p0[q] = (p0[q] + p1[q]) + p2[q];
        *(u32x4*)(Hm + m * 1024 + c8) = pack8(p0); }
}

#ifndef DUPM
#define DUPM 0
#endif
#ifndef PHM
#define PHM 0x7fff
#endif
#define GSYNC() do { XcdBarrier b_; b_.bar = (unsigned*)(launder(ak)->ws) + 1024; b_.x = xb_xcc_id(); b_.st = (volatile LAS unsigned*)(lds + LDS_BYTES - 64); xcd_barrier(b_); } while (0)
__global__ void __launch_bounds__(512, 2) fwd_kernel(Args kargs) {
    extern __shared__ __attribute__((aligned(16))) unsigned char lds_raw[];
    LAS unsigned char* lds = (LAS unsigned char*)lds_raw;
    cg::grid_group grid = cg::this_grid();
    { volatile LAS unsigned* st0 = (volatile LAS unsigned*)(lds + LDS_BYTES - 64); if (threadIdx.x == 0) { st0[0] = 0u; st0[1] = 0u; } __syncthreads(); }
    (void)xcd_barrier_post((unsigned*)(launder((ArgsP)__builtin_amdgcn_kernarg_segment_ptr())->ws) + 1024, (volatile LAS unsigned*)(lds + LDS_BYTES - 64));
    const ArgsP ak = (ArgsP)__builtin_amdgcn_kernarg_segment_ptr();

    if (PHM & 1) p0_phase(ak, lds); grid.sync();
    if (PHM & 2) p0b_phase(ak); GSYNC();
#pragma unroll 1
    for (int l = 0; l < 2; ++l) {
        if (PHM & 4) { const ArgsP a = launder(ak); const int G = opq_gdim(), bx = opq_bid(); unsigned char* ws = a->ws; unsigned char* ar = ws + WS_AR; bf16* H = (bf16*)(ws + WS_H); const float* adal = (const float*)(ws + WS_ADA) + l * 49152; (void)ar; (void)H; (void)adal;
          pg8::Gemm g{H, nullptr, nullptr, 0, (const bf16*)(ws + (l ? WS_WINA1 : WS_WINA0)), M, l ? 3584 : 3328, 1024};
          pg8::StaticOrder S; S.init(M, g.N, G, bx);
          EpiG1 E{(bf16*)(ar + AR_ZR), (bf16*)(ar + AR_CG), (bf16*)(ar + AR_PL), (bf16*)(ar + AR_LV)};
          pg8::gemm_phase<EpiG1, pg8::StaticOrder, true, true>(lds, g, S, E); }
        GSYNC();
        if (PHM & 8) prep_phase(ak, l, lds); GSYNC();
        if (DUPM & 1) { prep_phase(ak, l, lds); GSYNC(); }
        if (PHM & 16) { const ArgsP a = launder(ak); const int G = opq_gdim(), bx = opq_bid(); unsigned char* ws = a->ws; unsigned char* ar = ws + WS_AR; bf16* H = (bf16*)(ws + WS_H); const float* adal = (const float*)(ws + WS_ADA) + l * 49152; (void)ar; (void)H; (void)adal;
          pg8::Gemm g{(const bf16*)(ar + AR_LA), nullptr, nullptr, 0, (const bf16*)(ws + (l ? WS_WLORA1 : WS_WLORA0)), M, l ? 2048 : 1536, l ? 384 : 256};
          pg8::StaticOrder S; S.init(M, g.N, G, bx);
          EpiLora E{(bf16*)(ar + AR_LO), l ? 2048 : 1536, a->in[8] + l * 512, a->in[10] + l * 512, a->in[13]};
          pg8::gemm_phase<EpiLora, pg8::StaticOrder, true, true>(lds, g, S, E); }
        GSYNC();
        if (PHM & 32) scan_phase(ak, l, lds); GSYNC();
        if (DUPM & 16) { scan_phase(ak, l, lds); GSYNC(); }
        if (PHM & 64) post_phase(ak, l); GSYNC();
        if (DUPM & 2) { scan_phase(ak, l, lds); GSYNC(); post_phase(ak, l); GSYNC(); }
        if (DUPM & 4) { for (int q = 0; q < 16; ++q) GSYNC(); }
        if (PHM & 128) { const ArgsP a = launder(ak); const int G = opq_gdim(), bx = opq_bid(); unsigned char* ws = a->ws; unsigned char* ar = ws + WS_AR; bf16* H = (bf16*)(ws + WS_H); const float* adal = (const float*)(ws + WS_ADA) + l * 49152; (void)ar; (void)H; (void)adal;
          pg8::Gemm g{(const bf16*)(ar + AR_YRW), (const bf16*)(ar + AR_YCV), (const bf16*)(ar + AR_POOL), 4, (const bf16*)(ws + (l ? WS_WBR1 : WS_WBR0)), M, 3072, 512};
          pg8::StaticOrder S; S.init(M, g.N, G, bx);
          EpiBf<0> E{(bf16*)(ar + AR_P), 3072};
          pg8::gemm_phase<EpiBf<0>, pg8::StaticOrder, true, true>(lds, g, S, E); }
        GSYNC();
        if (PHM & 256) { const ArgsP a = launder(ak); const int G = opq_gdim(), bx = opq_bid(); unsigned char* ws = a->ws; unsigned char* ar = ws + WS_AR; bf16* H = (bf16*)(ws + WS_H); const float* adal = (const float*)(ws + WS_ADA) + l * 49152; (void)ar; (void)H; (void)adal;
          pg8::Gemm g{H, nullptr, nullptr, 0, (const bf16*)(ws + (l ? WS_WG1 : WS_WG0)), M, 3072, 1024};
          BranchOrder S; S.init(M, G, bx);
          EpiGate E{(bf16*)(ar + AR_P)};
          pg8::gemm_phase<EpiGate, BranchOrder, true, true>(lds, g, S, E); }
        GSYNC();
        if (PHM & 1024) { const ArgsP a = launder(ak); const int G = opq_gdim(), bx = opq_bid(); unsigned char* ws = a->ws; unsigned char* ar = ws + WS_AR; bf16* H = (bf16*)(ws + WS_H); const float* adal = (const float*)(ws + WS_ADA) + l * 49152; (void)ar; (void)H; (void)adal;
          pg8::Gemm g{(const bf16*)(ar + AR_P), nullptr, nullptr, 0, (const bf16*)(ws + (l ? WS_WOUT1 : WS_WOUT0)), M, 1024, 1024, 3072};
          pg8::StaticOrder S; S.init(M, g.N, G, bx);
          EpiRes E{l ? (const float*)a->out : a->in[0], a->out, adal + 2 * 1024};
          pg8::gemm_phase<EpiRes, pg8::StaticOrder, true, true>(lds, g, S, E); }
        GSYNC();
        if (PHM & 2048) { const ArgsP a = launder(ak); const float* adal = (const float*)(a->ws + WS_ADA) + l * 49152;
          ln_phase(a->out, (bf16*)(a->ws + WS_H), a->in[30] + l * 1024, a->in[31] + l * 1024, adal + 3 * 1024, adal + 4 * 1024, true); }
        GSYNC();
        if (PHM & 4096) { const ArgsP a = launder(ak); const int G = opq_gdim(), bx = opq_bid(); unsigned char* ws = a->ws; unsigned char* ar = ws + WS_AR; bf16* H = (bf16*)(ws + WS_H); const float* adal = (const float*)(ws + WS_ADA) + l * 49152; (void)ar; (void)H; (void)adal;
          pg8::Gemm g{H, nullptr, nullptr, 0, (const bf16*)(ws + (l ? WS_W1_1 : WS_W1_0)), M, 4096, 1024};
          pg8::StaticOrder S; S.init(M, g.N, G, bx);
          EpiBf<1> E{(bf16*)(ar + AR_HID), 4096};
          pg8::gemm_phase<EpiBf<1>, pg8::StaticOrder, true, true>(lds, g, S, E); }
        GSYNC();
        if (PHM & 8192) { const ArgsP a = launder(ak); const int G = opq_gdim(), bx = opq_bid(); unsigned char* ws = a->ws; unsigned char* ar = ws + WS_AR; bf16* H = (bf16*)(ws + WS_H); const float* adal = (const float*)(ws + WS_ADA) + l * 49152; (void)ar; (void)H; (void)adal;
          pg8::Gemm g{(const bf16*)(ar + AR_HID), nullptr, nullptr, 0, (const bf16*)(ws + (l ? WS_W2_1 : WS_W2_0)), M, 1024, 4096};
          pg8::StaticOrder S; S.init(M, g.N, G, bx);
          EpiRes E{a->out, a->out, adal + 5 * 1024};
          pg8::gemm_phase<EpiRes, pg8::StaticOrder, true, true>(lds, g, S, E); }
        GSYNC();
        if (PHM & 16384) { const ArgsP a = launder(ak); const float* ada1 = (const float*)(a->ws + WS_ADA) + 49152;
          ln_phase(a->out, (bf16*)(a->ws + WS_H), a->in[34] + l * 1024, a->in[35] + l * 1024, ada1, ada1 + 1024, l == 0); }
        if (l == 0) GSYNC();
    }
}

extern "C" void kernel_launch(void* const* d_in, const int* in_sizes, int n_in, void* d_out, int out_size, void* d_ws, size_t ws_size, hipStream_t stream) {
    static int grid = 0;
    if (grid == 0) {
        if (n_in != 36 || out_size != M * D || ws_size < WS_END) { fprintf(stderr, "kernel_launch: unexpected shapes (n_in %d, out %d, ws %zu)\n", n_in, out_size, ws_size); grid = -1; return; }
        int dev = 0, cus = 0, per_cu = 0;
        hipGetDevice(&dev); hipDeviceGetAttribute(&cus, hipDeviceAttributeMultiprocessorCount, dev);
        hipFuncSetAttribute((const void*)fwd_kernel, hipFuncAttributeMaxDynamicSharedMemorySize, LDS_BYTES);
        hipOccupancyMaxActiveBlocksPerMultiprocessor(&per_cu, (const void*)fwd_kernel, 512, LDS_BYTES);
        (void)hipGetLastError();
        if (per_cu < 1) per_cu = 1;
        grid = cus;
        if (grid > 256) grid = 256;
    }
    if (grid < 0) return;
    if (hipMemsetAsync(d_ws, 0, 65536, stream) != hipSuccess) { fprintf(stderr, "kernel_launch: memset failed\n"); return; }
    Args ha{};
    for (int i = 0; i < 36; ++i) ha.in[i] = (const float*)d_in[i];
    ha.out = (float*)d_out; ha.ws = (unsigned char*)d_ws;
    void* params[] = {&ha};
    hipError_t e = hipLaunchCooperativeKernel((const void*)fwd_kernel, dim3(grid), dim3(512), params, LDS_BYTES, stream);
    if (e != hipSuccess) fprintf(stderr, "cooperative launch failed: %s (grid %d)\n", hipGetErrorString(e), grid);
}
```

```cpp
#include <hip/hip_runtime.h>
#include <hip/hip_cooperative_groups.h>
#include <cstdio>
#include <cstdint>
namespace cg = cooperative_groups;
__device__ __forceinline__ int opq_tid() { int t = threadIdx.x; asm volatile("" : "+v"(t)); return t; }
__device__ __forceinline__ int opq_bid() { int t = blockIdx.x; asm volatile("" : "+s"(t)); return t; }
__device__ __forceinline__ int opq_gdim() { int t = gridDim.x; asm volatile("" : "+s"(t)); return t; }
#ifndef DUPM
#define DUPM 0
#endif
#ifndef PHM
#define PHM 0x7fff
#endif
#ifndef TPROBE
#define TPROBE 0
#endif
#ifndef TMASK
#define TMASK 0
#endif
namespace pg8 {
#define PG8_LAS __attribute__((address_space(3)))
typedef unsigned short bf16_t;
typedef short bf16x8 __attribute__((ext_vector_type(8)));
typedef float f32x4 __attribute__((ext_vector_type(4)));
typedef unsigned u32x4 __attribute__((ext_vector_type(4)));
constexpr int BM = 256, BK = 64, HALF = 128, HTB = HALF * BK * 2  , STAGE_BYTES = 8 * HTB, NXCD = 8, WGM = 8;

__host__ __device__ __forceinline__ int lds_byte(int r, int c) { const int st = (r >> 4) * 2 + (c >> 5), rr = r & 15, cc = c & 31, ob = rr * 64 + cc * 2; return st * 1024 + (ob ^ (((ob >> 9) & 1) << 5)); }
__host__ __device__ __forceinline__ void stage_rc(int b, int& R, int& C) { const int st = b / 1024, sb = b % 1024, swz = sb ^ (((sb >> 9) & 1) << 5); R = (st >> 1) * 16 + swz / 64; C = (st & 1) * 32 + (swz % 64) / 2; }
__host__ __device__ __forceinline__ int perm32(int rho) { const int n = rho >> 4, i = rho & 15; return 8 * (i >> 2) + 4 * n + (i & 3); }

struct Unit { int pm, pn; };
struct Gemm { const bf16_t* A; const bf16_t* A1; const bf16_t* A2; int segt; const bf16_t* Bt; int M, N, K; int lda;
    __device__ __forceinline__ const bf16_t* a_of(int pn) const { return segt == 0 ? A : (pn < segt ? A : (pn < 2 * segt ? A1 : A2)); } };

struct StaticOrder {
    int nM, nN, nwg, G, c;
    __host__ __device__ void init(int M, int N, int G_, int c_) { nM = M / BM; nN = N / BM; nwg = nM * nN; G = G_; c = c_; }
    __host__ __device__ bool next(int i, Unit& u) const {
        const long L = (long)i * G + c; if (L >= nwg) return false;
        int wgid = (int)L; { const int q = nwg / NXCD, r = nwg % NXCD, xcd = wgid % NXCD, off = wgid / NXCD; wgid = (xcd < r ? xcd * (q + 1) : r * (q + 1) + (xcd - r) * q) + off; }
        const int nig = WGM * nN, gid = wgid / nig, fm = gid * WGM, gsz = (nM - fm) < WGM ? (nM - fm) : WGM;
        u.pm = fm + ((wgid % nig) % gsz); u.pn = (wgid % nig) / gsz; return true;
    }
    __device__ __forceinline__ void a_ready(const Unit&) const {}
    __device__ __forceinline__ void done(const Unit&) const {}
};
__device__ __forceinline__ unsigned cvt_pk_bf16(float lo, float hi) { unsigned r; asm volatile("v_cvt_pk_bf16_f32 %0, %1, %2" : "=v"(r) : "v"(lo), "v"(hi)); return r; }
template <class Epi, class Sched, bool ALIGN_EPI = false, bool SP2 = false>
__device__ __forceinline__ void gemm_phase(PG8_LAS unsigned char* lds, const Gemm g, const Sched& S, const Epi& E) {
    const int tid = opq_tid(), wid = __builtin_amdgcn_readfirstlane(tid >> 6), lane = tid & 63, wr = wid >> 2, wc = wid & 3, fr = lane & 15, fq = lane >> 4;
    const int K = g.K, nt = K / BK, LDA = g.lda ? g.lda : g.K;
    unsigned voffA[2], voffB[2];
#pragma unroll
    for (int i = 0; i < 2; ++i) { int R, C; stage_rc(tid * 16 + i * 8192, R, C); const int Rb = Epi::PERM ? ((R & ~31) + perm32(R & 31)) : R;
        voffA[i] = (unsigned)(R * LDA + C) * 2u; voffB[i] = (unsigned)(Rb * K + C) * 2u; }
    const size_t kstep = (size_t)(BK * 2);
    const size_t hstep = (size_t)HALF * K * 2;
    const size_t tstep = 2 * hstep;
    const size_t hstepA = (size_t)HALF * LDA * 2, tstepA = 2 * hstepA;
    const unsigned ldsw = (unsigned)wid * 1024u;
    const int aoff = lds_byte(wr * 64 + fr, fq * 8), boff = lds_byte(wc * 32 + fr, fq * 8);
#define PG8_SA(b, h) (((b) * 2 + (h)) * HTB)
#define PG8_SB(b, h) ((4 + (b) * 2 + (h)) * HTB)
#define PG8_STAGE(bufoff, gbase, voff) do { _Pragma("unroll") for (int _i = 0; _i < 2; ++_i) \
        __builtin_amdgcn_global_load_lds((const unsigned*)((const char*)(gbase) + (voff)[_i]), (PG8_LAS unsigned*)(lds + (bufoff) + ldsw + _i * 8192), 16, 0, 0); } while (0)
#define PG8_LDA(dst, b, h) do { _Pragma("unroll") for (int m = 0; m < 4; ++m) _Pragma("unroll") for (int k = 0; k < 2; ++k) dst[m][k] = *(const PG8_LAS bf16x8*)(lds + PG8_SA(b, h) + aoff + m * 2048 + k * 1024); } while (0)
#define PG8_LDB(dst, b, h) do { _Pragma("unroll") for (int n = 0; n < 2; ++n) _Pragma("unroll") for (int k = 0; k < 2; ++k) dst[n][k] = *(const PG8_LAS bf16x8*)(lds + PG8_SB(b, h) + boff + n * 2048 + k * 1024); } while (0)
#define PG8_MMA(ai, bj, At, Bt) do { __builtin_amdgcn_s_setprio(1); _Pragma("unroll") for (int m = 0; m < 4; ++m) _Pragma("unroll") for (int n = 0; n < 2; ++n) _Pragma("unroll") for (int k = 0; k < 2; ++k) \
        acc[ai][bj][m][n] = __builtin_amdgcn_mfma_f32_16x16x32_bf16(Bt[n][k], At[m][k], acc[ai][bj][m][n], 0, 0, 0); __builtin_amdgcn_s_setprio(0); } while (0)
#define PG8_WAIT_V(n) asm volatile("s_waitcnt vmcnt(" #n ")" ::: "memory")
#define PG8_WAIT_L(n) asm volatile("s_waitcnt lgkmcnt(" #n ")" ::: "memory")
#define PG8_BAR __builtin_amdgcn_s_barrier()
#define PG8_SCHED __builtin_amdgcn_sched_barrier(0)
    Unit cur, nxt; int ui = 0;
    if (!S.next(0, cur)) return;
    f32x4 acc[2][2][4][2];
#pragma unroll
    for (int a = 0; a < 2; ++a)
#pragma unroll
        for (int b = 0; b < 2; ++b)
#pragma unroll
            for (int m = 0; m < 4; ++m)
#pragma unroll
                for (int n = 0; n < 2; ++n) acc[a][b][m][n] = (f32x4){0.f, 0.f, 0.f, 0.f};
    bf16x8 At[4][2], B0[2][2], B1[2][2];
    const char* cA = (const char*)g.a_of(cur.pn) + (size_t)cur.pm * tstepA; const char* cB = (const char*)g.Bt + (size_t)cur.pn * tstep;
    S.a_ready(cur);
    if constexpr (SP2) {
        PG8_STAGE(PG8_SB(0, 0), cB, voffB); PG8_STAGE(PG8_SB(0, 1), cB + hstep, voffB); PG8_STAGE(PG8_SA(0, 0), cA, voffA); PG8_STAGE(PG8_SA(0, 1), cA + hstepA, voffA);
        if (wr == 1) PG8_BAR;
        PG8_WAIT_V(2); PG8_BAR;
        PG8_STAGE(PG8_SB(1, 0), cB + kstep, voffB); PG8_STAGE(PG8_SA(1, 0), cA + kstep, voffA); PG8_STAGE(PG8_SB(1, 1), cB + hstep + kstep, voffB);
        PG8_WAIT_V(6); PG8_BAR;
    } else {
        PG8_STAGE(PG8_SB(0, 0), cB, voffB); PG8_STAGE(PG8_SA(0, 0), cA, voffA); PG8_STAGE(PG8_SB(0, 1), cB + hstep, voffB); PG8_STAGE(PG8_SA(0, 1), cA + hstepA, voffA);
        if (wr == 1) PG8_BAR;
        PG8_WAIT_V(4); PG8_BAR;
        PG8_STAGE(PG8_SB(1, 0), cB + kstep, voffB); PG8_STAGE(PG8_SA(1, 0), cA + kstep, voffA); PG8_STAGE(PG8_SB(1, 1), cB + hstep + kstep, voffB);
        PG8_WAIT_V(6); PG8_BAR;
    }
    for (;;) {
        const bool has_next = S.next(ui + 1, nxt);
        const char* nA = has_next ? (const char*)g.a_of(nxt.pn) + (size_t)nxt.pm * tstepA : cA; const char* nB = has_next ? (const char*)g.Bt + (size_t)nxt.pn * tstep : cB;
        for (int t = 0; t < nt; t += 2) {
            const bool last = (t == nt - 2);
            const char* a1 = cA + (size_t)(t + 1) * kstep;
            const char* a2 = last ? nA : cA + (size_t)(t + 2) * kstep; const char* b2 = last ? nB : cB + (size_t)(t + 2) * kstep;
            const char* a3 = a2 + kstep; const char* b3 = b2 + kstep;
            if (last && has_next) S.a_ready(nxt);
            if constexpr (SP2) {
            PG8_LDB(B0, 0, 0); PG8_LDB(B1, 0, 1); PG8_SCHED; PG8_LDA(At, 0, 0); PG8_STAGE(PG8_SA(1, 1), a1 + hstepA, voffA);
            PG8_WAIT_V(8); PG8_WAIT_L(0); PG8_BAR; PG8_MMA(0, 0, At, B0); PG8_MMA(0, 1, At, B1); PG8_BAR; PG8_SCHED;
            PG8_LDA(At, 0, 1); PG8_STAGE(PG8_SB(0, 0), b2, voffB); PG8_STAGE(PG8_SB(0, 1), b2 + hstep, voffB); PG8_STAGE(PG8_SA(0, 0), a2, voffA);
            PG8_WAIT_V(8); PG8_WAIT_L(0); PG8_BAR; PG8_MMA(1, 0, At, B0); PG8_MMA(1, 1, At, B1); PG8_BAR; PG8_SCHED;
            PG8_LDB(B0, 1, 0); PG8_LDB(B1, 1, 1); PG8_SCHED; PG8_LDA(At, 1, 0); PG8_STAGE(PG8_SA(0, 1), a2 + hstepA, voffA);
            PG8_WAIT_V(8); PG8_WAIT_L(0); PG8_BAR; PG8_MMA(0, 0, At, B0); PG8_MMA(0, 1, At, B1); PG8_BAR; PG8_SCHED;
            PG8_LDA(At, 1, 1); PG8_STAGE(PG8_SB(1, 0), b3, voffB); PG8_STAGE(PG8_SB(1, 1), b3 + hstep, voffB); PG8_STAGE(PG8_SA(1, 0), a3, voffA);
            PG8_WAIT_V(8); PG8_WAIT_L(0); PG8_BAR; PG8_MMA(1, 0, At, B0); PG8_MMA(1, 1, At, B1); PG8_BAR; PG8_SCHED;
            } else {
            PG8_LDB(B0, 0, 0); PG8_SCHED; PG8_LDA(At, 0, 0); PG8_STAGE(PG8_SA(1, 1), a1 + hstepA, voffA);
            PG8_WAIT_L(8); PG8_BAR; PG8_WAIT_L(0); PG8_MMA(0, 0, At, B0); PG8_BAR; PG8_SCHED;
            PG8_LDB(B1, 0, 1); PG8_STAGE(PG8_SB(0, 0), b2, voffB);
            PG8_BAR; PG8_WAIT_L(0); PG8_MMA(0, 1, At, B1); PG8_BAR;
            PG8_LDA(At, 0, 1); PG8_STAGE(PG8_SA(0, 0), a2, voffA);
            PG8_BAR; PG8_WAIT_L(0); PG8_MMA(1, 0, At, B0); PG8_BAR; PG8_SCHED;
            PG8_STAGE(PG8_SB(0, 1), b2 + hstep, voffB);
            PG8_WAIT_V(6); PG8_BAR; PG8_MMA(1, 1, At, B1); PG8_BAR;
            PG8_LDB(B0, 1, 0); PG8_SCHED; PG8_LDA(At, 1, 0); PG8_STAGE(PG8_SA(0, 1), a2 + hstepA, voffA);
            PG8_WAIT_L(8); PG8_BAR; PG8_WAIT_L(0); PG8_MMA(0, 0, At, B0); PG8_BAR; PG8_SCHED;
            PG8_LDB(B1, 1, 1); PG8_STAGE(PG8_SB(1, 0), b3, voffB);
            PG8_BAR; PG8_WAIT_L(0); PG8_MMA(0, 1, At, B1); PG8_BAR;
            PG8_LDA(At, 1, 1); PG8_STAGE(PG8_SA(1, 0), a3, voffA);
            PG8_BAR; PG8_WAIT_L(0); PG8_MMA(1, 0, At, B0); PG8_BAR; PG8_SCHED;
            PG8_STAGE(PG8_SB(1, 1), b3 + hstep, voffB);
            PG8_WAIT_V(6); PG8_BAR; PG8_MMA(1, 1, At, B1); PG8_BAR;
            }
        }
        if constexpr (ALIGN_EPI) { if (wr == 0) PG8_BAR; }
        if constexpr (!Epi::AFTER_DRAIN) { E(acc, cur, wr, wc, fr, fq); S.done(cur); }
        if (!has_next) break;
#pragma unroll
        for (int a = 0; a < 2; ++a)
#pragma unroll
            for (int b = 0; b < 2; ++b)
#pragma unroll
                for (int m = 0; m < 4; ++m)
#pragma unroll
                    for (int n = 0; n < 2; ++n) acc[a][b][m][n] = (f32x4){0.f, 0.f, 0.f, 0.f};
        cur = nxt; cA = nA; cB = nB; ++ui;
        if constexpr (ALIGN_EPI) { if (wr == 1) PG8_BAR; }
    }
    PG8_WAIT_V(0);
    if constexpr (!ALIGN_EPI) { if (wr == 0) PG8_BAR; }
    PG8_BAR;
    if constexpr (Epi::AFTER_DRAIN) { E.fused(acc, cur, wr, wc, fr, fq, lds, wid, lane); S.done(cur); }
#undef PG8_SA
#undef PG8_SB
#undef PG8_STAGE
#undef PG8_LDA
#undef PG8_LDB
#undef PG8_MMA
#undef PG8_WAIT_V
#undef PG8_WAIT_L
#undef PG8_BAR
#undef PG8_SCHED
}
}

#define LAS __attribute__((address_space(3)))
typedef unsigned short bf16;
typedef pg8::f32x4 f32x4;
typedef pg8::u32x4 u32x4;
typedef unsigned u32x2 __attribute__((ext_vector_type(2)));
using pg8::Unit;

constexpr int M = 65536, D = 1024, SEQ = 8192;
constexpr float ALPHA = 1.4142135623730951f;
constexpr float LN_EPS = 1e-5f, GN_EPS = 64e-5f;
constexpr int LDS_BYTES = 147456;

constexpr size_t MiB = (size_t)1 << 20;
constexpr size_t WS_ADAP = 1 * MiB, WS_ADA = 4 * MiB, WS_WLORA0 = 5 * MiB, WS_WLORA1 = 6 * MiB, WS_WINA0 = 8 * MiB, WS_WINA1 = 15 * MiB,
    WS_WG0 = 22 * MiB, WS_WG1 = 28 * MiB, WS_WBR0 = 34 * MiB, WS_WBR1 = 37 * MiB, WS_WOUT0 = 40 * MiB, WS_WOUT1 = 42 * MiB,
    WS_W1_0 = 44 * MiB, WS_W1_1 = 52 * MiB, WS_W2_0 = 60 * MiB, WS_W2_1 = 68 * MiB, WS_VFIRST = 76 * MiB, WS_H = 140 * MiB, WS_AR = 268 * MiB;
constexpr size_t AR_ZR = 0, AR_CG = 224 * MiB, AR_PL = 288 * MiB, AR_LV = 352 * MiB, AR_LO = 224 * MiB, AR_YCV = 480 * MiB, AR_POOL = 544 * MiB,
    AR_YRW = 608 * MiB, AR_LA = 672 * MiB, AR_P = 0, AR_HID = 0;
constexpr size_t WS_END = WS_AR + 720 * MiB;

struct Args { const float* in[36]; float* out; unsigned char* ws; };
typedef const Args __attribute__((address_space(4)))* ArgsP;
__device__ __forceinline__ ArgsP launder(ArgsP p) { asm volatile("" : "+s"(p)); return p; }

#define XB_TMO      128
#define XB_XCNT(j)  (256  + 64 * (j))
#define XB_XSUB(j)  (1280 + 64 * (j))
#define XB_XGEN(j)  (2304 + 64 * (j))
#define XB_TOP      3328
#define XB_TOPGEN   3392
#define XCD_BAR_WORDS 3456
#define XB_SPIN_CAP (1u << 18)

__device__ __forceinline__ unsigned xb_ld(unsigned* p)              { return __hip_atomic_load(p, __ATOMIC_RELAXED, __HIP_MEMORY_SCOPE_AGENT); }
__device__ __forceinline__ unsigned xb_add(unsigned* p, unsigned v) { return __hip_atomic_fetch_add(p, v, __ATOMIC_RELAXED, __HIP_MEMORY_SCOPE_AGENT); }
__device__ __forceinline__ unsigned xb_xcc_id() { return (unsigned)__builtin_amdgcn_s_getreg((3 << 11) | 20) & 0xFu; }
#define XB_SPIN(cond, bar) do { unsigned _sp = 0; while (cond) { __builtin_amdgcn_s_sleep(1); \
    if ((++_sp & 255u) == 0u) { if (xb_ld(&(bar)[XB_TMO])) break; if (_sp > XB_SPIN_CAP) { atomicAdd(&(bar)[XB_TMO], 1u); break; } } } } while (0)

struct XcdBarrier {
    unsigned* bar; unsigned x;
    volatile LAS unsigned* st;
};

__device__ __forceinline__ XcdBarrier xcd_barrier_post(unsigned* bar, volatile LAS unsigned* st) {
    XcdBarrier b; b.bar = bar; b.x = xb_xcc_id(); b.st = st;
    if (threadIdx.x == 0) (void)xb_add(&bar[XB_XCNT(b.x)], 1u);
    return b;
}
__device__ __forceinline__ void xcd_barrier_complete(unsigned* bar, unsigned x, unsigned& nloc, unsigned& nx) {
    const unsigned G = gridDim.x * gridDim.y * gridDim.z;
    unsigned sum, cnt, mine, sp = 0u;
    for (;;) {
        sum = 0u; cnt = 0u; mine = 0u;
#pragma unroll
        for (unsigned j = 0; j < 16; ++j) { const unsigned c = xb_ld(&bar[XB_XCNT(j)]); sum += c; cnt += (c > 0u) ? 1u : 0u; mine = (j == x) ? c : mine; }
        if (sum == G) break;
        __builtin_amdgcn_s_sleep(1);
        if ((++sp & 255u) == 0u) { if (xb_ld(&bar[XB_TMO])) break; if (sp > XB_SPIN_CAP) { atomicAdd(&bar[XB_TMO], 1u); break; } }
    }
    nloc = mine > 0u ? mine : 1u; nx = cnt > 0u ? cnt : 1u;
}

__device__ __forceinline__ void xcd_barrier(const XcdBarrier& b) {
    asm volatile("s_waitcnt vmcnt(0)" ::: "memory");
    __syncthreads();
    if (threadIdx.x == 0) {
        unsigned* bar = b.bar;
        __builtin_amdgcn_s_waitcnt(0);
        unsigned nloc = b.st[0], nx = b.st[1];
        if (nloc == 0u) { xcd_barrier_complete(bar, b.x, nloc, nx); b.st[0] = nloc; b.st[1] = nx; }
        const unsigned old = xb_add(&bar[XB_XSUB(b.x)], 1u);
        const unsigned gen = old / nloc;
        if (old + 1u == (gen + 1u) * nloc) {
            __builtin_amdgcn_fence(__ATOMIC_RELEASE, "agent");
            asm volatile("s_waitcnt vmcnt(0)" ::: "memory");
            const unsigned og = xb_add(&bar[XB_TOP], 1u);
            const unsigned tg = og / nx;
            if (og + 1u == (tg + 1u) * nx) xb_add(&bar[XB_TOPGEN], 1u);
            else XB_SPIN(xb_ld(&bar[XB_TOPGEN]) == tg, bar);
            __builtin_amdgcn_fence(__ATOMIC_ACQUIRE, "agent");
            xb_add(&bar[XB_XGEN(b.x)], 1u);
            asm volatile("s_waitcnt vmcnt(0)" ::: "memory");
        } else {
            XB_SPIN(xb_ld(&bar[XB_XGEN(b.x)]) == gen, bar);
            __builtin_amdgcn_fence(__ATOMIC_ACQUIRE, "agent");
            asm volatile("s_waitcnt vmcnt(0)" ::: "memory");
        }
    }
    __syncthreads();
}
#define LDS_WAIT() asm volatile("s_waitcnt lgkmcnt(0)" ::: "memory")
__device__ __forceinline__ unsigned f2bf(float f) { unsigned u = __builtin_bit_cast(unsigned, f); return (u + 0x7fffu + ((u >> 16) & 1u)) >> 16; }
__device__ __forceinline__ unsigned pk2(float lo, float hi) { return pg8::cvt_pk_bf16(lo, hi); }
__device__ __forceinline__ float bflo(unsigned u) { return __uint_as_float(u << 16); }
__device__ __forceinline__ float bfhi(unsigned u) { return __uint_as_float(u & 0xffff0000u); }
__device__ __forceinline__ float bf1(unsigned short u) { return __uint_as_float(((unsigned)u) << 16); }
__device__ __forceinline__ float sigm(float x) { return __builtin_amdgcn_rcpf(1.f + __expf(-x)); }
__device__ __forceinline__ void unpack8(const u32x4 v, float (&o)[8]) { o[0] = bflo(v.x); o[1] = bfhi(v.x); o[2] = bflo(v.y); o[3] = bfhi(v.y); o[4] = bflo(v.z); o[5] = bfhi(v.z); o[6] = bflo(v.w); o[7] = bfhi(v.w); }
__device__ __forceinline__ u32x4 pack8(const float (&o)[8]) { u32x4 r; r.x = pk2(o[0], o[1]); r.y = pk2(o[2], o[3]); r.z = pk2(o[4], o[5]); r.w = pk2(o[6], o[7]); return r; }
__device__ __forceinline__ void load8f(const float* p, float (&o)[8]) { const f32x4 a = *(const f32x4*)p, b = *(const f32x4*)(p + 4); o[0] = a.x; o[1] = a.y; o[2] = a.z; o[3] = a.w; o[4] = b.x; o[5] = b.y; o[6] = b.z; o[7] = b.w; }
__device__ __forceinline__ float wave_sum(float v) {
#pragma unroll
    for (int o = 1; o < 64; o <<= 1) v += __shfl_xor(v, o);
    return v;
}
template <int CTRL> __device__ __forceinline__ float dppf(float x) { return __builtin_bit_cast(float, __builtin_amdgcn_update_dpp(0, __builtin_bit_cast(int, x), CTRL, 0xF, 0xF, true)); }
__device__ __forceinline__ float red4(float x) { x += dppf<0xB1>(x); x += dppf<0x4E>(x); return x; }
__device__ __forceinline__ float red8(float x) { x = red4(x); x += dppf<0x141>(x); return x; }
__device__ __forceinline__ float red16(float x) { x = red8(x); x += dppf<0x140>(x); return x; }

__device__ __forceinline__ void store8(bf16* p, const f32x4 v0, const f32x4 v1) {
    u32x4 w; w.x = pk2(v0[0], v0[1]); w.y = pk2(v0[2], v0[3]); w.z = pk2(v1[0], v1[1]); w.w = pk2(v1[2], v1[3]); *(u32x4*)p = w;
}
struct EpiG1 {
    static constexpr bool PERM = true, AFTER_DRAIN = false;
    bf16 *ZR, *CG, *PL, *LV;
    __device__ __forceinline__ void operator()(const f32x4 (&acc)[2][2][4][2], const Unit& u, int wr, int wc, int fr, int fq) const {
        const int row0 = u.pm * 256 + wr * 64 + fr, pn = u.pn, cin = wc * 32 + 8 * fq;
        if (pn < 7 || (pn >= 11 && pn < 13)) {
            bf16* base = pn < 7 ? ZR : PL; const int ldc = pn < 7 ? 1792 : 512, col0 = (pn < 7 ? pn : pn - 11) * 256 + cin;
#pragma unroll
            for (int ai = 0; ai < 2; ++ai)
#pragma unroll
                for (int m = 0; m < 4; ++m) { bf16* rp = base + (size_t)(row0 + ai * 128 + m * 16) * ldc + col0;
#pragma unroll
                    for (int bj = 0; bj < 2; ++bj) store8(rp + bj * 128, acc[ai][bj][m][0], acc[ai][bj][m][1]); }
        } else if (pn < 11) {
            const int col0 = (pn - 7) * 128 + cin;
#pragma unroll
            for (int ai = 0; ai < 2; ++ai)
#pragma unroll
                for (int m = 0; m < 4; ++m) { f32x4 h0, h1;
#pragma unroll
                    for (int i = 0; i < 4; ++i) { h0[i] = acc[ai][0][m][0][i] * sigm(acc[ai][1][m][0][i]); h1[i] = acc[ai][0][m][1][i] * sigm(acc[ai][1][m][1][i]); }
                    store8(CG + (size_t)(row0 + ai * 128 + m * 16) * 512 + col0, h0, h1); }
        } else {
            if (wc == 0) {
#pragma unroll
                for (int ai = 0; ai < 2; ++ai)
#pragma unroll
                    for (int m = 0; m < 4; ++m) store8(LV + (size_t)(row0 + ai * 128 + m * 16) * 32 + 8 * fq, acc[ai][0][m][0], acc[ai][0][m][1]);
            }
        }
    }
};
struct EpiLora {
    static constexpr bool PERM = true, AFTER_DRAIN = false;
    bf16* O; int ldc; const float *w0, *a0, *v0;
    __device__ __forceinline__ void operator()(const f32x4 (&acc)[2][2][4][2], const Unit& u, int wr, int wc, int fr, int fq) const {
        const int row0 = u.pm * 256 + wr * 64 + fr, type = u.pn >> 1, cin = wc * 32 + 8 * fq;
#pragma unroll
        for (int bj = 0; bj < 2; ++bj) {
            const int cb = u.pn * 256 + bj * 128 + cin, pc = cb & 511;
            f32x4 p0 = (f32x4){0.f, 0.f, 0.f, 0.f}, p1 = p0;
            if (type == 0) { p0 = *(const f32x4*)(w0 + pc); p1 = *(const f32x4*)(w0 + pc + 4); }
            else if (type == 1) { p0 = *(const f32x4*)(a0 + pc); p1 = *(const f32x4*)(a0 + pc + 4); }
            else if (type == 3) { p0 = *(const f32x4*)(v0 + pc); p1 = *(const f32x4*)(v0 + pc + 4); }
#pragma unroll
            for (int ai = 0; ai < 2; ++ai)
#pragma unroll
                for (int m = 0; m < 4; ++m) { f32x4 v0_ = acc[ai][bj][m][0] + p0, v1_ = acc[ai][bj][m][1] + p1;
                    if (type != 2) {
                        const float sc = type == 0 ? 0.60653065971f : 1.f;
#pragma unroll
                        for (int i = 0; i < 4; ++i) { v0_[i] = sc * sigm(v0_[i]); v1_[i] = sc * sigm(v1_[i]); } }
                    store8(O + (size_t)(row0 + ai * 128 + m * 16) * ldc + cb, v0_, v1_); }
        }
    }
};
template <int MODE  > struct EpiBf {
    static constexpr bool PERM = true, AFTER_DRAIN = false;
    bf16* O; int ldc;
    __device__ __forceinline__ void operator()(const f32x4 (&acc)[2][2][4][2], const Unit& u, int wr, int wc, int fr, int fq) const {
        const int row0 = u.pm * 256 + wr * 64 + fr, col0 = u.pn * 256 + wc * 32 + 8 * fq;
#pragma unroll
        for (int ai = 0; ai < 2; ++ai)
#pragma unroll
            for (int m = 0; m < 4; ++m) { bf16* rp = O + (size_t)(row0 + ai * 128 + m * 16) * ldc + col0;
#pragma unroll
                for (int bj = 0; bj < 2; ++bj) { f32x4 v0 = acc[ai][bj][m][0], v1 = acc[ai][bj][m][1];
                    if (MODE == 1) {
#pragma unroll
                        for (int i = 0; i < 4; ++i) { const float a = fmaxf(v0[i], 0.f), b = fmaxf(v1[i], 0.f); v0[i] = a * a; v1[i] = b * b; } }
                    if (MODE == 2) { float p[8]; unpack8(*(const u32x4*)(rp + bj * 128), p);
#pragma unroll
                        for (int i = 0; i < 4; ++i) { v0[i] = sigm(v0[i]) * p[i]; v1[i] = sigm(v1[i]) * p[4 + i]; } }
                    store8(rp + bj * 128, v0, v1); } }
    }
};
struct BranchOrder {
    pg8::StaticOrder S;
    __device__ void init(int M_, int G_, int c_) { S.init(M_, 1024, G_, c_); }
    __device__ bool next(int i, Unit& u) const { const int base = i / 3, br = i - 3 * base; Unit t; if (!S.next(base, t)) return false; u.pm = t.pm; u.pn = br * 4 + t.pn; return true; }
    __device__ __forceinline__ void a_ready(const Unit&) const {}
    __device__ __forceinline__ void done(const Unit&) const {}
};
struct EpiGate {
    static constexpr bool PERM = true, AFTER_DRAIN = false;
    bf16* P;
    __device__ __forceinline__ void operator()(const f32x4 (&acc)[2][2][4][2], const Unit& u, int wr, int wc, int fr, int fq) const {
        const int row0 = u.pm * 256 + wr * 64 + fr, br = u.pn >> 2, cown = u.pn * 256 + wc * 32 + 8 * fq, cslot = (u.pn & 3) * 256 + wc * 32 + 8 * fq;
#pragma unroll
        for (int ai = 0; ai < 2; ++ai)
#pragma unroll
            for (int m = 0; m < 4; ++m) { bf16* rp = P + (size_t)(row0 + ai * 128 + m * 16) * 3072;
#pragma unroll
                for (int bj = 0; bj < 2; ++bj) { f32x4 v0 = acc[ai][bj][m][0], v1 = acc[ai][bj][m][1]; float p[8]; unpack8(*(const u32x4*)(rp + cown + bj * 128), p);
#pragma unroll
                    for (int i = 0; i < 4; ++i) { v0[i] = sigm(v0[i]) * p[i]; v1[i] = sigm(v1[i]) * p[4 + i]; }
                    if (br > 0) { float q[8]; unpack8(*(const u32x4*)(rp + cslot + bj * 128), q);
#pragma unroll
                        for (int i = 0; i < 4; ++i) { v0[i] += q[i]; v1[i] += q[4 + i]; } }
                    store8(rp + cslot + bj * 128, v0, v1); } }
    }
};
struct EpiRes {
    static constexpr bool PERM = false, AFTER_DRAIN = false;
    const float* xin; float* out; const float* gt;
    __device__ __forceinline__ void operator()(const f32x4 (&acc)[2][2][4][2], const Unit& u, int wr, int wc, int fr, int fq) const {
        const float* gtb = gt + (size_t)(u.pm >> 5) * 6144; const int col0 = u.pn * 256 + wc * 32 + 4 * fq;
        f32x4 g4[2][2];
#pragma unroll
        for (int bj = 0; bj < 2; ++bj)
#pragma unroll
            for (int n = 0; n < 2; ++n) g4[bj][n] = *(const f32x4*)(gtb + col0 + bj * 128 + n * 16);
#pragma unroll
        for (int ai = 0; ai < 2; ++ai)
#pragma unroll
            for (int m = 0; m < 4; ++m) { const size_t off = (size_t)(u.pm * 256 + ai * 128 + wr * 64 + m * 16 + fr) * 1024 + col0;
#pragma unroll
                for (int bj = 0; bj < 2; ++bj)
#pragma unroll
                    for (int n = 0; n < 2; ++n) { const f32x4 x4 = *(const f32x4*)(xin + off + bj * 128 + n * 16);
                        *(f32x4*)(out + off + bj * 128 + n * 16) = x4 * ALPHA + g4[bj][n] * acc[ai][bj][m][n]; } }
    }
};

__device__ __forceinline__ void tr_item(const float* W, int N, int k0, int n0, bf16* dst, int K, LAS float* scr, int lane) {
#pragma unroll 8
    for (int i = 0; i < 32; ++i) { const int kk = 2 * i + (lane >> 5); scr[kk * 33 + (lane & 31)] = W[(size_t)(k0 + kk) * N + n0 + (lane & 31)]; }
    LDS_WAIT(); asm volatile("" ::: "memory");
    const int c = lane & 7;
#pragma unroll
    for (int j = 0; j < 4; ++j) { const int n = (lane >> 3) + 8 * j; const LAS float* s = scr + (8 * c) * 33 + n;
        u32x4 o; o.x = pk2(s[0 * 33], s[1 * 33]); o.y = pk2(s[2 * 33], s[3 * 33]); o.z = pk2(s[4 * 33], s[5 * 33]); o.w = pk2(s[6 * 33], s[7 * 33]);
        *(u32x4*)(dst + (size_t)n * K + 8 * c) = o; }
    LDS_WAIT(); asm volatile("" ::: "memory");
}
__device__ __forceinline__ bf16* win_dst(unsigned char* ws, int l, int n0) {
    bf16* wina = (bf16*)(ws + (l ? WS_WINA1 : WS_WINA0)); bf16* wg = (bf16*)(ws + (l ? WS_WG1 : WS_WG0));
    if (n0 < 1792) return wina + (size_t)n0 * 1024;
    if (n0 < 2816) { const int c = n0 - 1792, half = c >> 9, cc = c & 511, j = cc >> 7, i = cc & 127; return wina + (size_t)(1792 + j * 256 + half * 128 + i) * 1024; }
    if (n0 < 3328) return wina + (size_t)n0 * 1024;
    return wg + (size_t)(n0 - 3328) * 1024;
}
__device__ __forceinline__ void p0_phase(ArgsP a_, LAS unsigned char* lds) {
    const ArgsP a = launder(a_);
    const int tid = opq_tid(), lane = tid & 63, wave = tid >> 6, G = opq_gdim();
    const int gw = opq_bid() * 8 + wave, NGW = G * 8, gt = opq_bid() * 512 + tid, NT = G * 512;
    unsigned char* ws = a->ws;
    LAS float* scr = (LAS float*)(lds + wave * 8448);
    for (int it = gw; it < 16656; it += NGW) {
        int r = it;
        if (r >= 16640) { const int kb = r - 16640; tr_item(a->in[5], 32, 64 * kb, 0, (bf16*)(ws + WS_WINA1) + (size_t)3328 * 1024 + 64 * kb, 1024, scr, lane); continue; }
        const int l = r >= 8320 ? 1 : 0; r -= l * 8320;
        if (r < 3200) { const int kb = r / 200, nb = r % 200; tr_item(a->in[4] + (size_t)l * 1024 * 6400, 6400, 64 * kb, 32 * nb, win_dst(ws, l, 32 * nb) + 64 * kb, 1024, scr, lane); continue; } r -= 3200;
        bf16* wbr = (bf16*)(ws + (l ? WS_WBR1 : WS_WBR0));
        if (r < 256) { const int kb = r >> 5, nb = r & 31; tr_item(a->in[20] + (size_t)l * 512 * 1024, 1024, 64 * kb, 32 * nb, wbr + (size_t)(32 * nb) * 512 + 64 * kb, 512, scr, lane); continue; } r -= 256;
        if (r < 256) { const int kb = r >> 5, nb = r & 31; tr_item(a->in[25] + (size_t)l * 512 * 1024, 1024, 64 * kb, 32 * nb, wbr + (size_t)(1024 + 32 * nb) * 512 + 64 * kb, 512, scr, lane); continue; } r -= 256;
        if (r < 512) { const int kb = r >> 5, nb = r & 31; tr_item(a->in[29] + (size_t)l * 1024 * 1024, 1024, 64 * kb, 32 * nb, (bf16*)(ws + (l ? WS_WOUT1 : WS_WOUT0)) + (size_t)(32 * nb) * 1024 + 64 * kb, 1024, scr, lane); continue; } r -= 512;
        if (r < 2048) { const int kb = r >> 7, nb = r & 127; tr_item(a->in[32] + (size_t)l * 1024 * 4096, 4096, 64 * kb, 32 * nb, (bf16*)(ws + (l ? WS_W1_1 : WS_W1_0)) + (size_t)(32 * nb) * 1024 + 64 * kb, 1024, scr, lane); continue; } r -= 2048;
        { const int kb = r >> 5, nb = r & 31; tr_item(a->in[33] + (size_t)l * 4096 * 1024, 1024, 64 * kb, 32 * nb, (bf16*)(ws + (l ? WS_W2_1 : WS_W2_0)) + (size_t)(32 * nb) * 4096 + 64 * kb, 4096, scr, lane); }
    }
    { u32x4* z = (u32x4*)((bf16*)(ws + WS_WINA1) + (size_t)3360 * 1024); for (int i = gt; i < 28672; i += NT) z[i] = (u32x4){0u, 0u, 0u, 0u}; }
    { bf16* w = (bf16*)(ws + WS_WLORA0);
      for (int i = gt; i < 1536 * 256; i += NT) { const int n = i >> 8, k = i & 255; float v = 0.f;
          if (n < 512) { if (k < 64) v = a->in[9][k * 512 + n]; }
          else if (n < 1024) { if (k >= 64 && k < 128) v = a->in[11][(k - 64) * 512 + n - 512]; }
          else { if (k >= 128) v = a->in[12][(k - 128) * 512 + n - 1024]; }
          w[i] = (bf16)f2bf(v); } }
    { bf16* w = (bf16*)(ws + WS_WLORA1);
      for (int i = gt; i < 2048 * 384; i += NT) { const int n = i / 384, k = i % 384; float v = 0.f;
          if (n < 512) { if (k < 64) v = a->in[9][64 * 512 + k * 512 + n]; }
          else if (n < 1024) { if (k >= 64 && k < 128) v = a->in[11][64 * 512 + (k - 64) * 512 + n - 512]; }
          else if (n < 1536) { if (k >= 128 && k < 256) v = a->in[12][128 * 512 + (k - 128) * 512 + n - 1024]; }
          else { if (k >= 256 && k < 288) v = a->in[14][(k - 256) * 512 + n - 1536]; }
          w[i] = (bf16)f2bf(v); } }
    for (int idx = gt; idx < 131072; idx += NT) {
        const int n = idx & 1023, cg8 = (idx >> 10) & 63, l = idx >> 16, g = cg8 >> 4, c0 = (cg8 & 15) * 8;
        const float* plw = a->in[26] + ((size_t)(l * 4 + g) * 128 + c0) * 128; const float* pls = a->in[27] + l * 512 + g * 128; const float* plo = a->in[28] + ((size_t)l * 512 + g * 128) * 1024 + n;
        float acc[8];
#pragma unroll
        for (int i = 0; i < 8; ++i) acc[i] = 0.f;
#pragma unroll 8
        for (int d = 0; d < 128; ++d) { const float bw = plo[(size_t)d * 1024] * pls[d];
#pragma unroll
            for (int i = 0; i < 8; ++i) acc[i] += plw[i * 128 + d] * bw; }
        bf16* wbr = (bf16*)(ws + (l ? WS_WBR1 : WS_WBR0));
        *(u32x4*)(wbr + (size_t)(2048 + n) * 512 + g * 128 + c0) = pack8(acc);
    }
    float* adap = (float*)(ws + WS_ADAP);
    for (int wt = gw; wt < 1536; wt += NGW) {
        const int l = wt / 768, r = wt % 768, cb = r >> 3, kc = r & 7, col = cb * 64 + lane;
#pragma unroll
        for (int i = 0; i < 16; ++i) { const int idx = lane + 64 * i, b = idx >> 7, kk = idx & 127; const float x = a->in[1][b * 1024 + kc * 128 + kk]; scr[idx] = x * sigm(x); }
        LDS_WAIT(); asm volatile("" ::: "memory");
        float acc[8];
#pragma unroll
        for (int b = 0; b < 8; ++b) acc[b] = 0.f;
        const float* wp = a->in[2] + ((size_t)l * 1024 + kc * 128) * 6144 + col;
#pragma unroll 4
        for (int kk = 0; kk < 128; ++kk) { const float w = wp[(size_t)kk * 6144];
#pragma unroll
            for (int b = 0; b < 8; ++b) acc[b] += scr[b * 128 + kk] * w; }
#pragma unroll
        for (int b = 0; b < 8; ++b) adap[((size_t)(l * 8 + kc) * 8 + b) * 6144 + col] = acc[b];
        LDS_WAIT(); asm volatile("" ::: "memory");
    }
}
__device__ __forceinline__ void p0b_phase(ArgsP a_) {
    const ArgsP a = launder(a_);
    const int tid = opq_tid(), lane = tid & 63, wave = tid >> 6, G = opq_gdim();
    const int gw = opq_bid() * 8 + wave, NGW = G * 8, gt = opq_bid() * 512 + tid, NT = G * 512;
    const float* adap = (const float*)(a->ws + WS_ADAP); float* ada = (float*)(a->ws + WS_ADA);
    for (int i = gt; i < 2 * 49152; i += NT) { const int l = i / 49152, r = i % 49152, col = r % 6144; float s = a->in[3][l * 6144 + col];
#pragma unroll
        for (int kc = 0; kc < 8; ++kc) s += adap[(size_t)(l * 8 + kc) * 49152 + r];
        ada[i] = s; }
    bf16* H = (bf16*)(a->ws + WS_H);
    for (int rb = gw; rb < 2048; rb += NGW) {
        const int b = rb >> 8; f32x4 sh[4], sc[4];
#pragma unroll
        for (int j = 0; j < 4; ++j) { const int col = 4 * lane + 256 * j; f32x4 s0 = *(const f32x4*)(a->in[3] + col), s1 = *(const f32x4*)(a->in[3] + 1024 + col);
#pragma unroll
            for (int kc = 0; kc < 8; ++kc) { s0 += *(const f32x4*)(adap + (size_t)kc * 49152 + b * 6144 + col); s1 += *(const f32x4*)(adap + (size_t)kc * 49152 + b * 6144 + 1024 + col); }
            sh[j] = s0; sc[j] = s1 + 1.f; }
        for (int rr = 0; rr < 32; ++rr) { const size_t m = (size_t)rb * 32 + rr;
#pragma unroll
            for (int j = 0; j < 4; ++j) { const int col = 4 * lane + 256 * j; const f32x4 x = *(const f32x4*)(a->in[0] + m * 1024 + col); const f32x4 h = x * sc[j] + sh[j];
                u32x2 w; w.x = pk2(h[0], h[1]); w.y = pk2(h[2], h[3]); *(u32x2*)(H + m * 1024 + col) = w; } }
    }
}
__device__ __forceinline__ void ln_phase(float* X, bf16* H, const float* gam, const float* bet, const float* adash  , const float* adasc, bool writeH) {
    const int tid = opq_tid(), lane = tid & 63, wave = tid >> 6, gw = opq_bid() * 8 + wave, NGW = opq_gdim() * 8;
    for (int rb = gw; rb < 2048; rb += NGW) {
        const int b = rb >> 8; f32x4 g4[4], b4[4], sh[4], sc[4];
#pragma unroll
        for (int j = 0; j < 4; ++j) { const int col = 4 * lane + 256 * j; g4[j] = *(const f32x4*)(gam + col); b4[j] = *(const f32x4*)(bet + col);
            if (writeH) { sh[j] = *(const f32x4*)(adash + b * 6144 + col); sc[j] = *(const f32x4*)(adasc + b * 6144 + col) + 1.f; } else { sh[j] = g4[j]; sc[j] = g4[j]; } }
        for (int rr = 0; rr < 32; ++rr) { const size_t m = (size_t)rb * 32 + rr; f32x4 v[4]; float s = 0.f;
#pragma unroll
            for (int j = 0; j < 4; ++j) { v[j] = *(const f32x4*)(X + m * 1024 + 4 * lane + 256 * j); s += (v[j][0] + v[j][1]) + (v[j][2] + v[j][3]); }
            const float mean = wave_sum(s) * (1.f / 1024.f); float q = 0.f;
#pragma unroll
            for (int j = 0; j < 4; ++j) { v[j] = v[j] - mean; q += (v[j][0] * v[j][0] + v[j][1] * v[j][1]) + (v[j][2] * v[j][2] + v[j][3] * v[j][3]); }
            const float rstd = 1.0f / sqrtf(wave_sum(q) * (1.f / 1024.f) + LN_EPS);
#pragma unroll
            for (int j = 0; j < 4; ++j) { const int col = 4 * lane + 256 * j; const f32x4 y = v[j] * rstd * g4[j] + b4[j]; *(f32x4*)(X + m * 1024 + col) = y;
                if (writeH) { const f32x4 h = y * sc[j] + sh[j]; u32x2 w; w.x = pk2(h[0], h[1]); w.y = pk2(h[2], h[3]); *(u32x2*)(H + m * 1024 + col) = w; } } }
    }
}
__device__ __forceinline__ void prep_phase(ArgsP a_, int l, LAS unsigned char* lds) {
    const ArgsP a = launder(a_);
    const int tid = opq_tid(), lane = tid & 63, wave = tid >> 6, gw = opq_bid() * 8 + wave, NGW = opq_gdim() * 8;
    unsigned char* ar = a->ws + WS_AR;
    const bf16* ZR = (const bf16*)(ar + AR_ZR); const bf16* CG = (const bf16*)(ar + AR_CG); const bf16* PL = (const bf16*)(ar + AR_PL); const bf16* LV = (const bf16*)(ar + AR_LV);
    bf16* LA = (bf16*)(ar + AR_LA); bf16* YCV = (bf16*)(ar + AR_YCV); bf16* POOL = (bf16*)(ar + AR_POOL);
    LAS float* cw = (LAS float*)lds;
    for (int i = tid; i < 31 * 512; i += 512) cw[i] = a->in[21][l * 31 * 512 + i];
    __syncthreads();
    const int c8 = 8 * lane, ldA = l ? 384 : 256;
    float cvb[8], lng[8], lnb[8], mu[8];
    load8f(a->in[22] + l * 512 + c8, cvb); load8f(a->in[23] + l * 512 + c8, lng); load8f(a->in[24] + l * 512 + c8, lnb);
    if (lane < 32) load8f(a->in[6] + l * 1792 + 1536 + c8, mu);
    else if (l && lane < 36) load8f(a->in[7] + 8 * (lane - 32), mu);
    else {
#pragma unroll
        for (int i = 0; i < 8; ++i) mu[i] = 0.f; }
    for (int rb = gw; rb < 2048; rb += NGW)
        for (int gq = 0; gq < 8; ++gq) {
            const size_t m0 = (size_t)rb * 32 + gq * 4; const int s0 = (int)(m0 & 8191);
            if (lane < 32 || (l && lane < 36)) {
                const bf16* src = lane < 32 ? ZR + m0 * 1792 + 1536 + c8 : LV + m0 * 32 + 8 * (lane - 32); const int ldp = lane < 32 ? 1792 : 32;
                u32x4 zz[5];
#pragma unroll
                for (int i = 0; i < 5; ++i) zz[i] = (i == 0 && s0 == 0) ? (u32x4){0u, 0u, 0u, 0u} : *(const u32x4*)(src + (ptrdiff_t)(i - 1) * ldp);
#pragma unroll
                for (int i = 0; i < 4; ++i) { float zt[8], zp[8]; unpack8(zz[i + 1], zt); unpack8(zz[i], zp);
#pragma unroll
                    for (int q = 0; q < 8; ++q) { float z = zt[q] + (zp[q] - zt[q]) * mu[q];
                        if (lane < 8) z = 1.f - 2.f * __builtin_amdgcn_rcpf(1.f + __expf(2.f * z)); else if (lane >= 16 && lane < 32) z = sigm(z);
                        zt[q] = z; }
                    *(u32x4*)(LA + (m0 + i) * ldA + (lane < 32 ? c8 : 256 + 8 * (lane - 32))) = pack8(zt); }
            } else if (l && lane < 48) {
#pragma unroll
                for (int i = 0; i < 4; ++i) *(u32x4*)(LA + (m0 + i) * ldA + c8) = (u32x4){0u, 0u, 0u, 0u}; }
            { float acc[4][8]; f32x4 wq[4][2];
#pragma unroll
              for (int i = 0; i < 4; ++i)
#pragma unroll
                  for (int q = 0; q < 8; ++q) acc[i][q] = cvb[q];
#pragma unroll
              for (int hh = 0; hh < 2; ++hh) {
                  u32x4 xr[17];
#pragma unroll
                  for (int r = 0; r < 17; ++r) { const int rr = hh * 17 + r; const size_t row = (s0 - 30 + rr >= 0) ? (m0 - 30 + rr) : m0; xr[r] = *(const u32x4*)(CG + row * 512 + c8); }
#pragma unroll
                  for (int r = 0; r < 17; ++r) { const int rr = hh * 17 + r;
                      if (rr <= 30) { wq[rr & 3][0] = *(const LAS f32x4*)(cw + rr * 512 + c8); wq[rr & 3][1] = *(const LAS f32x4*)(cw + rr * 512 + c8 + 4); }
                      if (s0 - 30 + rr >= 0) { float x[8]; unpack8(xr[r], x);
#pragma unroll
                          for (int i = 0; i < 4; ++i) { const int j = rr - i; if (j >= 0 && j <= 30) {
#pragma unroll
                              for (int q = 0; q < 4; ++q) { acc[i][q] += x[q] * wq[j & 3][0][q]; acc[i][4 + q] += x[4 + q] * wq[j & 3][1][q]; } } } } }
              }
#pragma unroll
              for (int i = 0; i < 4; ++i) { float s1 = 0.f;
#pragma unroll
                  for (int q = 0; q < 8; ++q) s1 += acc[i][q];
                  const float mean = wave_sum(s1) * (1.f / 512.f); float qq = 0.f;
#pragma unroll
                  for (int q = 0; q < 8; ++q) { acc[i][q] -= mean; qq += acc[i][q] * acc[i][q]; }
                  const float rstd = 1.0f / sqrtf(wave_sum(qq) * (1.f / 512.f) + LN_EPS);
#pragma unroll
                  for (int q = 0; q < 8; ++q) { const float y = acc[i][q] * rstd * lng[q] + lnb[q]; acc[i][q] = y * sigm(y); }
                  *(u32x4*)(YCV + (m0 + i) * 512 + c8) = pack8(acc[i]); } }
            { const int win = 2 << (lane >> 4); u32x4 pr[19]; float sum[4][8], x0[4][8];
#pragma unroll
              for (int r = 0; r < 19; ++r) { const size_t row = (s0 - 15 + r >= 0) ? (m0 - 15 + r) : m0; pr[r] = *(const u32x4*)(PL + row * 512 + c8); }
#pragma unroll
              for (int i = 0; i < 4; ++i)
#pragma unroll
                  for (int q = 0; q < 8; ++q) sum[i][q] = 0.f;
#pragma unroll
              for (int r = 0; r < 19; ++r) { float x[8]; unpack8(pr[r], x);
#pragma unroll
                  for (int i = 0; i < 4; ++i) { const int d = i + 15 - r;
                      if (d >= 0 && d <= 15) { const int cnt = (s0 + i + 1) < win ? (s0 + i + 1) : win; const float f = d < cnt ? 1.f : 0.f;
#pragma unroll
                          for (int q = 0; q < 8; ++q) sum[i][q] += x[q] * f;
                          if (d == 0) {
#pragma unroll
                              for (int q = 0; q < 8; ++q) x0[i][q] = x[q]; } } } }
#pragma unroll
              for (int i = 0; i < 4; ++i) { const int cnt = (s0 + i + 1) < win ? (s0 + i + 1) : win; const float inv = 1.f / (float)cnt;
#pragma unroll
                  for (int q = 0; q < 8; ++q) sum[i][q] = sum[i][q] * inv - x0[i][q];
                  *(u32x4*)(POOL + (m0 + i) * 512 + c8) = pack8(sum[i]); } }
        }
    __syncthreads();
}
struct HSet { u32x2 rt[2], kt[2], rp[2], kp[2], ee[2], aa[2]; unsigned short vt[2], vp[2], vm[2], vf[2]; };
constexpr int SC_VV = 0, SC_YP = 4096, SC_OPS = 20480;
__device__ __forceinline__ void sc_load(HSet& S, int c, int l, int b, int h, int rg, int hl, const bf16* ZR, const bf16* LO, int ldlo, const bf16* VF) {
    if (c >= 256) return;
    const int cg = hl & 15, vc = h * 64 + 16 * rg + cg;
#pragma unroll
    for (int p = 0; p < 2; ++p) {
        const int t = (hl >> 4) + 16 * p, s = c * 32 + t; const size_t m = (size_t)b * 8192 + s;
        const bf16* zr = ZR + m * 1792; const bf16* lo = LO + m * ldlo;
        S.rt[p] = *(const u32x2*)(zr + h * 64 + 4 * cg); S.kt[p] = *(const u32x2*)(zr + 512 + h * 64 + 4 * cg); S.vt[p] = zr[1024 + vc];
        if (s > 0) { S.rp[p] = *(const u32x2*)(zr - 1792 + h * 64 + 4 * cg); S.kp[p] = *(const u32x2*)(zr - 1792 + 512 + h * 64 + 4 * cg); S.vp[p] = zr[-1792 + 1024 + vc]; }
        else { S.rp[p] = (u32x2){0u, 0u}; S.kp[p] = (u32x2){0u, 0u}; S.vp[p] = 0; }
        S.ee[p] = *(const u32x2*)(lo + h * 64 + 4 * cg); S.aa[p] = *(const u32x2*)(lo + 512 + h * 64 + 4 * cg);
        if (l) { S.vm[p] = lo[1536 + vc]; S.vf[p] = VF[m * 512 + vc]; } else { S.vm[p] = 0; S.vf[p] = 0; }
    }
}
__device__ __forceinline__ void sc_prep(const HSet& S, int c, int buf, int l, int b, int h, int rg, int hl, LAS unsigned char* lds, bf16* VF,
                                        const f32x4 mur, const f32x4 muk, const f32x4 kkc, const f32x4 kac, const float muv) {
    if (c >= 256) return;
    const int cg = hl & 15, vc = h * 64 + 16 * rg + cg;
#pragma unroll
    for (int p = 0; p < 2; ++p) {
        const int t = (hl >> 4) + 16 * p; const size_t m = (size_t)b * 8192 + c * 32 + t;
        f32x4 rt = {bflo(S.rt[p].x), bfhi(S.rt[p].x), bflo(S.rt[p].y), bfhi(S.rt[p].y)}, rp = {bflo(S.rp[p].x), bfhi(S.rp[p].x), bflo(S.rp[p].y), bfhi(S.rp[p].y)};
        f32x4 kt = {bflo(S.kt[p].x), bfhi(S.kt[p].x), bflo(S.kt[p].y), bfhi(S.kt[p].y)}, kp = {bflo(S.kp[p].x), bfhi(S.kp[p].x), bflo(S.kp[p].y), bfhi(S.kp[p].y)};
        const f32x4 e = {bflo(S.ee[p].x), bfhi(S.ee[p].x), bflo(S.ee[p].y), bfhi(S.ee[p].y)}, av = {bflo(S.aa[p].x), bfhi(S.aa[p].x), bflo(S.aa[p].y), bfhi(S.aa[p].y)};
        const f32x4 r = rt + (rp - rt) * mur, k = kt + (kp - kt) * muk;
        f32x4 w; w[0] = __expf(-e[0]); w[1] = __expf(-e[1]); w[2] = __expf(-e[2]); w[3] = __expf(-e[3]);
        f32x4 kk = k * kkc; const float ss = red16((kk[0] * kk[0] + kk[1] * kk[1]) + (kk[2] * kk[2] + kk[3] * kk[3]));
        kk = kk * __builtin_amdgcn_rsqf(fmaxf(ss, 1e-24f));
        const f32x4 kh = k * ((av - 1.f) * kac + 1.f);
        LAS float* o = (LAS float*)(lds + SC_OPS) + (buf * 32 + t) * 320 + 4 * cg;
        *(LAS f32x4*)(o) = w; *(LAS f32x4*)(o + 64) = -kk; *(LAS f32x4*)(o + 128) = kk * av; *(LAS f32x4*)(o + 192) = kh; *(LAS f32x4*)(o + 256) = r;
        const float vt = bf1(S.vt[p]), vp = bf1(S.vp[p]); float v = vt + (vp - vt) * muv;
        if (l) v = v + (bf1(S.vf[p]) - v) * bf1(S.vm[p]); else VF[m * 512 + vc] = (bf16)pk2(v, v);
        ((LAS float*)(lds + SC_VV))[(buf * 32 + t) * 16 + cg] = v;
    }
}
__device__ __forceinline__ void sc_yred(int c, int buf, int b, int h, int rg, int hl, LAS unsigned char* lds, bf16* YRW) {
    const int i = hl & 15;
#pragma unroll
    for (int p = 0; p < 2; ++p) { const int t = (hl >> 4) + 16 * p; const size_t m = (size_t)b * 8192 + c * 32 + t;
        const f32x4 q = *(const LAS f32x4*)((LAS float*)(lds + SC_YP) + ((buf * 32 + t) * 16 + i) * 4);
        const float ys = (q[0] + q[1]) + (q[2] + q[3]); YRW[m * 512 + h * 64 + 16 * rg + i] = (bf16)pk2(ys, ys); }
}
typedef float f32x2 __attribute__((ext_vector_type(2)));
struct ScOp { f32x4 w, a, b, k, r; float v; };
__device__ __forceinline__ ScOp sc_ld(const LAS float* ops, const LAS float* vv, int t) {
    ScOp o; o.w = *(const LAS f32x4*)(ops + t * 320); o.a = *(const LAS f32x4*)(ops + t * 320 + 64); o.b = *(const LAS f32x4*)(ops + t * 320 + 128);
    o.k = *(const LAS f32x4*)(ops + t * 320 + 192); o.r = *(const LAS f32x4*)(ops + t * 320 + 256); o.v = vv[t * 16]; return o;
}
__device__ __forceinline__ void sc_step(f32x2& s0, f32x2& s1, const ScOp& o, LAS float* ypt) {
    f32x2 p = s0 * o.a.xy; p = s1 * o.a.zw + p;
    const f32x2 vv = {o.v, o.v};
    const f32x2 t0 = s0 * o.w.xy + o.k.xy * vv, t1 = s1 * o.w.zw + o.k.zw * vv;
    const float sa = red16(p.x + p.y);
    const f32x2 sav = {sa, sa};
    s0 = o.b.xy * sav + t0;
    s1 = o.b.zw * sav + t1;
    f32x2 q = s0 * o.r.xy; q = s1 * o.r.zw + q;
    *ypt = red4(q.x + q.y);
}
__device__ __forceinline__ void sc_scan(f32x2& s0, f32x2& s1, int buf, int row, int seg, int lane, LAS unsigned char* lds) {
    const LAS float* ops = (const LAS float*)(lds + SC_OPS) + buf * 32 * 320 + 4 * seg;
    const LAS float* vv = (const LAS float*)(lds + SC_VV) + buf * 32 * 16 + row;
    LAS float* yp = (LAS float*)(lds + SC_YP) + (buf * 32 * 16 + row) * 4 + (seg >> 2);
    ScOp o0 = sc_ld(ops, vv, 0), o1 = sc_ld(ops, vv, 1);
#pragma unroll
    for (int t = 0; t < 32; t += 2) {
        const ScOp o2 = sc_ld(ops, vv, t + 2); sc_step(s0, s1, o0, yp + t * 64);
        const ScOp o3 = sc_ld(ops, vv, t + 3); sc_step(s0, s1, o1, yp + (t + 1) * 64);
        o0 = o2; o1 = o3;
    }
}
__device__ __forceinline__ void scan_phase(ArgsP a_, int l, LAS unsigned char* lds) {
    const ArgsP a = launder(a_);
    const int tid = opq_tid(), lane = tid & 63, wave = __builtin_amdgcn_readfirstlane(tid >> 6);
    unsigned char* ar = a->ws + WS_AR;
    const bf16* ZR = (const bf16*)(ar + AR_ZR); const bf16* LO = (const bf16*)(ar + AR_LO); const int ldlo = l ? 2048 : 1536;
    bf16* VF = (bf16*)(a->ws + WS_VFIRST); bf16* YRW = (bf16*)(ar + AR_YRW);
    for (int u = opq_bid(); u < 256; u += opq_gdim()) {
        const int b = u >> 5, h = (u >> 2) & 7, rg = u & 3;
        if (wave < 4) {
            f32x2 s0 = {0.f, 0.f}, s1 = {0.f, 0.f}; const int row = 4 * wave + (lane >> 4), seg = lane & 15;
            __syncthreads();
            for (int c = 0; c < 256; c += 2) {
                if (DUPM & 64) { f32x2 a0 = s0, a1 = s1; sc_scan(a0, a1, 0, row, seg, lane, lds); asm volatile("" :: "v"(a0), "v"(a1) : "memory"); }
                sc_scan(s0, s1, 0, row, seg, lane, lds); __syncthreads();
                if (DUPM & 64) { f32x2 a0 = s0, a1 = s1; sc_scan(a0, a1, 1, row, seg, lane, lds); asm volatile("" :: "v"(a0), "v"(a1) : "memory"); }
                sc_scan(s0, s1, 1, row, seg, lane, lds); __syncthreads(); }
        } else {
            const int hl = tid - 256, cg = hl & 15, ch = h * 64 + 4 * cg, vc = h * 64 + 16 * rg + cg;
            const f32x4 mur = *(const f32x4*)(a->in[6] + l * 1792 + ch), muk = *(const f32x4*)(a->in[6] + l * 1792 + 512 + ch);
            const f32x4 kkc = *(const f32x4*)(a->in[15] + l * 512 + ch), kac = *(const f32x4*)(a->in[16] + l * 512 + ch);
            const float muv = a->in[6][l * 1792 + 1024 + vc];
            HSet SA, SB;
            sc_load(SA, 0, l, b, h, rg, hl, ZR, LO, ldlo, VF); sc_prep(SA, 0, 0, l, b, h, rg, hl, lds, VF, mur, muk, kkc, kac, muv);
            sc_load(SA, 1, l, b, h, rg, hl, ZR, LO, ldlo, VF); sc_load(SB, 2, l, b, h, rg, hl, ZR, LO, ldlo, VF);
            __syncthreads();
            for (int c = 0; c < 256; c += 2) {
                if (c > 0) sc_yred(c - 1, 1, b, h, rg, hl, lds, YRW);
                sc_prep(SA, c + 1, 1, l, b, h, rg, hl, lds, VF, mur, muk, kkc, kac, muv);
                if (DUPM & 32) { f32x4 m2 = mur; asm volatile("" : "+v"(m2) :: "memory"); sc_prep(SA, c + 1, 1, l, b, h, rg, hl, lds, VF, m2, muk, kkc, kac, muv); }
                sc_load(SA, c + 3, l, b, h, rg, hl, ZR, LO, ldlo, VF);
                __syncthreads();
                sc_yred(c, 0, b, h, rg, hl, lds, YRW);
                sc_prep(SB, c + 2, 0, l, b, h, rg, hl, lds, VF, mur, muk, kkc, kac, muv);
                if (DUPM & 32) { f32x4 m2 = mur; asm volatile("" : "+v"(m2) :: "memory"); sc_prep(SB, c + 2, 0, l, b, h, rg, hl, lds, VF, m2, muk, kkc, kac, muv); }
                sc_load(SB, c + 4, l, b, h, rg, hl, ZR, LO, ldlo, VF);
                __syncthreads();
            }
            sc_yred(255, 1, b, h, rg, hl, lds, YRW);
        }
        __syncthreads();
    }
}
__device__ __forceinline__ void post_phase(ArgsP a_, int l) {
    const ArgsP a = launder(a_);
    const int tid = opq_tid(), lane = tid & 63, wave = tid >> 6, gw = opq_bid() * 8 + wave, NGW = opq_gdim() * 8, c8 = 8 * lane;
    unsigned char* ar = a->ws + WS_AR;
    const bf16* __restrict__ ZR = (const bf16*)(ar + AR_ZR); const bf16* __restrict__ LO = (const bf16*)(ar + AR_LO); const int ldlo = l ? 2048 : 1536;
    const bf16* __restrict__ VF = (const bf16*)(a->ws + WS_VFIRST); bf16* __restrict__ YRW = (bf16*)(ar + AR_YRW); const bf16* __restrict__ YRD = (const bf16*)(ar + AR_YRW);
    float mur[8], muk[8], muv[8], ka[8], rk[8], gng[8], gnb[8];
    load8f(a->in[6] + l * 1792 + c8, mur); load8f(a->in[6] + l * 1792 + 512 + c8, muk); load8f(a->in[6] + l * 1792 + 1024 + c8, muv);
    load8f(a->in[16] + l * 512 + c8, ka); load8f(a->in[17] + l * 512 + c8, rk); load8f(a->in[18] + l * 512 + c8, gng); load8f(a->in[19] + l * 512 + c8, gnb);
    for (int rb = gw; rb < 2048; rb += NGW)
#pragma unroll 2
        for (int rr = 0; rr < 32; ++rr) {
            const size_t m = (size_t)rb * 32 + rr; const int s = (int)(m & 8191);
            const bf16* zr = ZR + m * 1792 + c8; const bf16* lo = LO + m * ldlo + c8;
            float y[8], rt[8], kt[8], vt[8], rp[8], kp[8], vp[8], av[8], g[8];
            unpack8(*(const u32x4*)(YRD + m * 512 + c8), y);
            unpack8(*(const u32x4*)zr, rt); unpack8(*(const u32x4*)(zr + 512), kt); unpack8(*(const u32x4*)(zr + 1024), vt);
            if (s > 0) { unpack8(*(const u32x4*)(zr - 1792), rp); unpack8(*(const u32x4*)(zr - 1792 + 512), kp); unpack8(*(const u32x4*)(zr - 1792 + 1024), vp); }
            else {
#pragma unroll
                for (int i = 0; i < 8; ++i) { rp[i] = 0.f; kp[i] = 0.f; vp[i] = 0.f; } }
            unpack8(*(const u32x4*)(lo + 512), av); unpack8(*(const u32x4*)(lo + 1024), g);
            float bon = 0.f, sy = 0.f;
#pragma unroll
            for (int i = 0; i < 8; ++i) { const float r = rt[i] + (rp[i] - rt[i]) * mur[i], k = kt[i] + (kp[i] - kt[i]) * muk[i]; vt[i] = vt[i] + (vp[i] - vt[i]) * muv[i];
                bon += r * (k * (1.f + (av[i] - 1.f) * ka[i])) * rk[i]; sy += y[i]; }
            if (l) { float vm[8], vf[8]; unpack8(*(const u32x4*)(lo + 1536), vm); unpack8(*(const u32x4*)(VF + m * 512 + c8), vf);
#pragma unroll
                for (int i = 0; i < 8; ++i) vt[i] = vt[i] + (vf[i] - vt[i]) * vm[i]; }
            bon = red8(bon); const float mean = red8(sy) * (1.f / 64.f); float q = 0.f;
#pragma unroll
            for (int i = 0; i < 8; ++i) { y[i] -= mean; q += y[i] * y[i]; }
            const float rstd = 1.0f / sqrtf(red8(q) * (1.f / 64.f) + GN_EPS);
#pragma unroll
            for (int i = 0; i < 8; ++i) y[i] = (y[i] * rstd * gng[i] + gnb[i] + bon * vt[i]) * g[i];
            *(u32x4*)(YRW + m * 512 + c8) = pack8(y);
        }
}
__device__ __forceinline__ void combine_phase(ArgsP a_) {
    const ArgsP a = launder(a_);
    const int gt = opq_bid() * 512 + opq_tid(), NT = opq_gdim() * 512;
    const bf16* P = (const bf16*)(a->ws + WS_AR + AR_P); bf16* Hm = (bf16*)(a->ws + WS_H);
    for (int i = gt; i < M * 128; i += NT) { const size_t m = (size_t)(i >> 7); const int c8 = (i & 127) * 8; float p0[8], p1[8], p2[8];
        unpack8(*(const u32x4*)(P + m * 3072 + c8), p0); unpack8(*(const u32x4*)(P + m * 3072 + 1024 + c8), p1); unpack8(*(const u32x4*)(P + m * 3072 + 2048 + c8), p2);
#pragma unroll
        for (int q = 0; q < 8; ++q) p0[q] = (p0[q] + p1[q]) + p2[q];
        *(u32x4*)(Hm + m * 1024 + c8) = pack8(p0); }
}

#ifndef DUPM
#define DUPM 0
#endif
#ifndef PHM
#define PHM 0x7fff
#endif
#define GSYNC() do { XcdBarrier b_; b_.bar = (unsigned*)(launder(ak)->ws) + 1024; b_.x = xb_xcc_id(); b_.st = (volatile LAS unsigned*)(lds + LDS_BYTES - 64); xcd_barrier(b_); } while (0)
__global__ void __launch_bounds__(512, 2) fwd_kernel(Args kargs) {
    extern __shared__ __attribute__((aligned(16))) unsigned char lds_raw[];
    LAS unsigned char* lds = (LAS unsigned char*)lds_raw;
    cg::grid_group grid = cg::this_grid();
    { volatile LAS unsigned* st0 = (volatile LAS unsigned*)(lds + LDS_BYTES - 64); if (threadIdx.x == 0) { st0[0] = 0u; st0[1] = 0u; } __syncthreads(); }
    (void)xcd_barrier_post((unsigned*)(launder((ArgsP)__builtin_amdgcn_kernarg_segment_ptr())->ws) + 1024, (volatile LAS unsigned*)(lds + LDS_BYTES - 64));
    const ArgsP ak = (ArgsP)__builtin_amdgcn_kernarg_segment_ptr();

    if (PHM & 1) p0_phase(ak, lds); grid.sync();
    if (PHM & 2) p0b_phase(ak); GSYNC();
#pragma unroll 1
    for (int l = 0; l < 2; ++l) {
        if (PHM & 4) { const ArgsP a = launder(ak); const int G = opq_gdim(), bx = opq_bid(); unsigned char* ws = a->ws; unsigned char* ar = ws + WS_AR; bf16* H = (bf16*)(ws + WS_H); const float* adal = (const float*)(ws + WS_ADA) + l * 49152; (void)ar; (void)H; (void)adal;
          pg8::Gemm g{H, nullptr, nullptr, 0, (const bf16*)(ws + (l ? WS_WINA1 : WS_WINA0)), M, l ? 3584 : 3328, 1024};
          pg8::StaticOrder S; S.init(M, g.N, G, bx);
          EpiG1 E{(bf16*)(ar + AR_ZR), (bf16*)(ar + AR_CG), (bf16*)(ar + AR_PL), (bf16*)(ar + AR_LV)};
          pg8::gemm_phase<EpiG1, pg8::StaticOrder, true, true>(lds, g, S, E); }
        GSYNC();
        if (PHM & 8) prep_phase(ak, l, lds); GSYNC();
        if (DUPM & 1) { prep_phase(ak, l, lds); GSYNC(); }
        if (PHM & 16) { const ArgsP a = launder(ak); const int G = opq_gdim(), bx = opq_bid(); unsigned char* ws = a->ws; unsigned char* ar = ws + WS_AR; bf16* H = (bf16*)(ws + WS_H); const float* adal = (const float*)(ws + WS_ADA) + l * 49152; (void)ar; (void)H; (void)adal;
          pg8::Gemm g{(const bf16*)(ar + AR_LA), nullptr, nullptr, 0, (const bf16*)(ws + (l ? WS_WLORA1 : WS_WLORA0)), M, l ? 2048 : 1536, l ? 384 : 256};
          pg8::StaticOrder S; S.init(M, g.N, G, bx);
          EpiLora E{(bf16*)(ar + AR_LO), l ? 2048 : 1536, a->in[8] + l * 512, a->in[10] + l * 512, a->in[13]};
          pg8::gemm_phase<EpiLora, pg8::StaticOrder, true, true>(lds, g, S, E); }
        GSYNC();
        if (PHM & 32) scan_phase(ak, l, lds); GSYNC();
        if (DUPM & 16) { scan_phase(ak, l, lds); GSYNC(); }
        if (PHM & 64) post_phase(ak, l); GSYNC();
        if (DUPM & 2) { scan_phase(ak, l, lds); GSYNC(); post_phase(ak, l); GSYNC(); }
        if (DUPM & 4) { for (int q = 0; q < 16; ++q) GSYNC(); }
        if (PHM & 128) { const ArgsP a = launder(ak); const int G = opq_gdim(), bx = opq_bid(); unsigned char* ws = a->ws; unsigned char* ar = ws + WS_AR; bf16* H = (bf16*)(ws + WS_H); const float* adal = (const float*)(ws + WS_ADA) + l * 49152; (void)ar; (void)H; (void)adal;
          pg8::Gemm g{(const bf16*)(ar + AR_YRW), (const bf16*)(ar + AR_YCV), (const bf16*)(ar + AR_POOL), 4, (const bf16*)(ws + (l ? WS_WBR1 : WS_WBR0)), M, 3072, 512};
          pg8::StaticOrder S; S.init(M, g.N, G, bx);
          EpiBf<0> E{(bf16*)(ar + AR_P), 3072};
          pg8::gemm_phase<EpiBf<0>, pg8::StaticOrder, true, true>(lds, g, S, E); }
        GSYNC();
        if (PHM & 256) { const ArgsP a = launder(ak); const int G = opq_gdim(), bx = opq_bid(); unsigned char* ws = a->ws; unsigned char* ar = ws + WS_AR; bf16* H = (bf16*)(ws + WS_H); const float* adal = (const float*)(ws + WS_ADA) + l * 49152; (void)ar; (void)H; (void)adal;
          pg8::Gemm g{H, nullptr, nullptr, 0, (const bf16*)(ws + (l ? WS_WG1 : WS_WG0)), M, 3072, 1024};
          BranchOrder S; S.init(M, G, bx);
          EpiGate E{(bf16*)(ar + AR_P)};
          pg8::gemm_phase<EpiGate, BranchOrder, true, true>(lds, g, S, E); }
        GSYNC();
        if (PHM & 1024) { const ArgsP a = launder(ak); const int G = opq_gdim(), bx = opq_bid(); unsigned char* ws = a->ws; unsigned char* ar = ws + WS_AR; bf16* H = (bf16*)(ws + WS_H); const float* adal = (const float*)(ws + WS_ADA) + l * 49152; (void)ar; (void)H; (void)adal;
          pg8::Gemm g{(const bf16*)(ar + AR_P), nullptr, nullptr, 0, (const bf16*)(ws + (l ? WS_WOUT1 : WS_WOUT0)), M, 1024, 1024, 3072};
          pg8::StaticOrder S; S.init(M, g.N, G, bx);
          EpiRes E{l ? (const float*)a->out : a->in[0], a->out, adal + 2 * 1024};
          pg8::gemm_phase<EpiRes, pg8::StaticOrder, true, true>(lds, g, S, E); }
        GSYNC();
        if (PHM & 2048) { const ArgsP a = launder(ak); const float* adal = (const float*)(a->ws + WS_ADA) + l * 49152;
          ln_phase(a->out, (bf16*)(a->ws + WS_H), a->in[30] + l * 1024, a->in[31] + l * 1024, adal + 3 * 1024, adal + 4 * 1024, true); }
        GSYNC();
        if (PHM & 4096) { const ArgsP a = launder(ak); const int G = opq_gdim(), bx = opq_bid(); unsigned char* ws = a->ws; unsigned char* ar = ws + WS_AR; bf16* H = (bf16*)(ws + WS_H); const float* adal = (const float*)(ws + WS_ADA) + l * 49152; (void)ar; (void)H; (void)adal;
          pg8::Gemm g{H, nullptr, nullptr, 0, (const bf16*)(ws + (l ? WS_W1_1 : WS_W1_0)), M, 4096, 1024};
          pg8::StaticOrder S; S.init(M, g.N, G, bx);
          EpiBf<1> E{(bf16*)(ar + AR_HID), 4096};
          pg8::gemm_phase<EpiBf<1>, pg8::StaticOrder, true, true>(lds, g, S, E); }
        GSYNC();
        if (PHM & 8192) { const ArgsP a = launder(ak); const int G = opq_gdim(), bx = opq_bid(); unsigned char* ws = a->ws; unsigned char* ar = ws + WS_AR; bf16* H = (bf16*)(ws + WS_H); const float* adal = (const float*)(ws + WS_ADA) + l * 49152; (void)ar; (void)H; (void)adal;
          pg8::Gemm g{(const bf16*)(ar + AR_HID), nullptr, nullptr, 0, (const bf16*)(ws + (l ? WS_W2_1 : WS_W2_0)), M, 1024, 4096};
          pg8::StaticOrder S; S.init(M, g.N, G, bx);
          EpiRes E{a->out, a->out, adal + 5 * 1024};
          pg8::gemm_phase<EpiRes, pg8::StaticOrder, true, true>(lds, g, S, E); }
        GSYNC();
        if (PHM & 16384) { const ArgsP a = launder(ak); const float* ada1 = (const float*)(a->ws + WS_ADA) + 49152;
          ln_phase(a->out, (bf16*)(a->ws + WS_H), a->in[34] + l * 1024, a->in[35] + l * 1024, ada1, ada1 + 1024, l == 0); }
        if (l == 0) GSYNC();
    }
}

extern "C" void kernel_launch(void* const* d_in, const int* in_sizes, int n_in, void* d_out, int out_size, void* d_ws, size_t ws_size, hipStream_t stream) {
    static int grid = 0;
    if (grid == 0) {
        if (n_in != 36 || out_size != M * D || ws_size < WS_END) { fprintf(stderr, "kernel_launch: unexpected shapes (n_in %d, out %d, ws %zu)\n", n_in, out_size, ws_size); grid = -1; return; }
        int dev = 0, cus = 0, per_cu = 0;
        hipGetDevice(&dev); hipDeviceGetAttribute(&cus, hipDeviceAttributeMultiprocessorCount, dev);
        hipFuncSetAttribute((const void*)fwd_kernel, hipFuncAttributeMaxDynamicSharedMemorySize, LDS_BYTES);
        hipOccupancyMaxActiveBlocksPerMultiprocessor(&per_cu, (const void*)fwd_kernel, 512, LDS_BYTES);
        (void)hipGetLastError();
        if (per_cu < 1) per_cu = 1;
        grid = cus;
        if (grid > 256) grid = 256;
    }
    if (grid < 0) return;
    if (hipMemsetAsync(d_ws, 0, 65536, stream) != hipSuccess) { fprintf(stderr, "kernel_launch: memset failed\n"); return; }
    Args ha{};
    for (int i = 0; i < 36; ++i) ha.in[i] = (const float*)d_in[i];
    ha.out = (float*)d_out; ha.ws = (unsigned char*)d_ws;
    void* params[] = {&ha};
    hipError_t e = hipLaunchCooperativeKernel((const void*)fwd_kernel, dim3(grid), dim3(512), params, LDS_BYTES, stream);
    if (e != hipSuccess) fprintf(stderr, "cooperative launch failed: %s (grid %d)\n", hipGetErrorString(e), grid);
}
```
